# Optimizing an MI355X kernel written in HIP

```python
import math
import numpy as np
import jax
import jax.numpy as jnp
from jax import lax

D_MODEL = 1024
BATCH = 4
SEQ = 8192
DEPTH = 2

GRID_W = 64
CTX_LEN = 256
HEAD_DIM = 64
BLOCK_Q = 128
ROPE_THETA = 10000.0
EPS = 1e-6
NEG_INF = -1e30
A_HEADS = 8
A_KV_HEADS = 2
B_HEADS = 8
NA_ROWS = 8
NA_COLS = 16
C_HEADS = 4
D_HEADS = 8
D_KV_HEADS = 2
D_WINDOW = 128
MIX_EVEN = (A_HEADS + B_HEADS) * HEAD_DIM
MIX_ODD = C_HEADS * 2 * HEAD_DIM + D_HEADS * HEAD_DIM
EVEN_SPLITS = (A_HEADS * HEAD_DIM, A_KV_HEADS * HEAD_DIM, A_KV_HEADS * HEAD_DIM,
               B_HEADS * HEAD_DIM, B_HEADS * HEAD_DIM, B_HEADS * HEAD_DIM, MIX_EVEN)
ODD_SPLITS = (C_HEADS * 2 * HEAD_DIM, C_HEADS * 2 * HEAD_DIM, C_HEADS * 2 * HEAD_DIM,
              D_HEADS * HEAD_DIM, D_KV_HEADS * HEAD_DIM, D_KV_HEADS * HEAD_DIM, MIX_ODD)
IN_EVEN = sum(EVEN_SPLITS)
IN_ODD = sum(ODD_SPLITS)
N_EVEN = (DEPTH + 1) // 2
N_ODD = DEPTH // 2
SCALE = HEAD_DIM ** -0.5

kernel_name = 'hybrid_prefix_dit_block'


def rms_norm(x, gain=None):
    xf = x.astype(jnp.float32)
    y = xf * lax.rsqrt(jnp.mean(xf * xf, axis=-1, keepdims=True) + EPS)
    if gain is not None:
        y = y * gain.astype(jnp.float32)
    return y.astype(x.dtype)


def _split(x, sizes):
    idx = [int(i) for i in np.cumsum(sizes)[:-1]]
    return jnp.split(x, idx, axis=-1)


def _modulation(cvec, w_mod, b_mod):
    return jnp.split(jax.nn.silu(cvec) @ w_mod + b_mod, 3, axis=-1)


def lambda_init(layer):
    return 0.8 - 0.6 * math.exp(-0.3 * layer)


def axial_rope_tables(n_tok):
    t = jnp.arange(n_tok, dtype=jnp.int32)
    row = (t // GRID_W).astype(jnp.float32)
    col = (t % GRID_W).astype(jnp.float32)
    quarter = HEAD_DIM // 4
    inv_freq = ROPE_THETA ** (-jnp.arange(quarter, dtype=jnp.float32) / quarter)
    ang_r = row[:, None] * inv_freq
    ang_c = col[:, None] * inv_freq
    return (jnp.cos(ang_r), jnp.sin(ang_r), jnp.cos(ang_c), jnp.sin(ang_c))


def _rot(x, cos, sin):
    x1, x2 = jnp.split(x, 2, axis=-1)
    cos = cos[:, None, :]
    sin = sin[:, None, :]
    return jnp.concatenate([x1 * cos - x2 * sin, x1 * sin + x2 * cos], axis=-1)


def apply_axial_rope(x, tabs):
    cr, sr, cc, sc = tabs
    xr, xcol = jnp.split(x, 2, axis=-1)
    return jnp.concatenate([_rot(xr, cr, sr), _rot(xcol, cc, sc)], axis=-1).astype(x.dtype)


def neighbourhood_tables(n_tok):
    rows = n_tok // GRID_W
    win_r = min(NA_ROWS, rows)
    t = jnp.arange(n_tok, dtype=jnp.int32)
    r = t // GRID_W
    col = t % GRID_W
    rs = jnp.clip(r - win_r // 2, 0, rows - win_r)
    cs = jnp.clip(col - NA_COLS // 2, 0, GRID_W - NA_COLS)
    kr = rs[:, None, None] + jnp.arange(win_r, dtype=jnp.int32)[None, :, None]
    kc = cs[:, None, None] + jnp.arange(NA_COLS, dtype=jnp.int32)[None, None, :]
    key_idx = (kr * GRID_W + kc).reshape(n_tok, win_r * NA_COLS)
    bias_idx = ((kr - r[:, None, None] + NA_ROWS - 1) * (2 * NA_COLS - 1)
                + (kc - col[:, None, None] + NA_COLS - 1)).reshape(n_tok, win_r * NA_COLS)
    return key_idx, bias_idx


def _to_blocks(x):
    b, s = x.shape[:2]
    return jnp.moveaxis(x.reshape((b, s // BLOCK_Q, BLOCK_Q) + x.shape[2:]), 1, 0)


def _from_blocks(y):
    nb, b = y.shape[:2]
    return jnp.moveaxis(y, 0, 1).reshape((b, nb * BLOCK_Q) + y.shape[3:])


def gqa_attend(q5, k, v):
    sc = jnp.einsum('bqkgd,bskd->bkgqs', q5, k).astype(jnp.float32) * SCALE
    p = jax.nn.softmax(sc, axis=-1).astype(v.dtype)
    return jnp.einsum('bkgqs,bskd->bqkgd', p, v)


def diff_attend(q, k, v, lam):
    sc = jnp.einsum('bqhmd,bkhmd->bhmqk', q, k).astype(jnp.float32) * SCALE
    p = jax.nn.softmax(sc, axis=-1)
    a = (p[:, :, 0] - lam * p[:, :, 1]).astype(v.dtype)
    return jnp.einsum('bhqk,bkhe->bqhe', a, v)


def sink_attend(q5, k, v, sink):
    sc = jnp.einsum('bqkgd,bckd->bkgqc', q5, k).astype(jnp.float32) * SCALE
    s_sink = jnp.broadcast_to(sink[None, :, :, None, None], sc.shape[:-1] + (1,))
    p = jax.nn.softmax(jnp.concatenate([s_sink, sc], axis=-1), axis=-1)[..., 1:]
    return jnp.einsum('bkgqc,bckd->bqkgd', p.astype(v.dtype), v)


def neighbourhood_attend(q, k, v, k_ctx, v_ctx, rpb, key_idx, bias_idx):
    b, n_tok, h, d = q.shape
    n_nb = key_idx.shape[-1]
    rpb_flat = rpb.reshape(h, -1).astype(jnp.float32)

    def blk(args):
        qi, ki, bi = args
        kg = k[:, ki]
        vg = v[:, ki]
        s_n = jnp.einsum('bqhd,bqnhd->bhqn', qi, kg).astype(jnp.float32) * SCALE + rpb_flat[:, bi][None]
        s_c = jnp.einsum('bqhd,bchd->bhqc', qi, k_ctx).astype(jnp.float32) * SCALE
        p = jax.nn.softmax(jnp.concatenate([s_n, s_c], axis=-1), axis=-1).astype(v.dtype)
        return (jnp.einsum('bhqn,bqnhd->bqhd', p[..., :n_nb], vg)
                + jnp.einsum('bhqc,bchd->bqhd', p[..., n_nb:], v_ctx))

    nb = n_tok // BLOCK_Q
    out = lax.map(blk, (_to_blocks(q), key_idx.reshape(nb, BLOCK_Q, n_nb), bias_idx.reshape(nb, BLOCK_Q, n_nb)))
    return _from_blocks(out).reshape(b, n_tok, h * d)


def window_attend(q5, k, v, k_ctx, v_ctx, sink):
    b, n_tok, hkv, g, d = q5.shape
    pad = D_WINDOW
    span = BLOCK_Q + 2 * pad
    kp = jnp.pad(k, ((0, 0), (pad, pad), (0, 0), (0, 0)))
    vp = jnp.pad(v, ((0, 0), (pad, pad), (0, 0), (0, 0)))
    starts = jnp.arange(n_tok // BLOCK_Q, dtype=jnp.int32) * BLOCK_Q

    def blk(args):
        qi, st = args
        kw = lax.dynamic_slice_in_dim(kp, st, span, axis=1)
        vw = lax.dynamic_slice_in_dim(vp, st, span, axis=1)
        qpos = st + jnp.arange(BLOCK_Q, dtype=jnp.int32)
        kpos = st - pad + jnp.arange(span, dtype=jnp.int32)
        valid = ((kpos[None, :] >= 0) & (kpos[None, :] < n_tok)
                 & (jnp.abs(qpos[:, None] - kpos[None, :]) <= D_WINDOW))
        s_w = jnp.einsum('bqkgd,bskd->bkgqs', qi, kw).astype(jnp.float32) * SCALE
        s_w = jnp.where(valid, s_w, NEG_INF)
        s_c = jnp.einsum('bqkgd,bckd->bkgqc', qi, k_ctx).astype(jnp.float32) * SCALE
        s_sink = jnp.broadcast_to(sink[None, :, :, None, None], s_w.shape[:-1] + (1,))
        p = jax.nn.softmax(jnp.concatenate([s_sink, s_w, s_c], axis=-1), axis=-1).astype(v.dtype)
        return (jnp.einsum('bkgqs,bskd->bqkgd', p[..., 1:1 + span], vw)
                + jnp.einsum('bkgqc,bckd->bqkgd', p[..., 1 + span:], v_ctx))

    out = lax.map(blk, (_to_blocks(q5), starts))
    return _from_blocks(out).reshape(b, n_tok, hkv * g * d)


def even_mixer(h, hc, w_in, q_gain, k_gain, rpb, rope_tabs, na_tabs, ctx_out):
    b, n_tok, _ = h.shape
    L = hc.shape[1]
    hd = HEAD_DIM
    ga = A_HEADS // A_KV_HEADS
    qa, ka, va, qb, kb, vb, z = _split(h @ w_in, EVEN_SPLITS)
    qa_c, ka_c, va_c, qb_c, kb_c, vb_c, z_c = _split(hc @ w_in, EVEN_SPLITS)
    qa = apply_axial_rope(rms_norm(qa.reshape(b, n_tok, A_HEADS, hd), q_gain), rope_tabs)
    ka = apply_axial_rope(rms_norm(ka.reshape(b, n_tok, A_KV_HEADS, hd), k_gain), rope_tabs)
    ka_c = rms_norm(ka_c.reshape(b, L, A_KV_HEADS, hd), k_gain)
    va_c = va_c.reshape(b, L, A_KV_HEADS, hd)
    k_all = jnp.concatenate([ka, ka_c], axis=1)
    v_all = jnp.concatenate([va.reshape(b, n_tok, A_KV_HEADS, hd), va_c], axis=1)
    qa5 = qa.reshape(b, n_tok, A_KV_HEADS, ga, hd)
    ya = _from_blocks(lax.map(lambda qi: gqa_attend(qi, k_all, v_all), _to_blocks(qa5))).reshape(b, n_tok, -1)
    kb_c = kb_c.reshape(b, L, B_HEADS, hd)
    vb_c = vb_c.reshape(b, L, B_HEADS, hd)
    yb = neighbourhood_attend(qb.reshape(b, n_tok, B_HEADS, hd), kb.reshape(b, n_tok, B_HEADS, hd),
                              vb.reshape(b, n_tok, B_HEADS, hd), kb_c, vb_c, rpb, na_tabs[0], na_tabs[1])
    y = jnp.concatenate([ya, yb], axis=-1) * jax.nn.silu(z)
    if not ctx_out:
        return y, None
    qa_c5 = rms_norm(qa_c.reshape(b, L, A_KV_HEADS, ga, hd), q_gain)
    ya_c = gqa_attend(qa_c5, ka_c, va_c).reshape(b, L, -1)
    yb_c = gqa_attend(qb_c.reshape(b, L, B_HEADS, 1, hd), kb_c, vb_c).reshape(b, L, -1)
    y_ctx = jnp.concatenate([ya_c, yb_c], axis=-1) * jax.nn.silu(z_c)
    return y, y_ctx


def odd_mixer(h, hc, w_in, lam_vecs, subln, sinks, lam0, rope_tabs, ctx_out):
    b, n_tok, _ = h.shape
    L = hc.shape[1]
    hd = HEAD_DIM
    gd = D_HEADS // D_KV_HEADS
    qc, kc, vc, qd, kd, vd, z = _split(h @ w_in, ODD_SPLITS)
    qc_c, kc_c, vc_c, qd_c, kd_c, vd_c, z_c = _split(hc @ w_in, ODD_SPLITS)
    lv = lam_vecs.astype(jnp.float32)
    lam = jnp.exp(jnp.sum(lv[0] * lv[1])) - jnp.exp(jnp.sum(lv[2] * lv[3])) + lam0
    qc = apply_axial_rope(qc.reshape(b, n_tok, 2 * C_HEADS, hd), rope_tabs).reshape(b, n_tok, C_HEADS, 2, hd)
    kc = apply_axial_rope(kc.reshape(b, n_tok, 2 * C_HEADS, hd), rope_tabs).reshape(b, n_tok, C_HEADS, 2, hd)
    kc_c = kc_c.reshape(b, L, C_HEADS, 2, hd)
    vc_c = vc_c.reshape(b, L, C_HEADS, 2 * hd)
    kc_all = jnp.concatenate([kc, kc_c], axis=1)
    vc_all = jnp.concatenate([vc.reshape(b, n_tok, C_HEADS, 2 * hd), vc_c], axis=1)
    yc = _from_blocks(lax.map(lambda qi: diff_attend(qi, kc_all, vc_all, lam), _to_blocks(qc)))
    yc = (rms_norm(yc, subln) * (1.0 - lam0)).reshape(b, n_tok, -1)
    qd5 = apply_axial_rope(qd.reshape(b, n_tok, D_HEADS, hd), rope_tabs).reshape(b, n_tok, D_KV_HEADS, gd, hd)
    kd = apply_axial_rope(kd.reshape(b, n_tok, D_KV_HEADS, hd), rope_tabs)
    kd_c = kd_c.reshape(b, L, D_KV_HEADS, hd)
    vd_c = vd_c.reshape(b, L, D_KV_HEADS, hd)
    sink = sinks.reshape(D_KV_HEADS, gd).astype(jnp.float32)
    yd = window_attend(qd5, kd, vd.reshape(b, n_tok, D_KV_HEADS, hd), kd_c, vd_c, sink)
    y = jnp.concatenate([yc, yd], axis=-1) * jax.nn.silu(z)
    if not ctx_out:
        return y, None
    yc_c = (rms_norm(diff_attend(qc_c.reshape(b, L, C_HEADS, 2, hd), kc_c, vc_c, lam), subln)
            * (1.0 - lam0)).reshape(b, L, -1)
    yd_c = sink_attend(qd_c.reshape(b, L, D_KV_HEADS, gd, hd), kd_c, vd_c, sink).reshape(b, L, -1)
    y_ctx = jnp.concatenate([yc_c, yd_c], axis=-1) * jax.nn.silu(z_c)
    return y, y_ctx


def setup_inputs(seed: int = 0) -> dict:
    key = jax.random.key(seed)
    ks = jax.random.split(key, 17)
    f32 = jnp.float32

    def nrm(k, shape, s):
        return jax.random.normal(k, shape, f32) * s

    return {
        'x': nrm(ks[0], (BATCH, SEQ, D_MODEL), 1.0),
        'c': nrm(ks[1], (BATCH, D_MODEL), 1.0),
        'ctx': nrm(ks[2], (BATCH, CTX_LEN, D_MODEL), 1.0),
        'c_ctx': nrm(ks[3], (D_MODEL,), 1.0),
        'w_mod': nrm(ks[4], (DEPTH, D_MODEL, 3 * D_MODEL), 0.5 * D_MODEL ** -0.5),
        'b_mod': nrm(ks[5], (DEPTH, 3 * D_MODEL), 0.02),
        'w_in_even': nrm(ks[6], (N_EVEN, D_MODEL, IN_EVEN), D_MODEL ** -0.5),
        'w_out_even': nrm(ks[7], (N_EVEN, MIX_EVEN, D_MODEL), MIX_EVEN ** -0.5),
        'a_q_norm': 1.0 + nrm(ks[8], (N_EVEN, HEAD_DIM), 0.02),
        'a_k_norm': 1.0 + nrm(ks[9], (N_EVEN, HEAD_DIM), 0.02),
        'b_rpb': nrm(ks[10], (N_EVEN, B_HEADS, 2 * NA_ROWS - 1, 2 * NA_COLS - 1), 0.1),
        'w_in_odd': nrm(ks[11], (N_ODD, D_MODEL, IN_ODD), D_MODEL ** -0.5),
        'w_out_odd': nrm(ks[12], (N_ODD, MIX_ODD, D_MODEL), MIX_ODD ** -0.5),
        'c_lambda': nrm(ks[13], (N_ODD, 4, HEAD_DIM), 0.1),
        'c_subln': 1.0 + nrm(ks[14], (N_ODD, 2 * HEAD_DIM), 0.02),
        'd_sinks': nrm(ks[15], (N_ODD, D_HEADS), 0.5),
        'final_norm': 1.0 + nrm(ks[16], (D_MODEL,), 0.02),
    }


def reference(x, c, ctx, c_ctx, w_mod, b_mod, w_in_even, w_out_even, a_q_norm, a_k_norm, b_rpb,
              w_in_odd, w_out_odd, c_lambda, c_subln, d_sinks, final_norm):
    n_tok = x.shape[1]
    rope_tabs = axial_rope_tables(n_tok)
    na_tabs = neighbourhood_tables(n_tok)
    xc = ctx
    for l in range(DEPTH):
        last = l == DEPTH - 1
        shift, scale, gate = _modulation(c, w_mod[l], b_mod[l])
        shift_c, scale_c, gate_c = _modulation(c_ctx, w_mod[l], b_mod[l])
        h = rms_norm(x) * (1.0 + scale[:, None]) + shift[:, None]
        hc = rms_norm(xc) * (1.0 + scale_c) + shift_c
        i = l // 2
        if l % 2 == 0:
            y, y_ctx = even_mixer(h, hc, w_in_even[i], a_q_norm[i], a_k_norm[i], b_rpb[i],
                                  rope_tabs, na_tabs, not last)
            w_out = w_out_even[i]
        else:
            y, y_ctx = odd_mixer(h, hc, w_in_odd[i], c_lambda[i], c_subln[i], d_sinks[i],
                                 lambda_init(l), rope_tabs, not last)
            w_out = w_out_odd[i]
        x = x + gate[:, None] * (y @ w_out)
        if not last:
            xc = xc + gate_c * (y_ctx @ w_out)
    return rms_norm(x, final_norm)
```

```cpp
#include <hip/hip_runtime.h>
#include <hip/hip_bf16.h>
#include <hip/hip_cooperative_groups.h>
#include <cstdio>
#include <cstdint>
#include <cmath>
namespace pg8 {
#define PG8_LAS __attribute__((address_space(3)))
typedef unsigned short bf16_t;
typedef short bf16x8 __attribute__((ext_vector_type(8)));
typedef float f32x4 __attribute__((ext_vector_type(4)));
typedef unsigned u32x4 __attribute__((ext_vector_type(4)));
constexpr int BM = 256, BK = 64, HALF = 128, HTB = HALF * BK * 2  , STAGE_BYTES = 8 * HTB, NXCD = 8, WGM = 8;

__host__ __device__ __forceinline__ int lds_byte(int r, int c) { const int st = (r >> 4) * 2 + (c >> 5), rr = r & 15, cc = c & 31, ob = rr * 64 + cc * 2; return st * 1024 + (ob ^ (((ob >> 9) & 1) << 5)); }
__host__ __device__ __forceinline__ void stage_rc(int b, int& R, int& C) { const int st = b / 1024, sb = b % 1024, swz = sb ^ (((sb >> 9) & 1) << 5); R = (st >> 1) * 16 + swz / 64; C = (st & 1) * 32 + (swz % 64) / 2; }
__host__ __device__ __forceinline__ int perm32(int rho) { const int n = rho >> 4, i = rho & 15; return 8 * (i >> 2) + 4 * n + (i & 3); }

struct Unit { int pm, pn; };
struct Gemm { const bf16_t* A; const bf16_t* Bt; int M, N, K; };

struct StaticOrder {
    int nM, nN, nwg, G, c;
    __host__ __device__ void init(int M, int N, int G_, int c_) { nM = M / BM; nN = N / BM; nwg = nM * nN; G = G_; c = c_; }
    __host__ __device__ bool next(int i, Unit& u) const {
        const long L = (long)i * G + c; if (L >= nwg) return false;
        int wgid = (int)L; { const int q = nwg / NXCD, r = nwg % NXCD, xcd = wgid % NXCD, off = wgid / NXCD; wgid = (xcd < r ? xcd * (q + 1) : r * (q + 1) + (xcd - r) * q) + off; }
        const int nig = WGM * nN, gid = wgid / nig, fm = gid * WGM, gsz = (nM - fm) < WGM ? (nM - fm) : WGM;
        u.pm = fm + ((wgid % nig) % gsz); u.pn = (wgid % nig) / gsz; return true;
    }
    __device__ __forceinline__ void a_ready(const Unit&) const {}
    __device__ __forceinline__ void done(const Unit&) const {}
};

__device__ __forceinline__ unsigned cvt_pk_bf16(float lo, float hi) { unsigned r; asm volatile("v_cvt_pk_bf16_f32 %0, %1, %2" : "=v"(r) : "v"(lo), "v"(hi)); return r; }
typedef float f32x2 __attribute__((ext_vector_type(2)));
typedef unsigned u32x2 __attribute__((ext_vector_type(2)));
constexpr float QSCALE = 0.125f * 1.4426950408889634f;
constexpr int SE = 8448, NQKV = 2304, DMODEL = 1024;

struct EpiQKV {
    static constexpr bool PERM = false, AFTER_DRAIN = false;
    bf16_t* QKV; bf16_t* Y; const float* ropec; const float* ropes; const float* gq; const float* gk; int layer;
    __device__ __forceinline__ void operator()(const f32x4 (&acc)[2][2][4][2], const Unit& u, int wr, int wc, int fr, int fq) const {
        asm volatile("" : "+v"(fr), "+v"(fq));
        const int c64 = u.pn * 4 + wc;
        int norm = 0; bool rope = false, scale = false, silu = false;
        if (layer == 0) { if (c64 < 8) { norm = 1; rope = true; scale = true; } else if (c64 < 10) { norm = 2; rope = true; } else if (c64 >= 12 && c64 < 20) scale = true; else if (c64 >= 36) silu = true; }
        else { if (c64 < 8) { rope = true; scale = true; } else if (c64 < 16) rope = true; else if (c64 >= 24 && c64 < 32) { rope = true; scale = true; } else if (c64 >= 32 && c64 < 34) rope = true; else if (c64 >= 36) silu = true; }
        const int pmb = u.pm % 33; const bool isctx = (pmb == 32); if (isctx) rope = false;
        const float* gain = (norm == 1) ? gq : gk;
#pragma unroll
        for (int ai = 0; ai < 2; ++ai) {
            const int pr = pmb * 4 + ai * 2 + wr;
#pragma unroll
            for (int m = 0; m < 4; ++m) {
                const size_t R = (size_t)u.pm * 256 + ai * 128 + wr * 64 + m * 16 + fr;
                f32x4 v[2][2];
#pragma unroll
                for (int bj = 0; bj < 2; ++bj)
#pragma unroll
                    for (int n = 0; n < 2; ++n) v[bj][n] = acc[ai][bj][m][n];
                if (norm) {
                    float ss = 0.f;
#pragma unroll
                    for (int bj = 0; bj < 2; ++bj)
#pragma unroll
                        for (int n = 0; n < 2; ++n) { const f32x4 x = v[bj][n]; ss += (x[0] * x[0] + x[1] * x[1]) + (x[2] * x[2] + x[3] * x[3]); }
                    ss += __shfl_xor(ss, 16); ss += __shfl_xor(ss, 32);
                    const float rs = 1.0f / sqrtf(ss * (1.0f / 64.0f) + 1e-6f);
#pragma unroll
                    for (int bj = 0; bj < 2; ++bj)
#pragma unroll
                        for (int n = 0; n < 2; ++n) v[bj][n] = v[bj][n] * rs * *(const f32x4*)(gain + 32 * bj + 16 * n + 4 * fq);
                }
                if (rope) {
                    const int pc = m * 16 + fr;
                    const f32x4 cr = *(const f32x4*)(ropec + pr * 16 + 4 * fq), sr = *(const f32x4*)(ropes + pr * 16 + 4 * fq);
                    const f32x4 cc = *(const f32x4*)(ropec + pc * 16 + 4 * fq), sc = *(const f32x4*)(ropes + pc * 16 + 4 * fq);
                    f32x4 x1 = v[0][0], x2 = v[0][1]; v[0][0] = x1 * cr - x2 * sr; v[0][1] = x1 * sr + x2 * cr;
                    x1 = v[1][0]; x2 = v[1][1]; v[1][0] = x1 * cc - x2 * sc; v[1][1] = x1 * sc + x2 * cc;
                }
                if (scale) {
#pragma unroll
                    for (int bj = 0; bj < 2; ++bj)
#pragma unroll
                        for (int n = 0; n < 2; ++n) v[bj][n] = v[bj][n] * QSCALE;
                }
                bf16_t* dst;
                if (silu) {
#pragma unroll
                    for (int bj = 0; bj < 2; ++bj)
#pragma unroll
                        for (int n = 0; n < 2; ++n)
#pragma unroll
                            for (int e = 0; e < 4; ++e) { const float x = v[bj][n][e]; v[bj][n][e] = x * __builtin_amdgcn_rcpf(1.0f + __builtin_amdgcn_exp2f(-1.4426950408889634f * x)); }
                    dst = Y + R * DMODEL + (size_t)(c64 - 36) * 64 + 4 * fq;
                } else dst = QKV + R * NQKV + (size_t)c64 * 64 + 4 * fq;
#pragma unroll
                for (int bj = 0; bj < 2; ++bj)
#pragma unroll
                    for (int n = 0; n < 2; ++n) { u32x2 w; w.x = cvt_pk_bf16(v[bj][n][0], v[bj][n][1]); w.y = cvt_pk_bf16(v[bj][n][2], v[bj][n][3]); *(u32x2*)(dst + 32 * bj + 16 * n) = w; }
                asm volatile("" ::: "memory");
            }
        }
    }
};

struct EpiOut {
    static constexpr bool PERM = false, AFTER_DRAIN = false;
    const float* xin; float* xout; const float* cin; float* cout; const float* mod;
    __device__ __forceinline__ void operator()(const f32x4 (&acc)[2][2][4][2], const Unit& u, int wr, int wc, int fr, int fq) const {
        asm volatile("" : "+v"(fr), "+v"(fq));
        const int pmb = u.pm % 33, b = u.pm / 33; const bool isctx = (pmb == 32);
        const float* src; float* dst; const float* gate;
        if (isctx) { src = cin + (size_t)b * 256 * DMODEL; dst = cout + (size_t)b * 256 * DMODEL; gate = mod + 4 * 3072 + 2048; }
        else { const size_t o = ((size_t)b * 8192 + (size_t)pmb * 256) * DMODEL; src = xin + o; dst = xout + o; gate = mod + b * 3072 + 2048; }
        const int col0 = u.pn * BM + wc * 32 + 4 * fq;
        f32x4 g[2][2];
#pragma unroll
        for (int bj = 0; bj < 2; ++bj)
#pragma unroll
            for (int n = 0; n < 2; ++n) g[bj][n] = *(const f32x4*)(gate + col0 + bj * HALF + n * 16);
#pragma unroll
        for (int ai = 0; ai < 2; ++ai)
#pragma unroll
            for (int m = 0; m < 4; ++m) { const size_t off = (size_t)(ai * HALF + wr * 64 + m * 16 + fr) * DMODEL + col0;
#pragma unroll
                for (int bj = 0; bj < 2; ++bj)
#pragma unroll
                    for (int n = 0; n < 2; ++n) { const f32x4 xo = *(const f32x4*)(src + off + bj * HALF + n * 16); *(f32x4*)(dst + off + bj * HALF + n * 16) = xo + g[bj][n] * acc[ai][bj][m][n]; }
                asm volatile("" ::: "memory"); }
    }
};
struct FlexOrder {
    StaticOrder base; int latent_only;
    __device__ void init(int N, int G_, int c_, int latent_only_) { latent_only = latent_only_; base.init(latent_only_ ? 4 * 8192 : 4 * SE, N, G_, c_); }
    __device__ bool next(int i, Unit& u) const { if (!base.next(i, u)) return false; if (latent_only) u.pm += u.pm >> 5; return true; }
    __device__ __forceinline__ void a_ready(const Unit&) const {}
    __device__ __forceinline__ void done(const Unit&) const {}
};
template <class Epi, class Sched, bool ALIGN_EPI = false, bool SP2 = false>
__device__ __forceinline__ void gemm_phase(PG8_LAS unsigned char* lds, const Gemm g, const Sched& S, const Epi& E) {
    int tid_ = threadIdx.x; asm volatile("" : "+v"(tid_));
    const int tid = tid_, wid = __builtin_amdgcn_readfirstlane(tid >> 6), lane = tid & 63, wr = wid >> 2, wc = wid & 3, fr = lane & 15, fq = lane >> 4;
    const int K = g.K, nt = K / BK;
    unsigned voffA[2], voffB[2];
#pragma unroll
    for (int i = 0; i < 2; ++i) { int R, C; stage_rc(tid * 16 + i * 8192, R, C); const int Rb = Epi::PERM ? ((R & ~31) + perm32(R & 31)) : R;
        voffA[i] = (unsigned)(R * K + C) * 2u; voffB[i] = (unsigned)(Rb * K + C) * 2u; }
    const size_t kstep = (size_t)(BK * 2);
    const size_t hstep = (size_t)HALF * K * 2;
    const size_t tstep = 2 * hstep;
    const unsigned ldsw = (unsigned)wid * 1024u;
    const int aoff = lds_byte(wr * 64 + fr, fq * 8), boff = lds_byte(wc * 32 + fr, fq * 8);
#define PG8_SA(b, h) (((b) * 2 + (h)) * HTB)
#define PG8_SB(b, h) ((4 + (b) * 2 + (h)) * HTB)
#define PG8_STAGE(bufoff, gbase, voff) do { _Pragma("unroll") for (int _i = 0; _i < 2; ++_i) \
        __builtin_amdgcn_global_load_lds((const unsigned*)((const char*)(gbase) + (voff)[_i]), (PG8_LAS unsigned*)(lds + (bufoff) + ldsw + _i * 8192), 16, 0, 0); } while (0)
#define PG8_LDA(dst, b, h) do { _Pragma("unroll") for (int m = 0; m < 4; ++m) _Pragma("unroll") for (int k = 0; k < 2; ++k) dst[m][k] = *(const PG8_LAS bf16x8*)(lds + PG8_SA(b, h) + aoff + m * 2048 + k * 1024); } while (0)
#define PG8_LDB(dst, b, h) do { _Pragma("unroll") for (int n = 0; n < 2; ++n) _Pragma("unroll") for (int k = 0; k < 2; ++k) dst[n][k] = *(const PG8_LAS bf16x8*)(lds + PG8_SB(b, h) + boff + n * 2048 + k * 1024); } while (0)
#define PG8_MMA(ai, bj, At, Bt) do { __builtin_amdgcn_s_setprio(1); _Pragma("unroll") for (int m = 0; m < 4; ++m) _Pragma("unroll") for (int n = 0; n < 2; ++n) _Pragma("unroll") for (int k = 0; k < 2; ++k) \
        acc[ai][bj][m][n] = __builtin_amdgcn_mfma_f32_16x16x32_bf16(Bt[n][k], At[m][k], acc[ai][bj][m][n], 0, 0, 0); __builtin_amdgcn_s_setprio(0); } while (0)
#define PG8_WAIT_V(n) asm volatile("s_waitcnt vmcnt(" #n ")" ::: "memory")
#define PG8_WAIT_L(n) asm volatile("s_waitcnt lgkmcnt(" #n ")" ::: "memory")
#define PG8_BAR __builtin_amdgcn_s_barrier()
#define PG8_SCHED __builtin_amdgcn_sched_barrier(0)
    Unit cur, nxt; int ui = 0;
    if (!S.next(0, cur)) return;
    f32x4 acc[2][2][4][2];
#pragma unroll
    for (int a = 0; a < 2; ++a)
#pragma unroll
        for (int b = 0; b < 2; ++b)
#pragma unroll
            for (int m = 0; m < 4; ++m)
#pragma unroll
                for (int n = 0; n < 2; ++n) acc[a][b][m][n] = (f32x4){0.f, 0.f, 0.f, 0.f};
    bf16x8 At[4][2], B0[2][2], B1[2][2];
    const char* cA = (const char*)g.A + (size_t)cur.pm * tstep; const char* cB = (const char*)g.Bt + (size_t)cur.pn * tstep;
    S.a_ready(cur);
    if constexpr (SP2) {
        PG8_STAGE(PG8_SB(0, 0), cB, voffB); PG8_STAGE(PG8_SB(0, 1), cB + hstep, voffB); PG8_STAGE(PG8_SA(0, 0), cA, voffA); PG8_STAGE(PG8_SA(0, 1), cA + hstep, voffA);
        if (wr == 1) PG8_BAR;
        PG8_WAIT_V(2); PG8_BAR;
        PG8_STAGE(PG8_SB(1, 0), cB + kstep, voffB); PG8_STAGE(PG8_SA(1, 0), cA + kstep, voffA); PG8_STAGE(PG8_SB(1, 1), cB + hstep + kstep, voffB);
        PG8_WAIT_V(6); PG8_BAR;
    } else {
        PG8_STAGE(PG8_SB(0, 0), cB, voffB); PG8_STAGE(PG8_SA(0, 0), cA, voffA); PG8_STAGE(PG8_SB(0, 1), cB + hstep, voffB); PG8_STAGE(PG8_SA(0, 1), cA + hstep, voffA);
        if (wr == 1) PG8_BAR;
        PG8_WAIT_V(4); PG8_BAR;
        PG8_STAGE(PG8_SB(1, 0), cB + kstep, voffB); PG8_STAGE(PG8_SA(1, 0), cA + kstep, voffA); PG8_STAGE(PG8_SB(1, 1), cB + hstep + kstep, voffB);
        PG8_WAIT_V(6); PG8_BAR;
    }
    for (;;) {
        const bool has_next = S.next(ui + 1, nxt);
        const char* nA = has_next ? (const char*)g.A + (size_t)nxt.pm * tstep : cA; const char* nB = has_next ? (const char*)g.Bt + (size_t)nxt.pn * tstep : cB;
        for (int t = 0; t < nt; t += 2) {
            const bool last = (t == nt - 2);
            const char* a1 = cA + (size_t)(t + 1) * kstep;
            const char* a2 = last ? nA : cA + (size_t)(t + 2) * kstep; const char* b2 = last ? nB : cB + (size_t)(t + 2) * kstep;
            const char* a3 = a2 + kstep; const char* b3 = b2 + kstep;
            if (last && has_next) S.a_ready(nxt);
            if constexpr (SP2) {
            PG8_LDB(B0, 0, 0); PG8_LDB(B1, 0, 1); PG8_SCHED; PG8_LDA(At, 0, 0); PG8_STAGE(PG8_SA(1, 1), a1 + hstep, voffA);
            PG8_WAIT_V(8); PG8_WAIT_L(0); PG8_BAR; PG8_MMA(0, 0, At, B0); PG8_MMA(0, 1, At, B1); PG8_BAR; PG8_SCHED;
            PG8_LDA(At, 0, 1); PG8_STAGE(PG8_SB(0, 0), b2, voffB); PG8_STAGE(PG8_SB(0, 1), b2 + hstep, voffB); PG8_STAGE(PG8_SA(0, 0), a2, voffA);
            PG8_WAIT_V(8); PG8_WAIT_L(0); PG8_BAR; PG8_MMA(1, 0, At, B0); PG8_MMA(1, 1, At, B1); PG8_BAR; PG8_SCHED;
            PG8_LDB(B0, 1, 0); PG8_LDB(B1, 1, 1); PG8_SCHED; PG8_LDA(At, 1, 0); PG8_STAGE(PG8_SA(0, 1), a2 + hstep, voffA);
            PG8_WAIT_V(8); PG8_WAIT_L(0); PG8_BAR; PG8_MMA(0, 0, At, B0); PG8_MMA(0, 1, At, B1); PG8_BAR; PG8_SCHED;
            PG8_LDA(At, 1, 1); PG8_STAGE(PG8_SB(1, 0), b3, voffB); PG8_STAGE(PG8_SB(1, 1), b3 + hstep, voffB); PG8_STAGE(PG8_SA(1, 0), a3, voffA);
            PG8_WAIT_V(8); PG8_WAIT_L(0); PG8_BAR; PG8_MMA(1, 0, At, B0); PG8_MMA(1, 1, At, B1); PG8_BAR; PG8_SCHED;
            } else {
            PG8_LDB(B0, 0, 0); PG8_SCHED; PG8_LDA(At, 0, 0); PG8_STAGE(PG8_SA(1, 1), a1 + hstep, voffA);
            PG8_WAIT_L(8); PG8_BAR; PG8_WAIT_L(0); PG8_MMA(0, 0, At, B0); PG8_BAR; PG8_SCHED;
            PG8_LDB(B1, 0, 1); PG8_STAGE(PG8_SB(0, 0), b2, voffB);
            PG8_BAR; PG8_WAIT_L(0); PG8_MMA(0, 1, At, B1); PG8_BAR;
            PG8_LDA(At, 0, 1); PG8_STAGE(PG8_SA(0, 0), a2, voffA);
            PG8_BAR; PG8_WAIT_L(0); PG8_MMA(1, 0, At, B0); PG8_BAR; PG8_SCHED;
            PG8_STAGE(PG8_SB(0, 1), b2 + hstep, voffB);
            PG8_WAIT_V(6); PG8_BAR; PG8_MMA(1, 1, At, B1); PG8_BAR;
            PG8_LDB(B0, 1, 0); PG8_SCHED; PG8_LDA(At, 1, 0); PG8_STAGE(PG8_SA(0, 1), a2 + hstep, voffA);
            PG8_WAIT_L(8); PG8_BAR; PG8_WAIT_L(0); PG8_MMA(0, 0, At, B0); PG8_BAR; PG8_SCHED;
            PG8_LDB(B1, 1, 1); PG8_STAGE(PG8_SB(1, 0), b3, voffB);
            PG8_BAR; PG8_WAIT_L(0); PG8_MMA(0, 1, At, B1); PG8_BAR;
            PG8_LDA(At, 1, 1); PG8_STAGE(PG8_SA(1, 0), a3, voffA);
            PG8_BAR; PG8_WAIT_L(0); PG8_MMA(1, 0, At, B0); PG8_BAR; PG8_SCHED;
            PG8_STAGE(PG8_SB(1, 1), b3 + hstep, voffB);
            PG8_WAIT_V(6); PG8_BAR; PG8_MMA(1, 1, At, B1); PG8_BAR;
            }
        }
        if constexpr (ALIGN_EPI) { if (wr == 0) PG8_BAR; }
        if constexpr (!Epi::AFTER_DRAIN) { E(acc, cur, wr, wc, fr, fq); S.done(cur); }
        if (!has_next) break;
#pragma unroll
        for (int a = 0; a < 2; ++a)
#pragma unroll
            for (int b = 0; b < 2; ++b)
#pragma unroll
                for (int m = 0; m < 4; ++m)
#pragma unroll
                    for (int n = 0; n < 2; ++n) acc[a][b][m][n] = (f32x4){0.f, 0.f, 0.f, 0.f};
        cur = nxt; cA = nA; cB = nB; ++ui;
        if constexpr (ALIGN_EPI) { if (wr == 1) PG8_BAR; }
    }
    PG8_WAIT_V(0);
    if constexpr (!ALIGN_EPI) { if (wr == 0) PG8_BAR; }
    PG8_BAR;
    if constexpr (Epi::AFTER_DRAIN) { E.fused(acc, cur, wr, wc, fr, fq, lds, wid, lane); S.done(cur); }
#undef PG8_SA
#undef PG8_SB
#undef PG8_STAGE
#undef PG8_LDA
#undef PG8_LDB
#undef PG8_MMA
#undef PG8_WAIT_V
#undef PG8_WAIT_L
#undef PG8_BAR
#undef PG8_SCHED
}
}
#define GAS __attribute__((address_space(1)))
#define LAS __attribute__((address_space(3)))
typedef unsigned short bf16;
typedef unsigned v4u __attribute__((ext_vector_type(4)));
typedef float f32x4 __attribute__((ext_vector_type(4)));
typedef short bf16x8 __attribute__((ext_vector_type(8)));
typedef GAS unsigned gu32;
typedef GAS unsigned long long gu64;
#define RLX_AGENT __ATOMIC_RELAXED, __HIP_MEMORY_SCOPE_AGENT
#define LDS_WAIT() asm volatile("s_waitcnt lgkmcnt(0)" ::: "memory")
#define VM_WAIT() asm volatile("s_waitcnt vmcnt(0)" ::: "memory")
__device__ __forceinline__ unsigned long long rt() { return __builtin_amdgcn_s_memrealtime(); }
__device__ __forceinline__ unsigned f2bf(float f) { unsigned u = __builtin_bit_cast(unsigned, f); return (u + 0x7fffu + ((u >> 16) & 1u)) >> 16; }
__device__ __forceinline__ unsigned pk2(float lo, float hi) { return f2bf(lo) | (f2bf(hi) << 16); }
#define XB_TMO      128
#define XB_XCNT(j)  (256  + 64 * (j))
#define XB_XSUB(j)  (1280 + 64 * (j))
#define XB_XGEN(j)  (2304 + 64 * (j))
#define XB_TOP      3328
#define XB_TOPGEN   3392
#define XCD_BAR_WORDS 3456
#define XB_SPIN_CAP (1u << 18)

__device__ __forceinline__ unsigned xb_ld(unsigned* p)              { return __hip_atomic_load(p, __ATOMIC_RELAXED, __HIP_MEMORY_SCOPE_AGENT); }
__device__ __forceinline__ unsigned xb_add(unsigned* p, unsigned v) { return __hip_atomic_fetch_add(p, v, __ATOMIC_RELAXED, __HIP_MEMORY_SCOPE_AGENT); }
__device__ __forceinline__ unsigned xb_xcc_id() { return (unsigned)__builtin_amdgcn_s_getreg((3 << 11) | 20) & 0xFu; }
#define XB_SPIN(cond, bar) do { unsigned _sp = 0; while (cond) { __builtin_amdgcn_s_sleep(1); \
    if ((++_sp & 255u) == 0u) { if (xb_ld(&(bar)[XB_TMO])) break; if (_sp > XB_SPIN_CAP) { atomicAdd(&(bar)[XB_TMO], 1u); break; } } } } while (0)

struct XcdBarrier {
    unsigned* bar; unsigned x;
    volatile LAS unsigned* st;
};

__device__ __forceinline__ XcdBarrier xcd_barrier_post(unsigned* bar, volatile LAS unsigned* st) {
    XcdBarrier b; b.bar = bar; b.x = xb_xcc_id(); b.st = st;
    if (threadIdx.x == 0) (void)xb_add(&bar[XB_XCNT(b.x)], 1u);
    return b;
}
__device__ __forceinline__ void xcd_barrier_complete(unsigned* bar, unsigned x, unsigned& nloc, unsigned& nx) {
    const unsigned G = gridDim.x * gridDim.y * gridDim.z;
    unsigned sum, cnt, mine, sp = 0u;
    for (;;) {
        sum = 0u; cnt = 0u; mine = 0u;
#pragma unroll
        for (unsigned j = 0; j < 16; ++j) { const unsigned c = xb_ld(&bar[XB_XCNT(j)]); sum += c; cnt += (c > 0u) ? 1u : 0u; mine = (j == x) ? c : mine; }
        if (sum == G) break;
        __builtin_amdgcn_s_sleep(1);
        if ((++sp & 255u) == 0u) { if (xb_ld(&bar[XB_TMO])) break; if (sp > XB_SPIN_CAP) { atomicAdd(&bar[XB_TMO], 1u); break; } }
    }
    nloc = mine > 0u ? mine : 1u; nx = cnt > 0u ? cnt : 1u;
}

__device__ __forceinline__ void xcd_barrier(const XcdBarrier& b) {
    asm volatile("s_waitcnt vmcnt(0)" ::: "memory");
    __syncthreads();
    if (threadIdx.x == 0) {
        unsigned* bar = b.bar;
        __builtin_amdgcn_s_waitcnt(0);
        unsigned nloc = b.st[0], nx = b.st[1];
        if (nloc == 0u) { xcd_barrier_complete(bar, b.x, nloc, nx); b.st[0] = nloc; b.st[1] = nx; }
        const unsigned old = xb_add(&bar[XB_XSUB(b.x)], 1u);
        const unsigned gen = old / nloc;
        if (old + 1u == (gen + 1u) * nloc) {
            __builtin_amdgcn_fence(__ATOMIC_RELEASE, "agent");
            asm volatile("s_waitcnt vmcnt(0)" ::: "memory");
            const unsigned og = xb_add(&bar[XB_TOP], 1u);
            const unsigned tg = og / nx;
            if (og + 1u == (tg + 1u) * nx) xb_add(&bar[XB_TOPGEN], 1u);
            else XB_SPIN(xb_ld(&bar[XB_TOPGEN]) == tg, bar);
            __builtin_amdgcn_fence(__ATOMIC_ACQUIRE, "agent");
            xb_add(&bar[XB_XGEN(b.x)], 1u);
            asm volatile("s_waitcnt vmcnt(0)" ::: "memory");
        } else {
            XB_SPIN(xb_ld(&bar[XB_XGEN(b.x)]) == gen, bar);
            __builtin_amdgcn_fence(__ATOMIC_ACQUIRE, "agent");
            asm volatile("s_waitcnt vmcnt(0)" ::: "memory");
        }
    }
    __syncthreads();
}
namespace wa {
typedef unsigned short u16;
typedef short bf16x8 __attribute__((ext_vector_type(8)));
typedef short s16x4 __attribute__((ext_vector_type(4)));
typedef float f32x16 __attribute__((ext_vector_type(16)));
typedef unsigned u32x4 __attribute__((ext_vector_type(4)));
typedef __attribute__((address_space(3))) unsigned char* lptr;
#define WA_LAS __attribute__((address_space(3)))
__device__ __forceinline__ int crow(int r, int hi) { return (r & 3) + 8 * (r >> 2) + 4 * hi; }
typedef float f32x2_t __attribute__((ext_vector_type(2))); typedef __bf16 bf16x2_t __attribute__((ext_vector_type(2)));
__device__ __forceinline__ unsigned cvtpk(float lo, float hi) { f32x2_t v = {lo, hi}; bf16x2_t b = __builtin_convertvector(v, bf16x2_t); return __builtin_bit_cast(unsigned, b); }
__device__ __forceinline__ float bflo(unsigned w) { return __builtin_bit_cast(float, w << 16); }
__device__ __forceinline__ float bfhi(unsigned w) { return __builtin_bit_cast(float, w & 0xffff0000u); }

struct TileRegs { u32x4 k[8], v[8]; };
constexpr unsigned PITCH = 2304;
__device__ __forceinline__ void tile_load(TileRegs& t, const u16* Kp, const u16* Vp, unsigned koff, unsigned voff) {
#pragma unroll
    for (int i = 0; i < 8; ++i) t.k[i] = *(const u32x4*)(Kp + (size_t)(8 * i) * PITCH + koff);
#pragma unroll
    for (int pc = 0; pc < 8; ++pc) t.v[pc] = *(const u32x4*)(Vp + (size_t)(16 * (pc & 3)) * PITCH + (pc >> 2) * 32 + voff);
}
__device__ __forceinline__ void tile_store(const TileRegs& t, lptr slot, int lane) {
#pragma unroll
    for (int i = 0; i < 8; ++i) *(WA_LAS u32x4*)(slot + (lane & 7) * 1024 + (8 * i + (lane >> 3)) * 16) = t.k[i];
#pragma unroll
    for (int pc = 0; pc < 8; ++pc) *(WA_LAS u32x4*)(slot + 8192 + pc * 1024 + lane * 16) = t.v[pc];
}
__device__ __forceinline__ void qkt(f32x16& p0, f32x16& p1, lptr slot, const bf16x8 (&qr)[4], int r32, int hi) {
    const lptr kb = slot + hi * 1024 + r32 * 16;
    const f32x16 z = {0.f, 0.f, 0.f, 0.f, 0.f, 0.f, 0.f, 0.f, 0.f, 0.f, 0.f, 0.f, 0.f, 0.f, 0.f, 0.f};
    p0 = z; p1 = z;
#pragma unroll
    for (int d0 = 0; d0 < 4; ++d0) {
        const bf16x8 b0 = *(const WA_LAS bf16x8*)(kb + d0 * 2048);
        const bf16x8 b1 = *(const WA_LAS bf16x8*)(kb + d0 * 2048 + 512);
        p0 = __builtin_amdgcn_mfma_f32_32x32x16_bf16(b0, qr[d0], p0, 0, 0, 0);
        p1 = __builtin_amdgcn_mfma_f32_32x32x16_bf16(b1, qr[d0], p1, 0, 0, 0);
    }
}
typedef short v4i16_t __attribute__((ext_vector_type(4)));
__device__ __forceinline__ s16x4 vtr(lptr p) { return __builtin_bit_cast(s16x4, __builtin_amdgcn_ds_read_tr16_b64_v4i16((WA_LAS v4i16_t*)p)); }
__device__ __forceinline__ void pv(f32x16 (&o)[2], lptr slot, const u32x4 (&pw)[4], int lane) {
    const int hi = lane >> 5;
    const lptr vb = slot + 8192 + ((lane >> 4) & 1) * 32 + (lane & 3) * 8 + (4 * hi + ((lane & 15) >> 2)) * 64;
#pragma unroll
    for (int d0 = 0; d0 < 2; ++d0)
#pragma unroll
        for (int ks = 0; ks < 4; ++ks) {
            const s16x4 lo = vtr(vb + d0 * 4096 + ks * 1024), hh = vtr(vb + d0 * 4096 + ks * 1024 + 512);
            const bf16x8 vf = (bf16x8){lo[0], lo[1], lo[2], lo[3], hh[0], hh[1], hh[2], hh[3]};
            o[d0] = __builtin_amdgcn_mfma_f32_32x32x16_bf16(__builtin_bit_cast(bf16x8, pw[ks]), vf, o[d0], 0, 0, 0);
        }
}
__device__ __forceinline__ void xhalf(float mine, float& other) {
    unsigned x = __builtin_bit_cast(unsigned, mine), y = x; asm volatile("" : "+v"(y));
    auto rr = __builtin_amdgcn_permlane32_swap(x, y, false, false);
    const unsigned lo = rr[0], hi = rr[1];
    other = __builtin_bit_cast(float, (__builtin_amdgcn_mbcnt_hi(~0u, __builtin_amdgcn_mbcnt_lo(~0u, 0u)) < 32u) ? hi : lo);
}
__device__ __forceinline__ float rowmax(const f32x16& p0, const f32x16& p1) {
    float a = fmaxf(p0[0], p1[0]);
#pragma unroll
    for (int r = 1; r < 16; ++r) a = fmaxf(a, fmaxf(p0[r], p1[r]));
    float other; xhalf(a, other);
    return fmaxf(a, other);
}
struct State { f32x16 o[2]; float m, l; };
__device__ __forceinline__ void sm_pv(State& st, f32x16& p0, f32x16& p1, lptr slot, WA_LAS float* wsf, int lane) {
    const int r32 = lane & 31, hi = lane >> 5;
    const float rm = rowmax(p0, p1);
    const float mnew = fmaxf(st.m, rm);
    const float ms = (mnew == -INFINITY) ? 0.f : mnew;
    const float alpha = __builtin_amdgcn_exp2f(st.m - ms);
    st.m = mnew;
    float ps = 0.f;
#pragma unroll
    for (int r = 0; r < 16; ++r) { p0[r] = __builtin_amdgcn_exp2f(p0[r] - ms); p1[r] = __builtin_amdgcn_exp2f(p1[r] - ms); ps += p0[r] + p1[r]; }
    st.l = st.l * alpha + ps;
    if (!__all(alpha == 1.0f)) {
        if (hi == 0) wsf[r32] = alpha;
#pragma unroll
        for (int r = 0; r < 16; ++r) { const float f = wsf[crow(r, hi)]; st.o[0][r] *= f; st.o[1][r] *= f; }
    }
    u32x4 pw[4];
#pragma unroll
    for (int i = 0; i < 4; ++i) { pw[0][i] = cvtpk(p0[2 * i], p0[2 * i + 1]); pw[1][i] = cvtpk(p0[8 + 2 * i], p0[9 + 2 * i]); pw[2][i] = cvtpk(p1[2 * i], p1[2 * i + 1]); pw[3][i] = cvtpk(p1[8 + 2 * i], p1[9 + 2 * i]); }
    pv(st.o, slot, pw, lane);
}
__device__ __forceinline__ void row_recip(const State& st, float (&rl)[16], WA_LAS float* wsf, int lane) {
    const int r32 = lane & 31, hi = lane >> 5;
    float other; xhalf(st.l, other);
    const float lt = st.l + other;
    if (hi == 0) wsf[32 + r32] = lt;
#pragma unroll
    for (int r = 0; r < 16; ++r) rl[r] = 1.0f / wsf[32 + crow(r, hi)];
}
__device__ __forceinline__ void store_mul(const State& st, const float (&rl)[16], u16* Yp, lptr stg_, int lane) {
    const int r32 = lane & 31, hi = lane >> 5; WA_LAS u16* stg = (WA_LAS u16*)stg_;
#pragma unroll
    for (int r = 0; r < 16; ++r) { const int orow = crow(r, hi);
#pragma unroll
        for (int d0 = 0; d0 < 2; ++d0) stg[orow * 64 + d0 * 32 + r32] = (u16)(cvtpk(st.o[d0][r] * rl[r], 0.f) & 0xffffu); }
    asm volatile("s_waitcnt lgkmcnt(0)" ::: "memory");
#pragma unroll
    for (int i = 0; i < 4; ++i) { const int row = i * 8 + (lane >> 3), ch = lane & 7;
        const u32x4 a = *(const WA_LAS u32x4*)(stg + row * 64 + ch * 8); u32x4* gp = (u32x4*)(Yp + (size_t)row * 1024 + ch * 8); const u32x4 y = *gp; u32x4 w;
#pragma unroll
        for (int e = 0; e < 4; ++e) w[e] = cvtpk(bflo(a[e]) * bflo(y[e]), bfhi(a[e]) * bfhi(y[e]));
        *gp = w; }
}

struct SpecPlain {
    const u16 *K, *V; int n;
    __device__ __forceinline__ int nt() const { return n; }
    __device__ __forceinline__ void tile(int j, const u16*& Kp, const u16*& Vp) const { Kp = K + (size_t)(64 * j) * PITCH; Vp = V + (size_t)(64 * j) * PITCH; }
    __device__ __forceinline__ void mask(int, f32x16&, f32x16&, int) const {}
};
struct SpecNA {
    const u16 *K, *V;
    int r, rs, c, cs; const WA_LAS float* bias;
    __device__ __forceinline__ int nt() const { return 12; }
    __device__ __forceinline__ void tile(int j, const u16*& Kp, const u16*& Vp) const { const int row = (j < 8) ? 64 * (rs + j) : 8192 + 64 * (j - 8); Kp = K + (size_t)row * PITCH; Vp = V + (size_t)row * PITCH; }
    __device__ __forceinline__ void mask(int j, f32x16& p0, f32x16& p1, int hi) const {
        if (j >= 8) return;
        const int base = (rs + j - r + 7) * 31 + 15 - c;
#pragma unroll
        for (int rr = 0; rr < 16; ++rr) {
            const int k0 = crow(rr, hi), k1 = k0 + 32;
            const bool v0 = (k0 >= cs) && (k0 <= cs + 15), v1 = (k1 >= cs) && (k1 <= cs + 15);
            const float b0 = bias[v0 ? base + k0 : 0], b1 = bias[v1 ? base + k1 : 0];
            p0[rr] = v0 ? p0[rr] + b0 : -INFINITY; p1[rr] = v1 ? p1[rr] + b1 : -INFINITY;
        }
    }
};
struct SpecWin {
    const u16 *K, *V; int ks0, nw, q;
    __device__ __forceinline__ int nt() const { return nw + 4; }
    __device__ __forceinline__ void tile(int j, const u16*& Kp, const u16*& Vp) const { const int row = (j < nw) ? ks0 + 64 * j : 8192 + 64 * (j - nw); Kp = K + (size_t)row * PITCH; Vp = V + (size_t)row * PITCH; }
    __device__ __forceinline__ void mask(int j, f32x16& p0, f32x16& p1, int hi) const {
        if (j >= nw) return;
#ifdef NOMASK_D
        return;
#endif
        const int kb = ks0 + 64 * j - q;
#pragma unroll
        for (int rr = 0; rr < 16; ++rr) { const int d0 = kb + crow(rr, hi), d1 = d0 + 32;
            if (d0 < -128 || d0 > 128) p0[rr] = -INFINITY; if (d1 < -128 || d1 > 128) p1[rr] = -INFINITY; }
    }
};
template <class Spec>
__device__ __forceinline__ void run(const Spec& sp, const u16* Qp, State& st, lptr slot, WA_LAS float* wsf, int lane, float* dumpS = nullptr, bool ksel = true) {
    const int r32 = lane & 31, hi = lane >> 5;
    bf16x8 qr[4];
#pragma unroll
    for (int d0 = 0; d0 < 4; ++d0) qr[d0] = *(const bf16x8*)(Qp + d0 * 16 + hi * 8);
    const f32x16 z = {0.f, 0.f, 0.f, 0.f, 0.f, 0.f, 0.f, 0.f, 0.f, 0.f, 0.f, 0.f, 0.f, 0.f, 0.f, 0.f};
    st.o[0] = z; st.o[1] = z;
    const int nt = sp.nt();
    TileRegs tr; const u16 *Kp, *Vp;
    const unsigned koff = (unsigned)(lane >> 3) * PITCH + (lane & 7) * 8, voff = (unsigned)(lane >> 2) * PITCH + (lane & 3) * 8;
#ifndef NOPF
    sp.tile(0, Kp, Vp); tile_load(tr, Kp, Vp, koff, voff);
#endif
    for (int j = 0; j < nt; ++j) {
#ifdef NOPF
        sp.tile(j, Kp, Vp); tile_load(tr, Kp, Vp, koff, voff);
        asm volatile("s_waitcnt vmcnt(0) lgkmcnt(0)" ::: "memory");
#endif
        tile_store(tr, slot, lane);
        asm volatile("" ::: "memory");
#ifdef NOPF
        asm volatile("s_waitcnt vmcnt(0) lgkmcnt(0)" ::: "memory");
#else
        if (j + 1 < nt) { sp.tile(j + 1, Kp, Vp); tile_load(tr, Kp, Vp, koff, voff); }
#endif
        f32x16 p0, p1;
        qkt(p0, p1, slot, qr, r32, hi);
#ifdef DUMP_S
        if (dumpS && j == 0) {
#pragma unroll
            for (int r = 0; r < 16; ++r) { dumpS[(size_t)r32 * 64 + crow(r, hi)] = p0[r]; dumpS[(size_t)r32 * 64 + 32 + crow(r, hi)] = p1[r]; }
        }
#endif
#ifdef UNIFORM_P
        p0 = p0 * 0.f; p1 = p1 * 0.f;
#endif
#ifdef KSEL
        if (ksel)
#pragma unroll
        for (int r = 0; r < 16; ++r) { if (crow(r, hi) != (KSEL)) p0[r] = -INFINITY; if (crow(r, hi) + 32 != (KSEL)) p1[r] = -INFINITY; }
#endif
        sp.mask(j, p0, p1, hi);
        sm_pv(st, p0, p1, slot, wsf, lane);
        asm volatile("" ::: "memory");
    }
}
}
namespace sc {
typedef unsigned short u16;
typedef unsigned u32x4 __attribute__((ext_vector_type(4)));
__device__ __forceinline__ float wsum(float v) {
#pragma unroll
    for (int o = 1; o < 64; o <<= 1) v += __shfl_xor(v, o);
    return v;
}
__device__ __forceinline__ float wmax(float v) {
#pragma unroll
    for (int o = 1; o < 64; o <<= 1) v = fmaxf(v, __shfl_xor(v, o));
    return v;
}
__device__ __forceinline__ void unpack8(const u32x4 w, float* f) {
#pragma unroll
    for (int e = 0; e < 4; ++e) { f[2 * e] = __builtin_bit_cast(float, w[e] << 16); f[2 * e + 1] = __builtin_bit_cast(float, w[e] & 0xffff0000u); }
}
template <int NS, class KeyFn>
__device__ __forceinline__ float row_attn(const u16* Qp, const u16* Kb, const u16* Vb, const KeyFn& kf, float sink_l2, int lane) {
    const float qd = __builtin_bit_cast(float, (unsigned)Qp[lane] << 16);
    float s[NS]; float mx = sink_l2;
#pragma unroll
    for (int i = 0; i < NS; ++i) {
        s[i] = -INFINITY;
        for (int kk = 0; kk < 64; ++kk) {
            int row; float bias; const bool ok = kf(64 * i + kk, row, bias);
            if (ok) { const float kd = __builtin_bit_cast(float, (unsigned)Kb[(size_t)row * 2304 + lane] << 16); float sc_ = wsum(qd * kd) + bias;
#ifdef UNIFORM_P
                sc_ = 0.f;
#endif
#ifdef KSEL
                if (kk != (KSEL)) sc_ = -INFINITY;
#endif
                if (lane == kk) s[i] = sc_; }
        }
        mx = fmaxf(mx, s[i]);
    }
    mx = wmax(mx);
    float l = 0.f, o = 0.f;
#pragma unroll
    for (int i = 0; i < NS; ++i) {
        float p = __builtin_amdgcn_exp2f(s[i] - mx); l += p;
#ifdef SC_PBF
        { unsigned u = __builtin_bit_cast(unsigned, p); u = (u + 0x7fffu + ((u >> 16) & 1u)) & 0xffff0000u; p = __builtin_bit_cast(float, u); }
#endif
        for (int kk = 0; kk < 64; ++kk) {
            int row; float bias; const bool ok = kf(64 * i + kk, row, bias);
            const float pk = __shfl(p, kk);
            if (ok) o += pk * __builtin_bit_cast(float, (unsigned)Vb[(size_t)row * 2304 + lane] << 16);
        }
    }
    l = wsum(l) + __builtin_amdgcn_exp2f(sink_l2 - mx);
    return o / l;
}
}
typedef float f32x2 __attribute__((ext_vector_type(2)));
#ifndef KSEL_MIX
#define KSEL_MIX 0
#endif
constexpr int NB = 4, SEQ = 8192, CTXL = 256, DM = 1024, SE = SEQ + CTXL, RT = NB * SE, NIN = 3328, NQKV = 2304;
constexpr float LOG2E = 1.4426950408889634f, LAM0 = 0.35550906759f;
constexpr size_t MiB = 1u << 20;
constexpr size_t WS_CTL = 0, CTL_ZERO_BYTES = 1 * MiB;
constexpr size_t WS_MOD = 1 * MiB;
constexpr size_t WS_ROPE = 1 * MiB + 256 * 1024;
constexpr size_t WS_WIN0 = 2 * MiB, WS_WIN1 = 10 * MiB;
constexpr size_t WS_WOUT0 = 18 * MiB, WS_WOUT1 = 20 * MiB;
constexpr size_t WS_XC1 = 24 * MiB;
constexpr size_t WS_H = 32 * MiB;
constexpr size_t WS_Y = 100 * MiB;
constexpr size_t WS_QKV = 168 * MiB;
constexpr size_t WS_OC = 320 * MiB;
constexpr size_t WS_END = 448 * MiB;
static_assert(WS_H + (size_t)RT * DM * 2 <= WS_Y && WS_Y + (size_t)RT * DM * 2 <= WS_QKV && WS_QKV + (size_t)RT * NQKV * 2 <= WS_OC && WS_OC + (size_t)32768 * 1024 * 4 <= WS_END, "ws map");
constexpr int CW_BAR = 4096;
constexpr int RING_BYTES = 131072, SCR_OFF = RING_BYTES, BIAS_OFF = SCR_OFF + 2048, LDSCTL_OFF = 148480, MISC_OFF = LDSCTL_OFF + 320, LDS_BYTES = 152 * 1024;
static_assert(BIAS_OFF + 8 * 465 * 4 <= LDSCTL_OFF && MISC_OFF + 128 <= LDS_BYTES, "LDS map");

typedef unsigned short u16;
__device__ __forceinline__ float wave_sum(float v) {
#pragma unroll
    for (int o = 1; o < 64; o <<= 1) v += __shfl_xor(v, o);
    return v;
}
__device__ __forceinline__ void p0_transpose_item(const float* W, int K, int N, u16* WT, bool perm, LAS float* scr, int item, int lane) {
    const int nblk = N / 32, kb = item / nblk, nb = item % nblk, k0 = 64 * kb, n0 = 32 * nb;
    const int rowbase = perm ? (256 * (n0 >> 8) + 128 * ((n0 >> 5) & 1) + 32 * ((n0 >> 6) & 3)) : n0;
#pragma unroll 8
    for (int i = 0; i < 32; ++i) { const int kk = 2 * i + (lane >> 5); scr[kk * 33 + (lane & 31)] = W[(size_t)(k0 + kk) * N + n0 + (lane & 31)]; }
    LDS_WAIT(); asm volatile("" ::: "memory");
    const int c = lane & 7;
#pragma unroll
    for (int j = 0; j < 4; ++j) { const int n = (lane >> 3) + 8 * j; const LAS float* s = scr + (8 * c) * 33 + n;
        v4u o; o.x = pk2(s[0 * 33], s[1 * 33]); o.y = pk2(s[2 * 33], s[3 * 33]); o.z = pk2(s[4 * 33], s[5 * 33]); o.w = pk2(s[6 * 33], s[7 * 33]);
        *(v4u*)(WT + (size_t)(rowbase + n) * K + k0 + 8 * c) = o; }
    LDS_WAIT(); asm volatile("" ::: "memory");
}

struct Args { const float* in[17]; float* out; unsigned char* ws; };

__global__ void __launch_bounds__(512, 2) fwd_kernel(Args args) {
    extern __shared__ __attribute__((aligned(16))) unsigned char lds_raw[];
    LAS unsigned char* lds = (LAS unsigned char*)lds_raw;
    volatile LAS unsigned* MISC = (volatile LAS unsigned*)(lds + MISC_OFF);
    const int G = gridDim.x, bx = blockIdx.x, vcu = (G % 8 == 0) ? (bx % 8) * (G / 8) + bx / 8 : bx, NGW = G * 8;
#define PH_IDS KP_DECL int tid = threadIdx.x; asm volatile("" : "+v"(tid)); const int lane = tid & 63, wave = __builtin_amdgcn_readfirstlane(tid >> 6), gw = vcu * 8 + wave; (void)lane; (void)gw;
#define AS4 __attribute__((address_space(4)))
#define KP_DECL const AS4 unsigned char* kp_ = (const AS4 unsigned char*)__builtin_amdgcn_kernarg_segment_ptr(); asm volatile("" : "+s"(kp_)); unsigned char* const ws = *(unsigned char* const AS4*)(kp_ + 144); (void)ws;
#define KIN(i) (*(const float* const AS4*)(kp_ + 8 * (i)))
#define KOUT (*(float* const AS4*)(kp_ + 136))
#define W_MOD ((float*)(ws + WS_MOD))
#define W_ROPEC ((float*)(ws + WS_ROPE))
#define W_ROPES ((float*)(ws + WS_ROPE) + 128 * 16)
#define W_XC1 ((float*)(ws + WS_XC1))
#define W_H ((u16*)(ws + WS_H))
#define W_Y ((u16*)(ws + WS_Y))
#define W_QKV ((u16*)(ws + WS_QKV))
#define W_OC ((float*)(ws + WS_OC))
    (void)args;
    for (int u = threadIdx.x; u < (LDS_BYTES - LDSCTL_OFF) / 4; u += 512) ((LAS unsigned*)(lds + LDSCTL_OFF))[u] = 0u;
    __syncthreads();
    { KP_DECL (void)xcd_barrier_post((unsigned*)(ws + WS_CTL) + CW_BAR, MISC + 8); }
#ifdef USE_CG
#define GRID_BAR() do { asm volatile("s_waitcnt vmcnt(0)" ::: "memory"); __threadfence(); cooperative_groups::this_grid().sync(); __threadfence(); } while (0)
#else
#define GRID_BAR() do { KP_DECL XcdBarrier b_; b_.bar = (unsigned*)(ws + WS_CTL) + CW_BAR; b_.x = xb_xcc_id(); b_.st = MISC + 8; xcd_barrier(b_); } while (0)
#endif

#ifndef SKIP_P0
    {
        PH_IDS
        const float* cvec = KIN(1); const float* cctx = KIN(3); const float* w_mod = KIN(4); const float* b_mod = KIN(5); float* MOD = W_MOD; float* ROPEC = W_ROPEC; float* ROPES = W_ROPES;
        LAS float* sil = (LAS float*)lds;
        LAS float* part = (LAS float*)(lds + 20480);
        if (bx < 192) {
            for (int i = tid; i < 5120; i += 512) { const int v = i >> 10, k = i & 1023; const float cv = (v < 4) ? cvec[v * 1024 + k] : cctx[k]; sil[i] = cv / (1.0f + __expf(-cv)); }
            __syncthreads();
            for (int it = bx; it < 192; it += G) {
                const int layer = it / 96, n0 = (it % 96) * 32, ks = tid >> 5, cl = tid & 31;
                const float* W = w_mod + (size_t)layer * 1024 * 3072 + n0 + cl;
                float a0 = 0.f, a1 = 0.f, a2 = 0.f, a3 = 0.f, a4 = 0.f;
#pragma unroll 16
                for (int kk = 0; kk < 64; ++kk) { const int k = ks * 64 + kk; const float w = W[(size_t)k * 3072];
                    a0 += sil[k] * w; a1 += sil[1024 + k] * w; a2 += sil[2048 + k] * w; a3 += sil[3072 + k] * w; a4 += sil[4096 + k] * w; }
                part[(ks * 5 + 0) * 32 + cl] = a0; part[(ks * 5 + 1) * 32 + cl] = a1; part[(ks * 5 + 2) * 32 + cl] = a2; part[(ks * 5 + 3) * 32 + cl] = a3; part[(ks * 5 + 4) * 32 + cl] = a4;
                __syncthreads();
                if (tid < 160) { const int v = tid >> 5; float s = b_mod[layer * 3072 + n0 + cl];
#pragma unroll
                    for (int q = 0; q < 16; ++q) s += part[(q * 5 + v) * 32 + cl];
                    MOD[(size_t)(layer * 5 + v) * 3072 + n0 + cl] = s; }
                __syncthreads();
            }
        } else if (bx >= G - 4) {
            const int e = (bx - (G - 4)) * 512 + tid, pos = e >> 4, j = e & 15;
            const float inv = exp2f(-(float)j * (13.287712379549449f / 16.0f));
            const float ang = (float)pos * inv;
            ROPEC[e] = cosf(ang); ROPES[e] = sinf(ang);
        }
        __syncthreads();
        LAS float* scr = (LAS float*)(lds + wave * 16384);
        constexpr int I_IN = 16 * 104, I_OUT = 16 * 32, NITEMS = 2 * I_IN + 2 * I_OUT;
        for (int it = gw; it < NITEMS; it += NGW) {
            const float* Wsrc; u16* Wdst; int N_, r; bool perm;
            if (it < I_IN) { Wsrc = KIN(6); Wdst = (u16*)(ws + WS_WIN0); N_ = NIN; r = it; perm = true; }
            else if (it < 2 * I_IN) { Wsrc = KIN(11); Wdst = (u16*)(ws + WS_WIN1); N_ = NIN; r = it - I_IN; perm = true; }
            else if (it < 2 * I_IN + I_OUT) { Wsrc = KIN(7); Wdst = (u16*)(ws + WS_WOUT0); N_ = 1024; r = it - 2 * I_IN; perm = false; }
            else { Wsrc = KIN(12); Wdst = (u16*)(ws + WS_WOUT1); N_ = 1024; r = it - 2 * I_IN - I_OUT; perm = false; }
            p0_transpose_item(Wsrc, 1024, N_, Wdst, perm, scr, r, lane);
        }
    }
#endif
    GRID_BAR();

    for (int layer = 0; layer < 2; ++layer) {
#ifndef SKIP_H
        {
            PH_IDS
            const float* modl = W_MOD + (size_t)layer * 5 * 3072; u16* H = W_H;
            const float* xs = layer == 0 ? KIN(0) : KOUT; const float* cs = layer == 0 ? KIN(2) : W_XC1;
            for (int R = gw; R < RT; R += NGW) {
                const int b = R / SE, t = R % SE;
                const float* src; const float* mv;
                if (t < SEQ) { src = xs + ((size_t)b * SEQ + t) * DM; mv = modl + b * 3072; } else { src = cs + ((size_t)b * CTXL + (t - SEQ)) * DM; mv = modl + 4 * 3072; }
                f32x4 v[4]; float ss = 0.f;
#pragma unroll
                for (int j = 0; j < 4; ++j) { v[j] = *(const f32x4*)(src + 4 * lane + 256 * j); ss += (v[j].x * v[j].x + v[j].y * v[j].y) + (v[j].z * v[j].z + v[j].w * v[j].w); }
                const float rstd = 1.0f / sqrtf(wave_sum(ss) * (1.0f / DM) + 1e-6f);
#pragma unroll
                for (int j = 0; j < 4; ++j) { const f32x4 sh = *(const f32x4*)(mv + 4 * lane + 256 * j), sc = *(const f32x4*)(mv + 1024 + 4 * lane + 256 * j);
                    const f32x4 h = v[j] * rstd * (sc + 1.0f) + sh;
                    *(unsigned long long*)(H + (size_t)R * DM + 4 * lane + 256 * j) = (unsigned long long)pk2(h.x, h.y) | ((unsigned long long)pk2(h.z, h.w) << 32); }
            }
        }
#endif
        GRID_BAR();
#ifndef SKIP_G1
        {
            KP_DECL
            pg8::Gemm g{W_H, (const u16*)(ws + (layer == 0 ? WS_WIN0 : WS_WIN1)), RT, NIN, DM}; pg8::StaticOrder S; S.init(RT, NIN, G, bx);
            pg8::EpiQKV E{W_QKV, W_Y, W_ROPEC, W_ROPES, KIN(8), KIN(9), layer};
            pg8::gemm_phase<pg8::EpiQKV, pg8::StaticOrder, true, true>(lds, g, S, E);
        }
#endif
        GRID_BAR();
#ifndef SKIP_ATT
        {
            PH_IDS
            const u16* QKV = W_QKV; u16* Y = W_Y; float* OC = W_OC; const float* rpb = KIN(10); const float* sinks = KIN(15);
            const wa::lptr slot = lds + wave * 16384; LAS float* wsf = (LAS float*)(lds + SCR_OFF + wave * 256);
            const int r32 = lane & 31, hi = lane >> 5;
            if (layer == 0) {
                LAS float* biasT = (LAS float*)(lds + BIAS_OFF);
                for (int i = tid; i < 8 * 465; i += 512) biasT[i] = rpb[i] * LOG2E;
                __syncthreads();
                for (int u = gw; u < 16896; u += NGW) {
                    wa::State st; st.m = -INFINITY; st.l = 0.f; float rl[16];
                    if (u < 8192) {
                        const int b = u >> 11, hq = (u >> 8) & 7, qb = u & 255; const u16* base = QKV + (size_t)b * SE * NQKV;
                        wa::SpecPlain sp{base + 512 + (hq >> 2) * 64, base + 640 + (hq >> 2) * 64, 132};
                        wa::run(sp, base + (size_t)(qb * 32 + r32) * NQKV + hq * 64, st, slot, wsf, lane, nullptr, KSEL_MIX == 0);
                        wa::row_recip(st, rl, wsf, lane);
#ifdef ABL_A
                        for (int r = 0; r < 16; ++r) rl[r] = 0.f;
#endif
                        wa::store_mul(st, rl, Y + ((size_t)b * SE + qb * 32) * DM + hq * 64, slot, lane);
                    } else if (u < 16384) {
                        const int v = u - 8192, b = v >> 11, h = (v >> 8) & 7, qb = v & 255; const u16* base = QKV + (size_t)b * SE * NQKV;
                        const int r = qb >> 1, c = 32 * (qb & 1) + r32, rs = min(max(r - 4, 0), 120), cs = min(max(c - 8, 0), 48);
                        wa::SpecNA sp{base + 1280 + h * 64, base + 1792 + h * 64, r, rs, c, cs, biasT + h * 465};
                        wa::run(sp, base + (size_t)(qb * 32 + r32) * NQKV + 768 + h * 64, st, slot, wsf, lane, nullptr, KSEL_MIX == 1);
                        wa::row_recip(st, rl, wsf, lane);
#ifdef ABL_B
                        for (int r = 0; r < 16; ++r) rl[r] = 0.f;
#endif
#ifndef SC_B
                        wa::store_mul(st, rl, Y + ((size_t)b * SE + qb * 32) * DM + 512 + h * 64, slot, lane);
#endif
                    } else {
                        const int v = u - 16384, isb = v >> 8, w = v & 255, b = w >> 6, h = (w >> 3) & 7, qb = w & 7; const u16* base = QKV + ((size_t)b * SE + SEQ) * NQKV;
                        const int kc = isb ? 1280 + h * 64 : 512 + (h >> 2) * 64, vc = isb ? 1792 + h * 64 : 640 + (h >> 2) * 64, qc = isb ? 768 + h * 64 : h * 64;
                        wa::SpecPlain sp{base + kc, base + vc, 4};
                        wa::run(sp, base + (size_t)(qb * 32 + r32) * NQKV + qc, st, slot, wsf, lane, nullptr, KSEL_MIX == 2);
                        wa::row_recip(st, rl, wsf, lane);
                        wa::store_mul(st, rl, Y + ((size_t)b * SE + SEQ + qb * 32) * DM + isb * 512 + h * 64, slot, lane);
                    }
                }
            } else {
                for (int u = gw; u < 24576; u += NGW) {
                    wa::State st; float rl[16];
                    if (u < 16384) {
                        const int b = u >> 12, pp = (u >> 8) & 15, qb = u & 255, h = pp >> 2, m = (pp >> 1) & 1, vh = pp & 1; const u16* base = QKV + (size_t)b * SE * NQKV;
                        st.m = -INFINITY; st.l = 0.f;
                        wa::SpecPlain sp{base + 512 + (2 * h + m) * 64, base + 1024 + h * 128 + vh * 64, 132};
                        wa::run(sp, base + (size_t)(qb * 32 + r32) * NQKV + (2 * h + m) * 64, st, slot, wsf, lane, nullptr, KSEL_MIX == 3);
                        wa::row_recip(st, rl, wsf, lane);
                        float* op = OC + ((size_t)b * SEQ + qb * 32) * 1024 + h * 256 + m * 128 + vh * 64 + r32;
#pragma unroll
                        for (int r = 0; r < 16; ++r) { const int q = wa::crow(r, hi); op[(size_t)q * 1024] = st.o[0][r] * rl[r]; op[(size_t)q * 1024 + 32] = st.o[1][r] * rl[r]; }
                    } else {
                        const int v = u - 16384, b = v >> 11, hq = (v >> 8) & 7, qb = v & 255, t0 = qb * 32; const u16* base = QKV + (size_t)b * SE * NQKV;
                        const int first = (t0 - 128) & ~63, ilo = first < 0 ? (-first) >> 6 : 0, ihi = min(4, (SEQ - 64 - first) >> 6);
                        st.m = sinks[hq] * LOG2E; st.l = hi == 0 ? 1.0f : 0.0f;
#ifdef CTXONLY_D
                        st.m = -INFINITY; st.l = 0.f;
                        wa::SpecWin sp{base + 2048 + (hq >> 2) * 64, base + 2176 + (hq >> 2) * 64, first + 64 * ilo, 0, t0 + r32};
#else
                        wa::SpecWin sp{base + 2048 + (hq >> 2) * 64, base + 2176 + (hq >> 2) * 64, first + 64 * ilo, ihi - ilo + 1, t0 + r32};
#endif
#ifdef DUMP_S
                        wa::run(sp, base + (size_t)(t0 + r32) * NQKV + 1536 + hq * 64, st, slot, wsf, lane, b == 0 ? (float*)(ws + WS_H + 32 * MiB) + ((size_t)t0 * 8 + hq * 32) * 64 : nullptr);
#else
                        wa::run(sp, base + (size_t)(t0 + r32) * NQKV + 1536 + hq * 64, st, slot, wsf, lane, nullptr, KSEL_MIX == 4);
#endif
                        wa::row_recip(st, rl, wsf, lane);
#ifdef ABL_D
                        for (int r = 0; r < 16; ++r) rl[r] = 0.f;
#endif
#ifndef SC_D
                        wa::store_mul(st, rl, Y + ((size_t)b * SE + t0) * DM + 512 + hq * 64, slot, lane);
#endif
#ifdef DIFF_D
                        if (b == 0) { float* dp = (float*)(ws + WS_H) + (size_t)t0 * 512 + hq * 64 + r32;
                            _Pragma("unroll") for (int r = 0; r < 16; ++r) { const int q = wa::crow(r, hi); dp[(size_t)q * 512] = st.o[0][r] * rl[r]; dp[(size_t)q * 512 + 32] = st.o[1][r] * rl[r]; } }
#endif
                    }
                }
            }
#if defined(SC_B) || defined(SC_D)
            {
                const float* rpb_ = KIN(10); const float* sinks_ = KIN(15);
                for (int task = gw; task < NB * SEQ * 8; task += NGW) {
                    const int h = task & 7, row = task >> 3, b = row >> 13, t = row & 8191; const u16* base = QKV + (size_t)b * SE * NQKV;
                    float val = 0.f; bool doit = false;
#ifdef SC_B
                    if (layer == 0) {
                        const int r = t >> 6, c = t & 63, rs = min(max(r - 4, 0), 120), cs = min(max(c - 8, 0), 48);
                        auto kf = [&](int slot, int& krow, float& bias) -> bool { if (slot < 128) { const int kr = rs + (slot >> 4), kc = cs + (slot & 15); krow = kr * 64 + kc; bias = rpb_[h * 465 + (kr - r + 7) * 31 + (kc - c + 15)] * LOG2E; return true; }
                            krow = 8192 + slot - 128; bias = 0.f; return slot < 384; };
                        val = sc::row_attn<6>(base + (size_t)t * NQKV + 768 + h * 64, base + 1280 + h * 64, base + 1792 + h * 64, kf, -INFINITY, lane); doit = true;
                    }
#endif
#ifdef SC_D
                    if (layer == 1) {
                        auto kf = [&](int slot, int& krow, float& bias) -> bool { bias = 0.f; if (slot < 257) { krow = t - 128 + slot; return krow >= 0 && krow < SEQ; } krow = 8192 + slot - 257; return slot < 513; };
                        val = sc::row_attn<9>(base + (size_t)t * NQKV + 1536 + h * 64, base + 2048 + (h >> 2) * 64, base + 2176 + (h >> 2) * 64, kf, sinks_[h] * LOG2E, lane); doit = true;
                    }
#endif
                    if (doit) { u16* yp = Y + ((size_t)b * SE + t) * DM + 512 + h * 64 + lane; const float z = __builtin_bit_cast(float, (unsigned)*yp << 16); *yp = (u16)(wa::cvtpk(val * z, 0.f) & 0xffffu); }
                }
            }
#endif
        }
#endif
        GRID_BAR();
#ifdef CHK_GEMM
        if (layer == 0) {
            PH_IDS
            const u16* H = W_H; const u16* WT = (const u16*)(ws + WS_WIN0); const u16* QKV = W_QKV;
            const int c = (CHK_GEMM) * 64 + lane, tile = c >> 8, cc = c & 255, p = 256 * tile + 128 * ((cc >> 5) & 1) + 32 * (cc >> 6) + (cc & 31);
            for (int R = gw; R < RT; R += NGW) {
                float acc = 0.f;
                for (int k = 0; k < 1024; ++k) acc += __builtin_bit_cast(float, (unsigned)H[(size_t)R * 1024 + k] << 16) * __builtin_bit_cast(float, (unsigned)WT[(size_t)p * 1024 + k] << 16);
                const float got = __builtin_bit_cast(float, (unsigned)QKV[(size_t)R * NQKV + c] << 16);
                const bool badv = fabsf(got - acc) > 0.02f + 0.01f * fabsf(acc);
                const unsigned long long m = __ballot(badv);
                if (m != 0ull && lane == 0) atomicAdd((unsigned*)(ws + WS_CTL) + 64, 1u);
            }
        }
        GRID_BAR();
#endif
#ifndef DIFF_THR
#define DIFF_THR 0.05f
#endif
#ifdef DIFF_D
        if (layer == 1) {
            PH_IDS
            const u16* QKV = W_QKV; const float* sinks_ = KIN(15); const float* dbg = (const float*)(ws + WS_H);
            float md = 0.f;
            for (int task = gw; task < 8192 * 8; task += NGW) {
                const int h = task & 7, t = task >> 3; const u16* base = QKV;
#ifdef CTXONLY_D
                auto kf = [&](int slot, int& krow, float& bias) -> bool { bias = 0.f; krow = 8192 + slot; return slot < 256; };
#elif defined(NOMASK_D)
                const int t0_ = t & ~31, first_ = (t0_ - 128) & ~63, ilo_ = first_ < 0 ? (-first_) >> 6 : 0, ihi_ = min(4, (SEQ - 64 - first_) >> 6), ks0_ = first_ + 64 * ilo_, nw_ = ihi_ - ilo_ + 1;
                auto kf = [&](int slot, int& krow, float& bias) -> bool { bias = 0.f; if (slot < 320) { krow = ks0_ + slot; return slot < 64 * nw_; } krow = 8192 + slot - 320; return slot < 576; };
#else
                auto kf = [&](int slot, int& krow, float& bias) -> bool { bias = 0.f; if (slot < 257) { krow = t - 128 + slot; return krow >= 0 && krow < SEQ; } krow = 8192 + slot - 257; return slot < 513; };
#endif
                const float val = sc::row_attn<9>(base + (size_t)t * NQKV + 1536 + h * 64, base + 2048 + (h >> 2) * 64, base + 2176 + (h >> 2) * 64, kf,
#ifdef CTXONLY_D
                    -INFINITY,
#else
                    sinks_[h] * LOG2E,
#endif
                    lane);
#ifdef DUMP_S
                float sdiff = 0.f;
                { const float qd = __builtin_bit_cast(float, (unsigned)(base + (size_t)t * NQKV + 1536 + h * 64)[lane] << 16);
                  const float* ds_ = (const float*)(ws + WS_H + 32 * MiB) + ((size_t)(t & ~31) * 8 + h * 32 + (t & 31)) * 64;
                  for (int kk = 0; kk < 64; ++kk) { int row; float bias; kf(kk, row, bias); const float kd = __builtin_bit_cast(float, (unsigned)(base + 2048 + (h >> 2) * 64)[(size_t)row * 2304 + lane] << 16);
                      const float sref = sc::wsum(qd * kd); sdiff = fmaxf(sdiff, fabsf(sref - ds_[kk])); } }
#endif
                const float dd = sc::wmax(fabsf(val - dbg[(size_t)t * 512 + h * 64 + lane]));
#ifdef DUMP_S
                if (sdiff > DIFF_THR && lane == 0) {
#else
                if (dd > DIFF_THR && lane == 0) {
#endif
#if DIFF_D == 1
                    atomicAdd((unsigned*)(ws + WS_CTL) + 64, 1u);
#elif DIFF_D == 2
                    atomicMax((unsigned*)(ws + WS_CTL) + 64, (unsigned)(8191 - t));
#elif DIFF_D == 3
                    atomicMax((unsigned*)(ws + WS_CTL) + 64, (unsigned)t);
#elif DIFF_D == 4
                    atomicOr((unsigned*)(ws + WS_CTL) + 64, 1u << (t & 31));
#elif DIFF_D == 5
                    atomicOr((unsigned*)(ws + WS_CTL) + 64, (1u << h) | (1u << (8 + ((t >> 5) & 1))));
#endif
                }
                md = dd;
            }
            (void)md;
        }
        GRID_BAR();
#endif
#ifndef SKIP_CMB
        if (layer == 1) {
            PH_IDS
            const float* clam = KIN(13); const float* subln = KIN(14); const float* OC = W_OC; u16* Y = W_Y;
            float lam;
            { const float a = clam[lane] * clam[64 + lane], b2 = clam[128 + lane] * clam[192 + lane]; lam = expf(wave_sum(a)) - expf(wave_sum(b2)) + LAM0; }
            const f32x2 g2 = *(const f32x2*)(subln + 2 * lane);
            for (int row = gw; row < NB * SEQ; row += NGW) {
                const int b = row >> 13, t = row & 8191; const size_t R = (size_t)b * SE + t;
#pragma unroll
                for (int h = 0; h < 4; ++h) {
                    const float* o0 = OC + (size_t)row * 1024 + h * 256 + 2 * lane; const f32x2 a = *(const f32x2*)o0, c2 = *(const f32x2*)(o0 + 128);
                    const f32x2 v = a - c2 * lam; const float rstd = 1.0f / sqrtf(wave_sum(v.x * v.x + v.y * v.y) * (1.0f / 128.0f) + 1e-6f);
                    const f32x2 o = v * rstd * g2 * (1.0f - LAM0);
                    unsigned* yp = (unsigned*)(Y + R * DM + h * 128 + 2 * lane); const unsigned yv = *yp;
                    *yp = wa::cvtpk(o.x * wa::bflo(yv), o.y * wa::bfhi(yv));
                }
            }
            GRID_BAR();
        }
#endif
#ifndef SKIP_G2
        {
            KP_DECL
            pg8::Gemm g{W_Y, (const u16*)(ws + (layer == 0 ? WS_WOUT0 : WS_WOUT1)), RT, DM, DM}; pg8::FlexOrder S; S.init(DM, G, bx, layer);
            pg8::EpiOut E{layer == 0 ? KIN(0) : KOUT, KOUT, KIN(2), W_XC1, W_MOD + (size_t)layer * 5 * 3072};
            pg8::gemm_phase<pg8::EpiOut, pg8::FlexOrder, true, true>(lds, g, S, E);
        }
#endif
        GRID_BAR();
    }
    PH_IDS
    float* out = KOUT; const float* fnorm = KIN(16);
    const float bad = (__hip_atomic_load((unsigned*)(ws + WS_CTL) + CW_BAR + XB_TMO, __ATOMIC_RELAXED, __HIP_MEMORY_SCOPE_AGENT) != 0u) ? __builtin_nanf("") : 0.f;
#if defined(DIFF_D) || defined(CHK_GEMM)
    const float dbgv = (float)__hip_atomic_load((unsigned*)(ws + WS_CTL) + 64, __ATOMIC_RELAXED, __HIP_MEMORY_SCOPE_AGENT);
#endif
    for (int row = gw; row < NB * SEQ; row += NGW) {
        float* p = out + (size_t)row * DM; f32x4 v[4]; float ss = 0.f;
#pragma unroll
        for (int j = 0; j < 4; ++j) { v[j] = *(const f32x4*)(p + 4 * lane + 256 * j); ss += (v[j].x * v[j].x + v[j].y * v[j].y) + (v[j].z * v[j].z + v[j].w * v[j].w); }
        const float rstd = 1.0f / sqrtf(wave_sum(ss) * (1.0f / DM) + 1e-6f);
#pragma unroll
        for (int j = 0; j < 4; ++j) { const f32x4 gn = *(const f32x4*)(fnorm + 4 * lane + 256 * j); *(f32x4*)(p + 4 * lane + 256 * j) = v[j] * rstd * gn + bad; }
#if defined(DIFF_D) || defined(CHK_GEMM)
        #ifdef DIFF_COARSE
        if (row == 0 && lane == 0) p[0] = (dbgv > 30000.f ? 4000.f : dbgv > 3000.f ? 3000.f : dbgv > 300.f ? 2000.f : dbgv > 30.f ? 1000.f : dbgv > 0.f ? 500.f : 0.f) + 100.0f;
#else
        if (row == 0 && lane == 0) p[0] = dbgv + 100.0f;
#endif
#endif
    }
}

extern "C" void kernel_launch(void* const* d_in, const int* in_sizes, int n_in, void* d_out, int out_size, void* d_ws, size_t ws_size, hipStream_t stream) {
    static int grid = 0;
    if (grid == 0) {
        if (n_in != 17 || in_sizes[0] != NB * SEQ * DM || out_size != NB * SEQ * DM || ws_size < WS_END) { fprintf(stderr, "kernel_launch: unexpected shapes / workspace (n_in %d, ws %zu)\n", n_in, ws_size); grid = -1; return; }
        int dev = 0, cus = 0, per_cu = 0;
        if (hipGetDevice(&dev) != hipSuccess || hipDeviceGetAttribute(&cus, hipDeviceAttributeMultiprocessorCount, dev) != hipSuccess) { grid = -1; return; }
        if (hipFuncSetAttribute((const void*)fwd_kernel, hipFuncAttributeMaxDynamicSharedMemorySize, LDS_BYTES) != hipSuccess) { fprintf(stderr, "kernel_launch: hipFuncSetAttribute failed\n"); grid = -1; return; }
        if (hipOccupancyMaxActiveBlocksPerMultiprocessor(&per_cu, (const void*)fwd_kernel, 512, LDS_BYTES) != hipSuccess || per_cu < 1) { fprintf(stderr, "kernel_launch: occupancy query says %d blocks per CU\n", per_cu); per_cu = 1; }
        (void)hipGetLastError();
        grid = cus;
    }
    if (grid < 0) return;
    if (hipMemsetAsync((char*)d_ws + WS_CTL, 0, CTL_ZERO_BYTES, stream) != hipSuccess) { fprintf(stderr, "kernel_launch: memset failed\n"); return; }
    Args a{};
    for (int i = 0; i < 17; ++i) a.in[i] = (const float*)d_in[i];
    a.out = (float*)d_out; a.ws = (unsigned char*)d_ws;
#ifdef USE_CG
    void* kargs[] = {&a};
    hipError_t e = hipLaunchCooperativeKernel((const void*)fwd_kernel, dim3(grid), dim3(512), kargs, LDS_BYTES, stream);
    if (e != hipSuccess) fprintf(stderr, "cooperative launch failed: %s\n", hipGetErrorString(e));
#else
    hipLaunchKernelGGL(fwd_kernel, dim3(grid), dim3(512), LDS_BYTES, stream, a);
#endif
}
```

```cpp
#include <hip/hip_runtime.h>
#include <hip/hip_bf16.h>
#include <hip/hip_cooperative_groups.h>
#include <cstdio>
#include <cstdint>
#include <cmath>
namespace pg8 {
#define PG8_LAS __attribute__((address_space(3)))
typedef unsigned short bf16_t;
typedef short bf16x8 __attribute__((ext_vector_type(8)));
typedef float f32x4 __attribute__((ext_vector_type(4)));
typedef unsigned u32x4 __attribute__((ext_vector_type(4)));
constexpr int BM = 256, BK = 64, HALF = 128, HTB = HALF * BK * 2  , STAGE_BYTES = 8 * HTB, NXCD = 8, WGM = 8;

__host__ __device__ __forceinline__ int lds_byte(int r, int c) { const int st = (r >> 4) * 2 + (c >> 5), rr = r & 15, cc = c & 31, ob = rr * 64 + cc * 2; return st * 1024 + (ob ^ (((ob >> 9) & 1) << 5)); }
__host__ __device__ __forceinline__ void stage_rc(int b, int& R, int& C) { const int st = b / 1024, sb = b % 1024, swz = sb ^ (((sb >> 9) & 1) << 5); R = (st >> 1) * 16 + swz / 64; C = (st & 1) * 32 + (swz % 64) / 2; }
__host__ __device__ __forceinline__ int perm32(int rho) { const int n = rho >> 4, i = rho & 15; return 8 * (i >> 2) + 4 * n + (i & 3); }

struct Unit { int pm, pn; };
struct Gemm { const bf16_t* A; const bf16_t* Bt; int M, N, K; };

struct StaticOrder {
    int nM, nN, nwg, G, c;
    __host__ __device__ void init(int M, int N, int G_, int c_) { nM = M / BM; nN = N / BM; nwg = nM * nN; G = G_; c = c_; }
    __host__ __device__ bool next(int i, Unit& u) const {
        const long L = (long)i * G + c; if (L >= nwg) return false;
        int wgid = (int)L; { const int q = nwg / NXCD, r = nwg % NXCD, xcd = wgid % NXCD, off = wgid / NXCD; wgid = (xcd < r ? xcd * (q + 1) : r * (q + 1) + (xcd - r) * q) + off; }
        const int nig = WGM * nN, gid = wgid / nig, fm = gid * WGM, gsz = (nM - fm) < WGM ? (nM - fm) : WGM;
        u.pm = fm + ((wgid % nig) % gsz); u.pn = (wgid % nig) / gsz; return true;
    }
    __device__ __forceinline__ void a_ready(const Unit&) const {}
    __device__ __forceinline__ void done(const Unit&) const {}
};

__device__ __forceinline__ unsigned cvt_pk_bf16(float lo, float hi) { unsigned r; asm volatile("v_cvt_pk_bf16_f32 %0, %1, %2" : "=v"(r) : "v"(lo), "v"(hi)); return r; }
typedef float f32x2 __attribute__((ext_vector_type(2)));
typedef unsigned u32x2 __attribute__((ext_vector_type(2)));
constexpr float QSCALE = 0.125f * 1.4426950408889634f;
constexpr int SE = 8448, NQKV = 2304, DMODEL = 1024;

struct EpiQKV {
    static constexpr bool PERM = false, AFTER_DRAIN = false;
    bf16_t* QKV; bf16_t* Y; const float* ropec; const float* ropes; const float* gq; const float* gk; int layer;
    __device__ __forceinline__ void operator()(const f32x4 (&acc)[2][2][4][2], const Unit& u, int wr, int wc, int fr, int fq) const {
        asm volatile("" : "+v"(fr), "+v"(fq));
        const int c64 = u.pn * 4 + wc;
        int norm = 0; bool rope = false, scale = false, silu = false;
        if (layer == 0) { if (c64 < 8) { norm = 1; rope = true; scale = true; } else if (c64 < 10) { norm = 2; rope = true; } else if (c64 >= 12 && c64 < 20) scale = true; else if (c64 >= 36) silu = true; }
        else { if (c64 < 8) { rope = true; scale = true; } else if (c64 < 16) rope = true; else if (c64 >= 24 && c64 < 32) { rope = true; scale = true; } else if (c64 >= 32 && c64 < 34) rope = true; else if (c64 >= 36) silu = true; }
        const int pmb = u.pm % 33; const bool isctx = (pmb == 32); if (isctx) rope = false;
        const float* gain = (norm == 1) ? gq : gk;
#pragma unroll
        for (int ai = 0; ai < 2; ++ai) {
            const int pr = pmb * 4 + ai * 2 + wr;
#pragma unroll
            for (int m = 0; m < 4; ++m) {
                const size_t R = (size_t)u.pm * 256 + ai * 128 + wr * 64 + m * 16 + fr;
                f32x4 v[2][2];
#pragma unroll
                for (int bj = 0; bj < 2; ++bj)
#pragma unroll
                    for (int n = 0; n < 2; ++n) v[bj][n] = acc[ai][bj][m][n];
                if (norm) {
                    float ss = 0.f;
#pragma unroll
                    for (int bj = 0; bj < 2; ++bj)
#pragma unroll
                        for (int n = 0; n < 2; ++n) { const f32x4 x = v[bj][n]; ss += (x[0] * x[0] + x[1] * x[1]) + (x[2] * x[2] + x[3] * x[3]); }
                    ss += __shfl_xor(ss, 16); ss += __shfl_xor(ss, 32);
                    const float rs = 1.0f / sqrtf(ss * (1.0f / 64.0f) + 1e-6f);
#pragma unroll
                    for (int bj = 0; bj < 2; ++bj)
#pragma unroll
                        for (int n = 0; n < 2; ++n) v[bj][n] = v[bj][n] * rs * *(const f32x4*)(gain + 32 * bj + 16 * n + 4 * fq);
                }
                if (rope) {
                    const int pc = m * 16 + fr;
                    const f32x4 cr = *(const f32x4*)(ropec + pr * 16 + 4 * fq), sr = *(const f32x4*)(ropes + pr * 16 + 4 * fq);
                    const f32x4 cc = *(const f32x4*)(ropec + pc * 16 + 4 * fq), sc = *(const f32x4*)(ropes + pc * 16 + 4 * fq);
                    f32x4 x1 = v[0][0], x2 = v[0][1]; v[0][0] = x1 * cr - x2 * sr; v[0][1] = x1 * sr + x2 * cr;
                    x1 = v[1][0]; x2 = v[1][1]; v[1][0] = x1 * cc - x2 * sc; v[1][1] = x1 * sc + x2 * cc;
                }
                if (scale) {
#pragma unroll
                    for (int bj = 0; bj < 2; ++bj)
#pragma unroll
                        for (int n = 0; n < 2; ++n) v[bj][n] = v[bj][n] * QSCALE;
                }
                bf16_t* dst;
                if (silu) {
#pragma unroll
                    for (int bj = 0; bj < 2; ++bj)
#pragma unroll
                        for (int n = 0; n < 2; ++n)
#pragma unroll
                            for (int e = 0; e < 4; ++e) { const float x = v[bj][n][e]; v[bj][n][e] = x * __builtin_amdgcn_rcpf(1.0f + __builtin_amdgcn_exp2f(-1.4426950408889634f * x)); }
                    dst = Y + R * DMODEL + (size_t)(c64 - 36) * 64 + 4 * fq;
                } else dst = QKV + R * NQKV + (size_t)c64 * 64 + 4 * fq;
#pragma unroll
                for (int bj = 0; bj < 2; ++bj)
#pragma unroll
                    for (int n = 0; n < 2; ++n) { u32x2 w; w.x = cvt_pk_bf16(v[bj][n][0], v[bj][n][1]); w.y = cvt_pk_bf16(v[bj][n][2], v[bj][n][3]); *(u32x2*)(dst + 32 * bj + 16 * n) = w; }
                asm volatile("" ::: "memory");
            }
        }
    }
};

struct EpiOut {
    static constexpr bool PERM = false, AFTER_DRAIN = false;
    const float* xin; float* xout; const float* cin; float* cout; const float* mod;
    __device__ __forceinline__ void operator()(const f32x4 (&acc)[2][2][4][2], const Unit& u, int wr, int wc, int fr, int fq) const {
        asm volatile("" : "+v"(fr), "+v"(fq));
        const int pmb = u.pm % 33, b = u.pm / 33; const bool isctx = (pmb == 32);
        const float* src; float* dst; const float* gate;
        if (isctx) { src = cin + (size_t)b * 256 * DMODEL; dst = cout + (size_t)b * 256 * DMODEL; gate = mod + 4 * 3072 + 2048; }
        else { const size_t o = ((size_t)b * 8192 + (size_t)pmb * 256) * DMODEL; src = xin + o; dst = xout + o; gate = mod + b * 3072 + 2048; }
        const int col0 = u.pn * BM + wc * 32 + 4 * fq;
        f32x4 g[2][2];
#pragma unroll
        for (int bj = 0; bj < 2; ++bj)
#pragma unroll
            for (int n = 0; n < 2; ++n) g[bj][n] = *(const f32x4*)(gate + col0 + bj * HALF + n * 16);
#pragma unroll
        for (int ai = 0; ai < 2; ++ai)
#pragma unroll
            for (int m = 0; m < 4; ++m) { const size_t off = (size_t)(ai * HALF + wr * 64 + m * 16 + fr) * DMODEL + col0;
#pragma unroll
                for (int bj = 0; bj < 2; ++bj)
#pragma unroll
                    for (int n = 0; n < 2; ++n) { const f32x4 xo = *(const f32x4*)(src + off + bj * HALF + n * 16); *(f32x4*)(dst + off + bj * HALF + n * 16) = xo + g[bj][n] * acc[ai][bj][m][n]; }
                asm volatile("" ::: "memory"); }
    }
};
struct FlexOrder {
    StaticOrder base; int latent_only;
    __device__ void init(int N, int G_, int c_, int latent_only_) { latent_only = latent_only_; base.init(latent_only_ ? 4 * 8192 : 4 * SE, N, G_, c_); }
    __device__ bool next(int i, Unit& u) const { if (!base.next(i, u)) return false; if (latent_only) u.pm += u.pm >> 5; return true; }
    __device__ __forceinline__ void a_ready(const Unit&) const {}
    __device__ __forceinline__ void done(const Unit&) const {}
};
template <class Epi, class Sched, bool ALIGN_EPI = false, bool SP2 = false>
__device__ __forceinline__ void gemm_phase(PG8_LAS unsigned char* lds, const Gemm g, const Sched& S, const Epi& E) {
    int tid_ = threadIdx.x; asm volatile("" : "+v"(tid_));
    const int tid = tid_, wid = __builtin_amdgcn_readfirstlane(tid >> 6), lane = tid & 63, wr = wid >> 2, wc = wid & 3, fr = lane & 15, fq = lane >> 4;
    const int K = g.K, nt = K / BK;
    unsigned voffA[2], voffB[2];
#pragma unroll
    for (int i = 0; i < 2; ++i) { int R, C; stage_rc(tid * 16 + i * 8192, R, C); const int Rb = Epi::PERM ? ((R & ~31) + perm32(R & 31)) : R;
        voffA[i] = (unsigned)(R * K + C) * 2u; voffB[i] = (unsigned)(Rb * K + C) * 2u; }
    const size_t kstep = (size_t)(BK * 2);
    const size_t hstep = (size_t)HALF * K * 2;
    const size_t tstep = 2 * hstep;
    const unsigned ldsw = (unsigned)wid * 1024u;
    const int aoff = lds_byte(wr * 64 + fr, fq * 8), boff = lds_byte(wc * 32 + fr, fq * 8);
#define PG8_SA(b, h) (((b) * 2 + (h)) * HTB)
#define PG8_SB(b, h) ((4 + (b) * 2 + (h)) * HTB)
#define PG8_STAGE(bufoff, gbase, voff) do { _Pragma("unroll") for (int _i = 0; _i < 2; ++_i) \
        __builtin_amdgcn_global_load_lds((const unsigned*)((const char*)(gbase) + (voff)[_i]), (PG8_LAS unsigned*)(lds + (bufoff) + ldsw + _i * 8192), 16, 0, 0); } while (0)
#define PG8_LDA(dst, b, h) do { _Pragma("unroll") for (int m = 0; m < 4; ++m) _Pragma("unroll") for (int k = 0; k < 2; ++k) dst[m][k] = *(const PG8_LAS bf16x8*)(lds + PG8_SA(b, h) + aoff + m * 2048 + k * 1024); } while (0)
#define PG8_LDB(dst, b, h) do { _Pragma("unroll") for (int n = 0; n < 2; ++n) _Pragma("unroll") for (int k = 0; k < 2; ++k) dst[n][k] = *(const PG8_LAS bf16x8*)(lds + PG8_SB(b, h) + boff + n * 2048 + k * 1024); } while (0)
#define PG8_MMA(ai, bj, At, Bt) do { __builtin_amdgcn_s_setprio(1); _Pragma("unroll") for (int m = 0; m < 4; ++m) _Pragma("unroll") for (int n = 0; n < 2; ++n) _Pragma("unroll") for (int k = 0; k < 2; ++k) \
        acc[ai][bj][m][n] = __builtin_amdgcn_mfma_f32_16x16x32_bf16(Bt[n][k], At[m][k], acc[ai][bj][m][n], 0, 0, 0); __builtin_amdgcn_s_setprio(0); } while (0)
#define PG8_WAIT_V(n) asm volatile("s_waitcnt vmcnt(" #n ")" ::: "memory")
#define PG8_WAIT_L(n) asm volatile("s_waitcnt lgkmcnt(" #n ")" ::: "memory")
#define PG8_BAR __builtin_amdgcn_s_barrier()
#define PG8_SCHED __builtin_amdgcn_sched_barrier(0)
    Unit cur, nxt; int ui = 0;
    if (!S.next(0, cur)) return;
    f32x4 acc[2][2][4][2];
#pragma unroll
    for (int a = 0; a < 2; ++a)
#pragma unroll
        for (int b = 0; b < 2; ++b)
#pragma unroll
            for (int m = 0; m < 4; ++m)
#pragma unroll
                for (int n = 0; n < 2; ++n) acc[a][b][m][n] = (f32x4){0.f, 0.f, 0.f, 0.f};
    bf16x8 At[4][2], B0[2][2], B1[2][2];
    const char* cA = (const char*)g.A + (size_t)cur.pm * tstep; const char* cB = (const char*)g.Bt + (size_t)cur.pn * tstep;
    S.a_ready(cur);
    if constexpr (SP2) {
        PG8_STAGE(PG8_SB(0, 0), cB, voffB); PG8_STAGE(PG8_SB(0, 1), cB + hstep, voffB); PG8_STAGE(PG8_SA(0, 0), cA, voffA); PG8_STAGE(PG8_SA(0, 1), cA + hstep, voffA);
        if (wr == 1) PG8_BAR;
        PG8_WAIT_V(2); PG8_BAR;
        PG8_STAGE(PG8_SB(1, 0), cB + kstep, voffB); PG8_STAGE(PG8_SA(1, 0), cA + kstep, voffA); PG8_STAGE(PG8_SB(1, 1), cB + hstep + kstep, voffB);
        PG8_WAIT_V(6); PG8_BAR;
    } else {
        PG8_STAGE(PG8_SB(0, 0), cB, voffB); PG8_STAGE(PG8_SA(0, 0), cA, voffA); PG8_STAGE(PG8_SB(0, 1), cB + hstep, voffB); PG8_STAGE(PG8_SA(0, 1), cA + hstep, voffA);
        if (wr == 1) PG8_BAR;
        PG8_WAIT_V(4); PG8_BAR;
        PG8_STAGE(PG8_SB(1, 0), cB + kstep, voffB); PG8_STAGE(PG8_SA(1, 0), cA + kstep, voffA); PG8_STAGE(PG8_SB(1, 1), cB + hstep + kstep, voffB);
        PG8_WAIT_V(6); PG8_BAR;
    }
    for (;;) {
        const bool has_next = S.next(ui + 1, nxt);
        const char* nA = has_next ? (const char*)g.A + (size_t)nxt.pm * tstep : cA; const char* nB = has_next ? (const char*)g.Bt + (size_t)nxt.pn * tstep : cB;
        for (int t = 0; t < nt; t += 2) {
            const bool last = (t == nt - 2);
            const char* a1 = cA + (size_t)(t + 1) * kstep;
            const char* a2 = last ? nA : cA + (size_t)(t + 2) * kstep; const char* b2 = last ? nB : cB + (size_t)(t + 2) * kstep;
            const char* a3 = a2 + kstep; const char* b3 = b2 + kstep;
            if (last && has_next) S.a_ready(nxt);
            if constexpr (SP2) {
            PG8_LDB(B0, 0, 0); PG8_LDB(B1, 0, 1); PG8_SCHED; PG8_LDA(At, 0, 0); PG8_STAGE(PG8_SA(1, 1), a1 + hstep, voffA);
            PG8_WAIT_V(8); PG8_WAIT_L(0); PG8_BAR; PG8_MMA(0, 0, At, B0); PG8_MMA(0, 1, At, B1); PG8_BAR; PG8_SCHED;
            PG8_LDA(At, 0, 1); PG8_STAGE(PG8_SB(0, 0), b2, voffB); PG8_STAGE(PG8_SB(0, 1), b2 + hstep, voffB); PG8_STAGE(PG8_SA(0, 0), a2, voffA);
            PG8_WAIT_V(8); PG8_WAIT_L(0); PG8_BAR; PG8_MMA(1, 0, At, B0); PG8_MMA(1, 1, At, B1); PG8_BAR; PG8_SCHED;
            PG8_LDB(B0, 1, 0); PG8_LDB(B1, 1, 1); PG8_SCHED; PG8_LDA(At, 1, 0); PG8_STAGE(PG8_SA(0, 1), a2 + hstep, voffA);
            PG8_WAIT_V(8); PG8_WAIT_L(0); PG8_BAR; PG8_MMA(0, 0, At, B0); PG8_MMA(0, 1, At, B1); PG8_BAR; PG8_SCHED;
            PG8_LDA(At, 1, 1); PG8_STAGE(PG8_SB(1, 0), b3, voffB); PG8_STAGE(PG8_SB(1, 1), b3 + hstep, voffB); PG8_STAGE(PG8_SA(1, 0), a3, voffA);
            PG8_WAIT_V(8); PG8_WAIT_L(0); PG8_BAR; PG8_MMA(1, 0, At, B0); PG8_MMA(1, 1, At, B1); PG8_BAR; PG8_SCHED;
            } else {
            PG8_LDB(B0, 0, 0); PG8_SCHED; PG8_LDA(At, 0, 0); PG8_STAGE(PG8_SA(1, 1), a1 + hstep, voffA);
            PG8_WAIT_L(8); PG8_BAR; PG8_WAIT_L(0); PG8_MMA(0, 0, At, B0); PG8_BAR; PG8_SCHED;
            PG8_LDB(B1, 0, 1); PG8_STAGE(PG8_SB(0, 0), b2, voffB);
            PG8_BAR; PG8_WAIT_L(0); PG8_MMA(0, 1, At, B1); PG8_BAR;
            PG8_LDA(At, 0, 1); PG8_STAGE(PG8_SA(0, 0), a2, voffA);
            PG8_BAR; PG8_WAIT_L(0); PG8_MMA(1, 0, At, B0); PG8_BAR; PG8_SCHED;
            PG8_STAGE(PG8_SB(0, 1), b2 + hstep, voffB);
            PG8_WAIT_V(6); PG8_BAR; PG8_MMA(1, 1, At, B1); PG8_BAR;
            PG8_LDB(B0, 1, 0); PG8_SCHED; PG8_LDA(At, 1, 0); PG8_STAGE(PG8_SA(0, 1), a2 + hstep, voffA);
            PG8_WAIT_L(8); PG8_BAR; PG8_WAIT_L(0); PG8_MMA(0, 0, At, B0); PG8_BAR; PG8_SCHED;
            PG8_LDB(B1, 1, 1); PG8_STAGE(PG8_SB(1, 0), b3, voffB);
            PG8_BAR; PG8_WAIT_L(0); PG8_MMA(0, 1, At, B1); PG8_BAR;
            PG8_LDA(At, 1, 1); PG8_STAGE(PG8_SA(1, 0), a3, voffA);
            PG8_BAR; PG8_WAIT_L(0); PG8_MMA(1, 0, At, B0); PG8_BAR; PG8_SCHED;
            PG8_STAGE(PG8_SB(1, 1), b3 + hstep, voffB);
            PG8_WAIT_V(6); PG8_BAR; PG8_MMA(1, 1, At, B1); PG8_BAR;
            }
        }
        if constexpr (ALIGN_EPI) { if (wr == 0) PG8_BAR; }
        if constexpr (!Epi::AFTER_DRAIN) { E(acc, cur, wr, wc, fr, fq); S.done(cur); }
        if (!has_next) break;
#pragma unroll
        for (int a = 0; a < 2; ++a)
#pragma unroll
            for (int b = 0; b < 2; ++b)
#pragma unroll
                for (int m = 0; m < 4; ++m)
#pragma unroll
                    for (int n = 0; n < 2; ++n) acc[a][b][m][n] = (f32x4){0.f, 0.f, 0.f, 0.f};
        cur = nxt; cA = nA; cB = nB; ++ui;
        if constexpr (ALIGN_EPI) { if (wr == 1) PG8_BAR; }
    }
    PG8_WAIT_V(0);
    if constexpr (!ALIGN_EPI) { if (wr == 0) PG8_BAR; }
    PG8_BAR;
    if constexpr (Epi::AFTER_DRAIN) { E.fused(acc, cur, wr, wc, fr, fq, lds, wid, lane); S.done(cur); }
#undef PG8_SA
#undef PG8_SB
#undef PG8_STAGE
#undef PG8_LDA
#undef PG8_LDB
#undef PG8_MMA
#undef PG8_WAIT_V
#undef PG8_WAIT_L
#undef PG8_BAR
#undef PG8_SCHED
}
}
#define GAS __attribute__((address_space(1)))
#define LAS __attribute__((address_space(3)))
typedef unsigned short bf16;
typedef unsigned v4u __attribute__((ext_vector_type(4)));
typedef float f32x4 __attribute__((ext_vector_type(4)));
typedef short bf16x8 __attribute__((ext_vector_type(8)));
typedef GAS unsigned gu32;
typedef GAS unsigned long long gu64;
#define RLX_AGENT __ATOMIC_RELAXED, __HIP_MEMORY_SCOPE_AGENT
#define LDS_WAIT() asm volatile("s_waitcnt lgkmcnt(0)" ::: "memory")
#define VM_WAIT() asm volatile("s_waitcnt vmcnt(0)" ::: "memory")
__device__ __forceinline__ unsigned long long rt() { return __builtin_amdgcn_s_memrealtime(); }
__device__ __forceinline__ unsigned f2bf(float f) { unsigned u = __builtin_bit_cast(unsigned, f); return (u + 0x7fffu + ((u >> 16) & 1u)) >> 16; }
__device__ __forceinline__ unsigned pk2(float lo, float hi) { return f2bf(lo) | (f2bf(hi) << 16); }
#define XB_TMO      128
#define XB_XCNT(j)  (256  + 64 * (j))
#define XB_XSUB(j)  (1280 + 64 * (j))
#define XB_XGEN(j)  (2304 + 64 * (j))
#define XB_TOP      3328
#define XB_TOPGEN   3392
#define XCD_BAR_WORDS 3456
#define XB_SPIN_CAP (1u << 18)

__device__ __forceinline__ unsigned xb_ld(unsigned* p)              { return __hip_atomic_load(p, __ATOMIC_RELAXED, __HIP_MEMORY_SCOPE_AGENT); }
__device__ __forceinline__ unsigned xb_add(unsigned* p, unsigned v) { return __hip_atomic_fetch_add(p, v, __ATOMIC_RELAXED, __HIP_MEMORY_SCOPE_AGENT); }
__device__ __forceinline__ unsigned xb_xcc_id() { return (unsigned)__builtin_amdgcn_s_getreg((3 << 11) | 20) & 0xFu; }
#define XB_SPIN(cond, bar) do { unsigned _sp = 0; while (cond) { __builtin_amdgcn_s_sleep(1); \
    if ((++_sp & 255u) == 0u) { if (xb_ld(&(bar)[XB_TMO])) break; if (_sp > XB_SPIN_CAP) { atomicAdd(&(bar)[XB_TMO], 1u); break; } } } } while (0)

struct XcdBarrier {
    unsigned* bar; unsigned x;
    volatile LAS unsigned* st;
};

__device__ __forceinline__ XcdBarrier xcd_barrier_post(unsigned* bar, volatile LAS unsigned* st) {
    XcdBarrier b; b.bar = bar; b.x = xb_xcc_id(); b.st = st;
    if (threadIdx.x == 0) (void)xb_add(&bar[XB_XCNT(b.x)], 1u);
    return b;
}
__device__ __forceinline__ void xcd_barrier_complete(unsigned* bar, unsigned x, unsigned& nloc, unsigned& nx) {
    const unsigned G = gridDim.x * gridDim.y * gridDim.z;
    unsigned sum, cnt, mine, sp = 0u;
    for (;;) {
        sum = 0u; cnt = 0u; mine = 0u;
#pragma unroll
        for (unsigned j = 0; j < 16; ++j) { const unsigned c = xb_ld(&bar[XB_XCNT(j)]); sum += c; cnt += (c > 0u) ? 1u : 0u; mine = (j == x) ? c : mine; }
        if (sum == G) break;
        __builtin_amdgcn_s_sleep(1);
        if ((++sp & 255u) == 0u) { if (xb_ld(&bar[XB_TMO])) break; if (sp > XB_SPIN_CAP) { atomicAdd(&bar[XB_TMO], 1u); break; } }
    }
    nloc = mine > 0u ? mine : 1u; nx = cnt > 0u ? cnt : 1u;
}

__device__ __forceinline__ void xcd_barrier(const XcdBarrier& b) {
    asm volatile("s_waitcnt vmcnt(0)" ::: "memory");
    __syncthreads();
    if (threadIdx.x == 0) {
        unsigned* bar = b.bar;
        __builtin_amdgcn_s_waitcnt(0);
        unsigned nloc = b.st[0], nx = b.st[1];
        if (nloc == 0u) { xcd_barrier_complete(bar, b.x, nloc, nx); b.st[0] = nloc; b.st[1] = nx; }
        const unsigned old = xb_add(&bar[XB_XSUB(b.x)], 1u);
        const unsigned gen = old / nloc;
        if (old + 1u == (gen + 1u) * nloc) {
            __builtin_amdgcn_fence(__ATOMIC_RELEASE, "agent");
            asm volatile("s_waitcnt vmcnt(0)" ::: "memory");
            const unsigned og = xb_add(&bar[XB_TOP], 1u);
            const unsigned tg = og / nx;
            if (og + 1u == (tg + 1u) * nx) xb_add(&bar[XB_TOPGEN], 1u);
            else XB_SPIN(xb_ld(&bar[XB_TOPGEN]) == tg, bar);
            __builtin_amdgcn_fence(__ATOMIC_ACQUIRE, "agent");
            xb_add(&bar[XB_XGEN(b.x)], 1u);
            asm volatile("s_waitcnt vmcnt(0)" ::: "memory");
        } else {
            XB_SPIN(xb_ld(&bar[XB_XGEN(b.x)]) == gen, bar);
            __builtin_amdgcn_fence(__ATOMIC_ACQUIRE, "agent");
            asm volatile("s_waitcnt vmcnt(0)" ::: "memory");
        }
    }
    __syncthreads();
}
namespace wa {
typedef unsigned short u16;
typedef short bf16x8 __attribute__((ext_vector_type(8)));
typedef short s16x4 __attribute__((ext_vector_type(4)));
typedef float f32x16 __attribute__((ext_vector_type(16)));
typedef unsigned u32x4 __attribute__((ext_vector_type(4)));
typedef __attribute__((address_space(3))) unsigned char* lptr;
#define WA_LAS __attribute__((address_space(3)))
__device__ __forceinline__ int crow(int r, int hi) { return (r & 3) + 8 * (r >> 2) + 4 * hi; }
typedef float f32x2_t __attribute__((ext_vector_type(2))); typedef __bf16 bf16x2_t __attribute__((ext_vector_type(2)));
__device__ __forceinline__ unsigned cvtpk(float lo, float hi) { f32x2_t v = {lo, hi}; bf16x2_t b = __builtin_convertvector(v, bf16x2_t); return __builtin_bit_cast(unsigned, b); }
__device__ __forceinline__ float bflo(unsigned w) { return __builtin_bit_cast(float, w << 16); }
__device__ __forceinline__ float bfhi(unsigned w) { return __builtin_bit_cast(float, w & 0xffff0000u); }

struct TileRegs { u32x4 k[8], v[8]; };
constexpr unsigned PITCH = 2304;
__device__ __forceinline__ void tile_load(TileRegs& t, const u16* Kp, const u16* Vp, unsigned koff, unsigned voff) {
#pragma unroll
    for (int i = 0; i < 8; ++i) t.k[i] = *(const u32x4*)(Kp + (size_t)(8 * i) * PITCH + koff);
#pragma unroll
    for (int pc = 0; pc < 8; ++pc) t.v[pc] = *(const u32x4*)(Vp + (size_t)(16 * (pc & 3)) * PITCH + (pc >> 2) * 32 + voff);
}
__device__ __forceinline__ void tile_store(const TileRegs& t, lptr slot, int lane) {
#pragma unroll
    for (int i = 0; i < 8; ++i) *(WA_LAS u32x4*)(slot + (lane & 7) * 1024 + (8 * i + (lane >> 3)) * 16) = t.k[i];
#pragma unroll
    for (int pc = 0; pc < 8; ++pc) *(WA_LAS u32x4*)(slot + 8192 + pc * 1024 + lane * 16) = t.v[pc];
}
__device__ __forceinline__ void qkt(f32x16& p0, f32x16& p1, lptr slot, const bf16x8 (&qr)[4], int r32, int hi) {
    const lptr kb = slot + hi * 1024 + r32 * 16;
    const f32x16 z = {0.f, 0.f, 0.f, 0.f, 0.f, 0.f, 0.f, 0.f, 0.f, 0.f, 0.f, 0.f, 0.f, 0.f, 0.f, 0.f};
    p0 = z; p1 = z;
#pragma unroll
    for (int d0 = 0; d0 < 4; ++d0) {
        const bf16x8 b0 = *(const WA_LAS bf16x8*)(kb + d0 * 2048);
        const bf16x8 b1 = *(const WA_LAS bf16x8*)(kb + d0 * 2048 + 512);
        p0 = __builtin_amdgcn_mfma_f32_32x32x16_bf16(b0, qr[d0], p0, 0, 0, 0);
        p1 = __builtin_amdgcn_mfma_f32_32x32x16_bf16(b1, qr[d0], p1, 0, 0, 0);
    }
}
typedef short v4i16_t __attribute__((ext_vector_type(4)));
__device__ __forceinline__ s16x4 vtr(lptr p) { return __builtin_bit_cast(s16x4, __builtin_amdgcn_ds_read_tr16_b64_v4i16((WA_LAS v4i16_t*)p)); }
__device__ __forceinline__ void pv(f32x16 (&o)[2], lptr slot, const u32x4 (&pw)[4], int lane) {
    const int hi = lane >> 5;
    const lptr vb = slot + 8192 + ((lane >> 4) & 1) * 32 + (lane & 3) * 8 + (4 * hi + ((lane & 15) >> 2)) * 64;
#pragma unroll
    for (int d0 = 0; d0 < 2; ++d0)
#pragma unroll
        for (int ks = 0; ks < 4; ++ks) {
            const s16x4 lo = vtr(vb + d0 * 4096 + ks * 1024), hh = vtr(vb + d0 * 4096 + ks * 1024 + 512);
            const bf16x8 vf = (bf16x8){lo[0], lo[1], lo[2], lo[3], hh[0], hh[1], hh[2], hh[3]};
            o[d0] = __builtin_amdgcn_mfma_f32_32x32x16_bf16(__builtin_bit_cast(bf16x8, pw[ks]), vf, o[d0], 0, 0, 0);
        }
}
__device__ __forceinline__ void xhalf(float mine, float& other) {
    unsigned x = __builtin_bit_cast(unsigned, mine), y = x; asm volatile("" : "+v"(y));
    auto rr = __builtin_amdgcn_permlane32_swap(x, y, false, false);
    const unsigned lo = rr[0], hi = rr[1];
    other = __builtin_bit_cast(float, (__builtin_amdgcn_mbcnt_hi(~0u, __builtin_amdgcn_mbcnt_lo(~0u, 0u)) < 32u) ? hi : lo);
}
__device__ __forceinline__ float rowmax(const f32x16& p0, const f32x16& p1) {
    float a = fmaxf(p0[0], p1[0]);
#pragma unroll
    for (int r = 1; r < 16; ++r) a = fmaxf(a, fmaxf(p0[r], p1[r]));
    float other; xhalf(a, other);
    return fmaxf(a, other);
}
struct State { f32x16 o[2]; float m, l; };
__device__ __forceinline__ void sm_pv(State& st, f32x16& p0, f32x16& p1, lptr slot, WA_LAS float* wsf, int lane) {
    const int r32 = lane & 31, hi = lane >> 5;
    const float rm = rowmax(p0, p1);
    const float mnew = fmaxf(st.m, rm);
    const float ms = (mnew == -INFINITY) ? 0.f : mnew;
    const float alpha = __builtin_amdgcn_exp2f(st.m - ms);
    st.m = mnew;
    float ps = 0.f;
#pragma unroll
    for (int r = 0; r < 16; ++r) { p0[r] = __builtin_amdgcn_exp2f(p0[r] - ms); p1[r] = __builtin_amdgcn_exp2f(p1[r] - ms); ps += p0[r] + p1[r]; }
    st.l = st.l * alpha + ps;
    if (!__all(alpha == 1.0f)) {
        if (hi == 0) wsf[r32] = alpha;
#pragma unroll
        for (int r = 0; r < 16; ++r) { const float f = wsf[crow(r, hi)]; st.o[0][r] *= f; st.o[1][r] *= f; }
    }
    u32x4 pw[4];
#pragma unroll
    for (int i = 0; i < 4; ++i) { pw[0][i] = cvtpk(p0[2 * i], p0[2 * i + 1]); pw[1][i] = cvtpk(p0[8 + 2 * i], p0[9 + 2 * i]); pw[2][i] = cvtpk(p1[2 * i], p1[2 * i + 1]); pw[3][i] = cvtpk(p1[8 + 2 * i], p1[9 + 2 * i]); }
    pv(st.o, slot, pw, lane);
}
__device__ __forceinline__ void row_recip(const State& st, float (&rl)[16], WA_LAS float* wsf, int lane) {
    const int r32 = lane & 31, hi = lane >> 5;
    float other; xhalf(st.l, other);
    const float lt = st.l + other;
    if (hi == 0) wsf[32 + r32] = lt;
#pragma unroll
    for (int r = 0; r < 16; ++r) rl[r] = 1.0f / wsf[32 + crow(r, hi)];
}
__device__ __forceinline__ void store_mul(const State& st, const float (&rl)[16], u16* Yp, lptr stg_, int lane) {
    const int r32 = lane & 31, hi = lane >> 5; WA_LAS u16* stg = (WA_LAS u16*)stg_;
#pragma unroll
    for (int r = 0; r < 16; ++r) { const int orow = crow(r, hi);
#pragma unroll
        for (int d0 = 0; d0 < 2; ++d0) stg[orow * 64 + d0 * 32 + r32] = (u16)(cvtpk(st.o[d0][r] * rl[r], 0.f) & 0xffffu); }
    asm volatile("s_waitcnt lgkmcnt(0)" ::: "memory");
#pragma unroll
    for (int i = 0; i < 4; ++i) { const int row = i * 8 + (lane >> 3), ch = lane & 7;
        const u32x4 a = *(const WA_LAS u32x4*)(stg + row * 64 + ch * 8); u32x4* gp = (u32x4*)(Yp + (size_t)row * 1024 + ch * 8); const u32x4 y = *gp; u32x4 w;
#pragma unroll
        for (int e = 0; e < 4; ++e) w[e] = cvtpk(bflo(a[e]) * bflo(y[e]), bfhi(a[e]) * bfhi(y[e]));
        *gp = w; }
}

struct SpecPlain {
    const u16 *K, *V; int n;
    __device__ __forceinline__ int nt() const { return n; }
    __device__ __forceinline__ void tile(int j, const u16*& Kp, const u16*& Vp) const { Kp = K + (size_t)(64 * j) * PITCH; Vp = V + (size_t)(64 * j) * PITCH; }
    __device__ __forceinline__ void mask(int, f32x16&, f32x16&, int) const {}
};
struct SpecNA {
    const u16 *K, *V;
    int r, rs, c, cs; const WA_LAS float* bias;
    __device__ __forceinline__ int nt() const { return 12; }
    __device__ __forceinline__ void tile(int j, const u16*& Kp, const u16*& Vp) const { const int row = (j < 8) ? 64 * (rs + j) : 8192 + 64 * (j - 8); Kp = K + (size_t)row * PITCH; Vp = V + (size_t)row * PITCH; }
    __device__ __forceinline__ void mask(int j, f32x16& p0, f32x16& p1, int hi) const {
        if (j >= 8) return;
        const int base = (rs + j - r + 7) * 31 + 15 - c;
#pragma unroll
        for (int rr = 0; rr < 16; ++rr) {
            const int k0 = crow(rr, hi), k1 = k0 + 32;
            const bool v0 = (k0 >= cs) && (k0 <= cs + 15), v1 = (k1 >= cs) && (k1 <= cs + 15);
            const float b0 = bias[v0 ? base + k0 : 0], b1 = bias[v1 ? base + k1 : 0];
            p0[rr] = v0 ? p0[rr] + b0 : -INFINITY; p1[rr] = v1 ? p1[rr] + b1 : -INFINITY;
        }
    }
};
struct SpecWin {
    const u16 *K, *V; int ks0, nw, q;
    __device__ __forceinline__ int nt() const { return nw + 4; }
    __device__ __forceinline__ void tile(int j, const u16*& Kp, const u16*& Vp) const { const int row = (j < nw) ? ks0 + 64 * j : 8192 + 64 * (j - nw); Kp = K + (size_t)row * PITCH; Vp = V + (size_t)row * PITCH; }
    __device__ __forceinline__ void mask(int j, f32x16& p0, f32x16& p1, int hi) const {
        if (j >= nw) return;
#ifdef NOMASK_D
        return;
#endif
        const int kb = ks0 + 64 * j - q;
#pragma unroll
        for (int rr = 0; rr < 16; ++rr) { const int d0 = kb + crow(rr, hi), d1 = d0 + 32;
            if (d0 < -128 || d0 > 128) p0[rr] = -INFINITY; if (d1 < -128 || d1 > 128) p1[rr] = -INFINITY; }
    }
};
template <class Spec>
__device__ __forceinline__ void run(const Spec& sp, const u16* Qp, State& st, lptr slot, WA_LAS float* wsf, int lane, float* dumpS = nullptr, bool ksel = true) {
    const int r32 = lane & 31, hi = lane >> 5;
    bf16x8 qr[4];
#pragma unroll
    for (int d0 = 0; d0 < 4; ++d0) qr[d0] = *(const bf16x8*)(Qp + d0 * 16 + hi * 8);
    const f32x16 z = {0.f, 0.f, 0.f, 0.f, 0.f, 0.f, 0.f, 0.f, 0.f, 0.f, 0.f, 0.f, 0.f, 0.f, 0.f, 0.f};
    st.o[0] = z; st.o[1] = z;
    const int nt = sp.nt();
    TileRegs tr; const u16 *Kp, *Vp;
    const unsigned koff = (unsigned)(lane >> 3) * PITCH + (lane & 7) * 8, voff = (unsigned)(lane >> 2) * PITCH + (lane & 3) * 8;
#ifndef NOPF
    sp.tile(0, Kp, Vp); tile_load(tr, Kp, Vp, koff, voff);
#endif
    for (int j = 0; j < nt; ++j) {
#ifdef NOPF
        sp.tile(j, Kp, Vp); tile_load(tr, Kp, Vp, koff, voff);
        asm volatile("s_waitcnt vmcnt(0) lgkmcnt(0)" ::: "memory");
#endif
        tile_store(tr, slot, lane);
        asm volatile("" ::: "memory");
#ifdef NOPF
        asm volatile("s_waitcnt vmcnt(0) lgkmcnt(0)" ::: "memory");
#else
        if (j + 1 < nt) { sp.tile(j + 1, Kp, Vp); tile_load(tr, Kp, Vp, koff, voff); }
#endif
        f32x16 p0, p1;
        qkt(p0, p1, slot, qr, r32, hi);
#ifdef DUMP_S
        if (dumpS && j == 0) {
#pragma unroll
            for (int r = 0; r < 16; ++r) { dumpS[(size_t)r32 * 64 + crow(r, hi)] = p0[r]; dumpS[(size_t)r32 * 64 + 32 + crow(r, hi)] = p1[r]; }
        }
#endif
#ifdef UNIFORM_P
        p0 = p0 * 0.f; p1 = p1 * 0.f;
#endif
#ifdef KSEL
        if (ksel)
#pragma unroll
        for (int r = 0; r < 16; ++r) { if (crow(r, hi) != (KSEL)) p0[r] = -INFINITY; if (crow(r, hi) + 32 != (KSEL)) p1[r] = -INFINITY; }
#endif
        sp.mask(j, p0, p1, hi);
        sm_pv(st, p0, p1, slot, wsf, lane);
        asm volatile("" ::: "memory");
    }
}
}
namespace sc {
typedef unsigned short u16;
typedef unsigned u32x4 __attribute__((ext_vector_type(4)));
__device__ __forceinline__ float wsum(float v) {
#pragma unroll
    for (int o = 1; o < 64; o <<= 1) v += __shfl_xor(v, o);
    return v;
}
__device__ __forceinline__ float wmax(float v) {
#pragma unroll
    for (int o = 1; o < 64; o <<= 1) v = fmaxf(v, __shfl_xor(v, o));
    return v;
}
__device__ __forceinline__ void unpack8(const u32x4 w, float* f) {
#pragma unroll
    for (int e = 0; e < 4; ++e) { f[2 * e] = __builtin_bit_cast(float, w[e] << 16); f[2 * e + 1] = __builtin_bit_cast(float, w[e] & 0xffff0000u); }
}
template <int NS, class KeyFn>
__device__ __forceinline__ float row_attn(const u16* Qp, const u16* Kb, const u16* Vb, const KeyFn& kf, float sink_l2, int lane) {
    const float qd = __builtin_bit_cast(float, (unsigned)Qp[lane] << 16);
    float s[NS]; float mx = sink_l2;
#pragma unroll
    for (int i = 0; i < NS; ++i) {
        s[i] = -INFINITY;
        for (int kk = 0; kk < 64; ++kk) {
            int row; float bias; const bool ok = kf(64 * i + kk, row, bias);
            if (ok) { const float kd = __builtin_bit_cast(float, (unsigned)Kb[(size_t)row * 2304 + lane] << 16); float sc_ = wsum(qd * kd) + bias;
#ifdef UNIFORM_P
                sc_ = 0.f;
#endif
#ifdef KSEL
                if (kk != (KSEL)) sc_ = -INFINITY;
#endif
                if (lane == kk) s[i] = sc_; }
        }
        mx = fmaxf(mx, s[i]);
    }
    mx = wmax(mx);
    float l = 0.f, o = 0.f;
#pragma unroll
    for (int i = 0; i < NS; ++i) {
        float p = __builtin_amdgcn_exp2f(s[i] - mx); l += p;
#ifdef SC_PBF
        { unsigned u = __builtin_bit_cast(unsigned, p); u = (u + 0x7fffu + ((u >> 16) & 1u)) & 0xffff0000u; p = __builtin_bit_cast(float, u); }
#endif
        for (int kk = 0; kk < 64; ++kk) {
            int row; float bias; const bool ok = kf(64 * i + kk, row, bias);
            const float pk = __shfl(p, kk);
            if (ok) o += pk * __builtin_bit_cast(float, (unsigned)Vb[(size_t)row * 2304 + lane] << 16);
        }
    }
    l = wsum(l) + __builtin_amdgcn_exp2f(sink_l2 - mx);
    return o / l;
}
}
namespace fa {
using bf16=__hip_bfloat16;
using bf16x8=__attribute__((ext_vector_type(8)))short;
using s16x4=__attribute__((ext_vector_type(4)))short;
using f32x16=__attribute__((ext_vector_type(16)))float;
using u32x4=__attribute__((ext_vector_type(4)))unsigned;
constexpr int D=64,DM=2304;
constexpr int NW=8,QBLK=32,QB=QBLK*NW,KVBLK=64;
__device__ __forceinline__ int crow(int r,int hi){return (r&3)+8*(r>>2)+4*hi;}
#define SBAR() __builtin_amdgcn_sched_barrier(0)
__device__ __forceinline__ void cmask(f32x16&p0,f32x16&p1,int jb,int qrel,int hi){
  const float NEG=-INFINITY; int kb=64*jb+4*hi;
  #pragma unroll
  for(int r=0;r<16;++r){int kv=kb+(r&3)+8*(r>>2); if(kv>qrel)p0[r]=NEG; if(kv+32>qrel)p1[r]=NEG;}
}

constexpr int NSLOT=3, SLOTB=8192;
constexpr int LDS_K=0, LDS_V=NSLOT*SLOTB, LDS_WS=2*NSLOT*SLOTB, LDS_OST=LDS_WS+NW*64*4, LDS_BYTES=LDS_OST+NW*4096;
constexpr float C2=0.125f*1.4426950408889634f;
__device__ __forceinline__ void glds16(const void*gsrc,unsigned lds_dst){unsigned keep;
  asm volatile("s_mov_b32 %0, m0\n\ts_mov_b32 m0, %2\n\ts_nop 0\n\tglobal_load_lds_dwordx4 %1, off\n\ts_mov_b32 m0, %0":"=&s"(keep):"v"(gsrc),"s"(lds_dst):"memory");}
__device__ __forceinline__ float max3f(float a,float b,float c){float r;asm("v_max3_f32 %0, %1, %2, %3":"=v"(r):"v"(a),"v"(b),"v"(c));return r;}
__device__ __forceinline__ float max2f(float a,float b){float r;asm("v_max_f32_e32 %0, %1, %2":"=v"(r):"v"(a),"v"(b));return r;}
__device__ __forceinline__ float fadd_s(float a,float b){float r;asm("v_add_f32_e32 %0, %1, %2":"=v"(r):"v"(a),"v"(b));return r;}
__device__ __forceinline__ float fsub_s(float a,float b){float r;asm("v_sub_f32_e32 %0, %1, %2":"=v"(r):"v"(a),"v"(b));return r;}
typedef float f32x2_t __attribute__((ext_vector_type(2))); typedef __bf16 bf16x2_t __attribute__((ext_vector_type(2)));
__device__ __forceinline__ unsigned cvtpk_s(float lo,float hi){f32x2_t v={lo,hi};bf16x2_t b=__builtin_convertvector(v,bf16x2_t);return __builtin_bit_cast(unsigned,b);}
#define WAIT_BAR(N) asm volatile("s_waitcnt vmcnt(" #N ") lgkmcnt(0)\n\ts_barrier":::"memory")

__device__ __forceinline__ void qkt(f32x16&p0,f32x16&p1,const char*Kslot,const bf16x8*qr,const f32x16&negm,int r32,int hi){
  const char*kb=Kslot+hi*1024+r32*16;
  #pragma unroll
  for(int d0=0;d0<4;++d0){
    const bf16x8 b0=*reinterpret_cast<const bf16x8*>(kb+d0*2048);
    const bf16x8 b1=*reinterpret_cast<const bf16x8*>(kb+d0*2048+512);
    if(d0==0){p0=__builtin_amdgcn_mfma_f32_32x32x16_bf16(b0,qr[0],negm,0,0,0);p1=__builtin_amdgcn_mfma_f32_32x32x16_bf16(b1,qr[0],negm,0,0,0);}
    else{p0=__builtin_amdgcn_mfma_f32_32x32x16_bf16(b0,qr[d0],p0,0,0,0);p1=__builtin_amdgcn_mfma_f32_32x32x16_bf16(b1,qr[d0],p1,0,0,0);}}
}
typedef __attribute__((address_space(3))) const char* lds_cptr;
typedef short v4i16_t __attribute__((ext_vector_type(4)));
__device__ __forceinline__ void kload8(bf16x8*kf,lds_cptr kp){
  kf[0]=*(const __attribute__((address_space(3))) bf16x8*)(kp);      kf[1]=*(const __attribute__((address_space(3))) bf16x8*)(kp+512);
  kf[2]=*(const __attribute__((address_space(3))) bf16x8*)(kp+2048); kf[3]=*(const __attribute__((address_space(3))) bf16x8*)(kp+2560);
  kf[4]=*(const __attribute__((address_space(3))) bf16x8*)(kp+4096); kf[5]=*(const __attribute__((address_space(3))) bf16x8*)(kp+4608);
  kf[6]=*(const __attribute__((address_space(3))) bf16x8*)(kp+6144); kf[7]=*(const __attribute__((address_space(3))) bf16x8*)(kp+6656);
}
__device__ __forceinline__ void kload2(bf16x8*kf,lds_cptr kp,int j){ kf[2*j]=*(const __attribute__((address_space(3))) bf16x8*)(kp+j*2048); kf[2*j+1]=*(const __attribute__((address_space(3))) bf16x8*)(kp+j*2048+512); }
__device__ __forceinline__ s16x4 vtr(lds_cptr p){ return __builtin_bit_cast(s16x4,__builtin_amdgcn_ds_read_tr16_b64_v4i16((__attribute__((address_space(3))) v4i16_t*)p)); }
__device__ __forceinline__ float xhalf(float mine){ unsigned x=__float_as_uint(mine),y=x; asm volatile("":"+v"(y)); auto rr=__builtin_amdgcn_permlane32_swap(x,y,false,false);
  const unsigned lo=rr[0],hi_=rr[1]; return __uint_as_float((__builtin_amdgcn_mbcnt_hi(~0u,__builtin_amdgcn_mbcnt_lo(~0u,0u))<32u)?hi_:lo); }
__device__ __forceinline__ float rowmax(const f32x16&p0,const f32x16&p1){
  float a=max3f(p0[0],p0[1],p1[0]),b=max3f(p0[2],p0[3],p1[1]);a=max3f(a,p1[2],p1[3]);
  #pragma unroll
  for(int r=4;r<16;r+=4){a=max3f(a,p0[r],p0[r+1]);b=max3f(b,p0[r+2],p0[r+3]);a=max3f(a,p1[r],p1[r+1]);b=max3f(b,p1[r+2],p1[r+3]);}
  const float m=max2f(a,b);
  return max2f(m,xhalf(m));
}
__device__ __forceinline__ void pv(f32x16*o,int vb,bf16x8 pa0,bf16x8 pa1,bf16x8 pa2,bf16x8 pa3){
  #pragma unroll
  for(int d0=0;d0<2;++d0){s16x4 lo[4],hi[4];
    #pragma unroll
    for(int ks=0;ks<4;++ks){
      asm volatile("ds_read_b64_tr_b16 %0,%1 offset:%c2":"=&v"(lo[ks]):"v"(vb),"i"(d0*4096+ks*1024):"memory");
      asm volatile("ds_read_b64_tr_b16 %0,%1 offset:%c2":"=&v"(hi[ks]):"v"(vb),"i"(d0*4096+ks*1024+512):"memory");}
    asm volatile("s_waitcnt lgkmcnt(0)":::"memory");SBAR();
    #define PK(k) (bf16x8){lo[k][0],lo[k][1],lo[k][2],lo[k][3],hi[k][0],hi[k][1],hi[k][2],hi[k][3]}
    o[d0]=__builtin_amdgcn_mfma_f32_32x32x16_bf16(pa0,PK(0),o[d0],0,0,0);
    o[d0]=__builtin_amdgcn_mfma_f32_32x32x16_bf16(pa1,PK(1),o[d0],0,0,0);
    o[d0]=__builtin_amdgcn_mfma_f32_32x32x16_bf16(pa2,PK(2),o[d0],0,0,0);
    o[d0]=__builtin_amdgcn_mfma_f32_32x32x16_bf16(pa3,PK(3),o[d0],0,0,0);
    #undef PK
  }
}

#ifndef ATTN_STORE16
#define ATTN_STORE16(p,v) (*(u32x4*)(p)=(v))
#endif
template<int THRL,class Out> __device__ __forceinline__ void attn_unit(const bf16*Q0,const bf16*__restrict__ Kh,const bf16*__restrict__ Vh,const int NT,char*shm,const Out&out){
  int tid_=threadIdx.x; asm volatile("":"+v"(tid_)); const int tid=tid_,lane=tid&63,r32=lane&31,hi=lane>>5; const int wid=__builtin_amdgcn_readfirstlane(tid>>6);
  const bf16*Qw=Q0+(long)(wid*QBLK)*DM;
  const unsigned lds0=(unsigned)(uintptr_t)shm;
  float*wsf=(float*)(shm+LDS_WS)+wid*64;
  const bf16*ksrc=Kh+(long)lane*DM+wid*8;
  const bf16*vsrc=Vh+(long)(16*(wid&3)+(lane>>2))*DM+(wid>>2)*32+(lane&3)*8;
  const unsigned kdst=lds0+LDS_K+wid*1024, vdst=lds0+LDS_V+wid*1024;
  #define DMA_K(t,slot) glds16(ksrc+(long)(t)*KVBLK*DM,(unsigned)__builtin_amdgcn_readfirstlane(kdst+(slot)))
  #define DMA_V(t,slot) glds16(vsrc+(long)(t)*KVBLK*DM,(unsigned)__builtin_amdgcn_readfirstlane(vdst+(slot)))
  const int vb0=(int)(lds0+LDS_V)+((lane>>4)&1)*32+(lane&3)*8+(4*hi+((lane&15)>>2))*64;
  const char*Kbase=shm+LDS_K; bf16x8 kf[8];
  const lds_cptr shm3=(lds_cptr)shm; const lds_cptr kp0=shm3+LDS_K+hi*1024+r32*16; const lds_cptr vp0=shm3+LDS_V+((lane>>4)&1)*32+(lane&3)*8+(4*hi+((lane&15)>>2))*64;
  DMA_K(0,0);DMA_V(0,0);DMA_K(1,SLOTB);
  bf16x8 qr[4];
  #pragma unroll
  for(int d0=0;d0<4;++d0)qr[d0]=*reinterpret_cast<const bf16x8*>(&Qw[(long)r32*DM+d0*16+hi*8]);
  float mhat=0.f,l_reg=0.f;f32x16 o[2];o[0]=f32x16{};o[1]=f32x16{};f32x16 negm=f32x16{};asm volatile("":"+v"(negm));
  #define CMASK(P0,P1,t) do{}while(0)
  bool resc=false;
  #define START(P0,P1) do{ const float rm=rowmax(P0,P1); resc=false; \
    { const float dl=rm; mhat=fadd_s(mhat,dl); \
      _Pragma("unroll") for(int r=0;r<16;++r){P0[r]=fsub_s(P0[r],dl);P1[r]=fsub_s(P1[r],dl);} \
      _Pragma("unroll") for(int r=0;r<16;++r)negm[r]=-mhat; asm volatile("":"+v"(negm)); } \
    _Pragma("unroll") for(int r=0;r<16;++r)P0[r]=__builtin_amdgcn_exp2f(P0[r]); }while(0)
  #define RESC() do{ if(resc){ asm volatile("s_waitcnt lgkmcnt(0)":::"memory"); \
      _Pragma("unroll") for(int d_=0;d_<2;++d_) _Pragma("unroll") for(int r=0;r<16;++r)o[d_][r]*=wsf[crow(r,hi)]; } }while(0)
  f32x16 pA0,pA1,pB0,pB1;
  int sl_prev=0,sl_cur=0,sl_next=SLOTB;
  #define ROT() do{sl_prev=sl_cur;sl_cur=sl_next;sl_next=(sl_next==(NSLOT-1)*SLOTB)?0:sl_next+SLOTB;}while(0)
  DMA_K(2,2*SLOTB);
  WAIT_BAR(3);
  qkt(pA0,pA1,Kbase,qr,negm,r32,hi);asm volatile("s_nop 15\n\ts_nop 7":"+v"(pA0),"+v"(pA1));CMASK(pA0,pA1,0);
  START(pA0,pA1);
  _Pragma("unroll") for(int r=0;r<16;++r)pA1[r]=__builtin_amdgcn_exp2f(pA1[r]);
  WAIT_BAR(0);
  DMA_K(3,0);DMA_V(1,SLOTB);
  ROT();
  kload8(kf,kp0+sl_cur);
  WAIT_BAR(2);
  s16x4 vlo[8],vhi[8]; u32x4 pw0,pw1,pw2,pw3;
  #define PKW(P,B) cvtpk_s(P[B],P[B+1])
  #define PAF(k) __builtin_bit_cast(bf16x8,pw##k)
  #define VFR(i) (bf16x8){vlo[i][0],vlo[i][1],vlo[i][2],vlo[i][3],vhi[i][0],vhi[i][1],vhi[i][2],vhi[i][3]}
  #define PIN(x) asm volatile("":"+v"(x))
  #define MX3(a,b,c) __builtin_fmaxf(__builtin_fmaxf((a),(b)),(c))
  #define GAPA(MF,A0,A1,A2,A3,W0,W1,PW) do{ MF; sacc+=A0; sacc+=A1; sacc+=A2; sacc+=A3; PIN(sacc); W0; W1; PIN(PW); SBAR(); }while(0)
  #define EX(v) __builtin_amdgcn_exp2f(v)
  #define GAPB(MF,X,B) do{ MF; X[B]=EX(X[B]); X[B+1]=EX(X[B+1]); X[B+2]=EX(X[B+2]); X[B+3]=EX(X[B+3]); PIN(X); SBAR(); }while(0)
  #define VRD(i) do{ vlo[i]=vtr(vp_+(((i)>>2)*4096+((i)&3)*1024)); vhi[i]=vtr(vp_+(((i)>>2)*4096+((i)&3)*1024+512)); }while(0)
  #define KRD(G,j) do{ if(G){ kload2(kf,kp0+sl_next,j); SBAR(); } }while(0)
  #define STEP(C0,C1,P0,P1,t,GK,GV,GL) do{ SBAR(); \
    const lds_cptr vp_=vp0+sl_prev; \
    VRD(0); SBAR(); float sacc=(P0[0]+P0[1]); \
    GAPA(C0=__builtin_amdgcn_mfma_f32_32x32x16_bf16(kf[0],qr[0],negm,0,0,0), P0[2],P0[3],P0[4],P0[5],     pw0[0]=PKW(P0,0), pw0[1]=PKW(P0,2), pw0); \
    VRD(4); SBAR(); GAPA(C1=__builtin_amdgcn_mfma_f32_32x32x16_bf16(kf[1],qr[0],negm,0,0,0), P0[6],P0[7],P0[8],P0[9],     pw0[2]=PKW(P0,4), pw0[3]=PKW(P0,6), pw0); \
    VRD(1); SBAR(); GAPA(C0=__builtin_amdgcn_mfma_f32_32x32x16_bf16(kf[2],qr[1],C0,0,0,0),   P0[10],P0[11],P0[12],P0[13], pw1[0]=PKW(P0,8), pw1[1]=PKW(P0,10), pw1); \
    VRD(5); SBAR(); GAPA(C1=__builtin_amdgcn_mfma_f32_32x32x16_bf16(kf[3],qr[1],C1,0,0,0),   P0[14],P0[15],P1[0],P1[1],   pw1[2]=PKW(P0,12),pw1[3]=PKW(P0,14), pw1); \
    VRD(2); SBAR(); GAPA(C0=__builtin_amdgcn_mfma_f32_32x32x16_bf16(kf[4],qr[2],C0,0,0,0),   P1[2],P1[3],P1[4],P1[5],     pw2[0]=PKW(P1,0), pw2[1]=PKW(P1,2), pw2); \
    VRD(6); SBAR(); GAPA(C1=__builtin_amdgcn_mfma_f32_32x32x16_bf16(kf[5],qr[2],C1,0,0,0),   P1[6],P1[7],P1[8],P1[9],     pw2[2]=PKW(P1,4), pw2[3]=PKW(P1,6), pw2); \
    VRD(3); SBAR(); GAPA(C0=__builtin_amdgcn_mfma_f32_32x32x16_bf16(kf[6],qr[3],C0,0,0,0),   P1[10],P1[11],P1[12],P1[13], pw3[0]=PKW(P1,8), pw3[1]=PKW(P1,10), pw3); \
    VRD(7); SBAR(); GAPA(C1=__builtin_amdgcn_mfma_f32_32x32x16_bf16(kf[7],qr[3],C1,0,0,0),   P1[14],P1[15],0.f,0.f,       pw3[2]=PKW(P1,12),pw3[3]=PKW(P1,14), pw3); \
    l_reg+=sacc; \
    if(GK){DMA_K((t)+3,sl_cur);} if(GV){DMA_V((t)+1,sl_next);} \
    CMASK(C0,C1,t); \
    { float a=MX3(C0[0],C0[1],C1[0]),b=MX3(C0[2],C0[3],C1[1]); a=MX3(a,C1[2],C1[3]); \
      _Pragma("unroll") for(int r=4;r<16;r+=4){a=MX3(a,C0[r],C0[r+1]);b=MX3(b,C0[r+2],C0[r+3]);a=MX3(a,C1[r],C1[r+1]);b=MX3(b,C1[r+2],C1[r+3]);} \
      float rm=__builtin_fmaxf(a,b); rm=__builtin_fmaxf(rm,xhalf(rm)); \
      resc=false; \
      if(__builtin_expect(__any(rm>(float)THRL),0)){ const float dl=__builtin_fmaxf(rm,0.f); mhat+=dl; \
        _Pragma("unroll") for(int r=0;r<16;++r){C0[r]-=dl;C1[r]-=dl;} \
        _Pragma("unroll") for(int r=0;r<16;++r)negm[r]=-mhat; asm volatile("":"+v"(negm)); \
        const float f=__builtin_amdgcn_exp2f(-dl); l_reg*=f; if(hi==0)wsf[r32]=f; resc=true; } } \
    SBAR(); \
    GAPB(o[0]=__builtin_amdgcn_mfma_f32_32x32x16_bf16(PAF(0),VFR(0),o[0],0,0,0), C0,0); \
    GAPB(o[1]=__builtin_amdgcn_mfma_f32_32x32x16_bf16(PAF(0),VFR(4),o[1],0,0,0), C0,4); \
    KRD(GL,0); GAPB(o[0]=__builtin_amdgcn_mfma_f32_32x32x16_bf16(PAF(1),VFR(1),o[0],0,0,0), C0,8); \
    KRD(GL,1); GAPB(o[1]=__builtin_amdgcn_mfma_f32_32x32x16_bf16(PAF(1),VFR(5),o[1],0,0,0), C0,12); \
    KRD(GL,2); GAPB(o[0]=__builtin_amdgcn_mfma_f32_32x32x16_bf16(PAF(2),VFR(2),o[0],0,0,0), C1,0); \
    KRD(GL,3); GAPB(o[1]=__builtin_amdgcn_mfma_f32_32x32x16_bf16(PAF(2),VFR(6),o[1],0,0,0), C1,4); \
    GAPB(o[0]=__builtin_amdgcn_mfma_f32_32x32x16_bf16(PAF(3),VFR(3),o[0],0,0,0), C1,8); \
    GAPB(o[1]=__builtin_amdgcn_mfma_f32_32x32x16_bf16(PAF(3),VFR(7),o[1],0,0,0), C1,12); \
    }while(0)
  int t=1;
  #undef CMASK
  #define CMASK(P0,P1,t) do{}while(0)
  for(;t+5<NT;t+=2){
    STEP(pB0,pB1,pA0,pA1,t,true,true,true);     WAIT_BAR(2); RESC(); ROT();
    STEP(pA0,pA1,pB0,pB1,t+1,true,true,true);   WAIT_BAR(2); RESC(); ROT();
  }
  #undef CMASK
  #define CMASK(P0,P1,t) do{}while(0)
  #define ENDW(tt) do{ if((tt)+3<NT){WAIT_BAR(2);} else if((tt)+2<NT){WAIT_BAR(1);} else {WAIT_BAR(0);} }while(0)
  for(;t+1<NT;t+=2){
    STEP(pB0,pB1,pA0,pA1,t,(t+3<NT),(t+1<NT),(t+1<NT));       ENDW(t);   RESC(); ROT();
    STEP(pA0,pA1,pB0,pB1,t+1,(t+4<NT),(t+2<NT),(t+2<NT));     ENDW(t+1); RESC(); ROT();
  }
  STEP(pB0,pB1,pA0,pA1,NT-1,false,false,false); RESC();
  { float sacc=pB0[0]+pB0[1]; _Pragma("unroll") for(int r=2;r<16;++r)sacc+=pB0[r]; _Pragma("unroll") for(int r=0;r<16;++r)sacc+=pB1[r]; l_reg+=sacc;
    pw0=(u32x4){PKW(pB0,0),PKW(pB0,2),PKW(pB0,4),PKW(pB0,6)};pw1=(u32x4){PKW(pB0,8),PKW(pB0,10),PKW(pB0,12),PKW(pB0,14)};pw2=(u32x4){PKW(pB1,0),PKW(pB1,2),PKW(pB1,4),PKW(pB1,6)};pw3=(u32x4){PKW(pB1,8),PKW(pB1,10),PKW(pB1,12),PKW(pB1,14)};
    SBAR(); pv(o,vb0+sl_cur,PAF(0),PAF(1),PAF(2),PAF(3)); }
  #undef PKW
  #undef PAF
  #undef VFR
  #undef PIN
  #undef MX3
  #undef GAPA
  #undef GAPB
  #undef EX
  #undef VRD
  #undef KRD
  #undef STEP
  #undef ENDW
  l_reg+=xhalf(l_reg);
  if(hi==0)wsf[32+r32]=l_reg;asm volatile("s_waitcnt lgkmcnt(0)":::"memory");
  float rli[16];
  #pragma unroll
  for(int r=0;r<16;++r)rli[r]=__builtin_amdgcn_rcpf(wsf[32+crow(r,hi)]);
  out(o,rli,wid,lane,shm);
  asm volatile("s_waitcnt lgkmcnt(0)\n\ts_barrier":::"memory");
  #undef DMA_K
  #undef DMA_V
  #undef CMASK
  #undef START
  #undef RESC
  #undef ROT
}
struct OutMulY {
  unsigned short* Y0;
  __device__ __forceinline__ void operator()(const f32x16 (&o)[2],const float (&rli)[16],int wid,int lane,char*shm)const{
    const int r32=lane&31,hi=lane>>5; unsigned short*stg=(unsigned short*)(shm+LDS_OST)+wid*2048;
    #pragma unroll
    for(int r=0;r<16;++r){const int orow=crow(r,hi);
      #pragma unroll
      for(int d0=0;d0<2;++d0)stg[orow*64+d0*32+r32]=(unsigned short)(cvtpk_s(o[d0][r]*rli[r],0.f)&0xffffu);}
    asm volatile("s_waitcnt lgkmcnt(0)":::"memory");
    unsigned short*Yw=Y0+(long)(wid*QBLK)*1024;
    #pragma unroll
    for(int i=0;i<4;++i){const int row=i*8+(lane>>3),ch=lane&7; const u32x4 a=*(const u32x4*)(stg+row*64+ch*8); u32x4*gp=(u32x4*)(Yw+(long)row*1024+ch*8); const u32x4 y=*gp; u32x4 w;
      #pragma unroll
      for(int e=0;e<4;++e)w[e]=cvtpk_s(__uint_as_float(a[e]<<16)*__uint_as_float(y[e]<<16),__uint_as_float(a[e]&0xffff0000u)*__uint_as_float(y[e]&0xffff0000u));
      *gp=w;}
  }
};
struct OutF32 {
  float* O0;
  __device__ __forceinline__ void operator()(const f32x16 (&o)[2],const float (&rli)[16],int wid,int lane,char*)const{
    const int r32=lane&31,hi=lane>>5; float*op=O0+(long)(wid*QBLK)*1024+r32;
    #pragma unroll
    for(int r=0;r<16;++r){const int q=crow(r,hi); op[(long)q*1024]=o[0][r]*rli[r]; op[(long)q*1024+32]=o[1][r]*rli[r];}
  }
};
constexpr int ATTN_LDS_BYTES=LDS_BYTES;
#undef SBAR
#undef WAIT_BAR
}
typedef float f32x2 __attribute__((ext_vector_type(2)));
#ifndef KSEL_MIX
#define KSEL_MIX 0
#endif
#ifndef FA_THR
#define FA_THR 8
#endif
constexpr int NB = 4, SEQ = 8192, CTXL = 256, DM = 1024, SE = SEQ + CTXL, RT = NB * SE, NIN = 3328, NQKV = 2304;
constexpr float LOG2E = 1.4426950408889634f, LAM0 = 0.35550906759f;
constexpr size_t MiB = 1u << 20;
constexpr size_t WS_CTL = 0, CTL_ZERO_BYTES = 1 * MiB;
constexpr size_t WS_MOD = 1 * MiB;
constexpr size_t WS_ROPE = 1 * MiB + 256 * 1024;
constexpr size_t WS_WIN0 = 2 * MiB, WS_WIN1 = 10 * MiB;
constexpr size_t WS_WOUT0 = 18 * MiB, WS_WOUT1 = 20 * MiB;
constexpr size_t WS_XC1 = 24 * MiB;
constexpr size_t WS_H = 32 * MiB;
constexpr size_t WS_Y = 100 * MiB;
constexpr size_t WS_QKV = 168 * MiB;
constexpr size_t WS_OC = 320 * MiB;
constexpr size_t WS_END = 448 * MiB;
static_assert(WS_H + (size_t)RT * DM * 2 <= WS_Y && WS_Y + (size_t)RT * DM * 2 <= WS_QKV && WS_QKV + (size_t)RT * NQKV * 2 <= WS_OC && WS_OC + (size_t)32768 * 1024 * 4 <= WS_END, "ws map");
constexpr int CW_BAR = 4096;
constexpr int RING_BYTES = 131072, SCR_OFF = RING_BYTES, BIAS_OFF = SCR_OFF + 2048, LDSCTL_OFF = 148480, MISC_OFF = LDSCTL_OFF + 320, LDS_BYTES = 152 * 1024;
static_assert(BIAS_OFF + 8 * 465 * 4 <= LDSCTL_OFF && MISC_OFF + 128 <= LDS_BYTES, "LDS map");

typedef unsigned short u16;
__device__ __forceinline__ float wave_sum(float v) {
#pragma unroll
    for (int o = 1; o < 64; o <<= 1) v += __shfl_xor(v, o);
    return v;
}
__device__ __forceinline__ void p0_transpose_item(const float* W, int K, int N, u16* WT, bool perm, LAS float* scr, int item, int lane) {
    const int nblk = N / 32, kb = item / nblk, nb = item % nblk, k0 = 64 * kb, n0 = 32 * nb;
    const int rowbase = perm ? (256 * (n0 >> 8) + 128 * ((n0 >> 5) & 1) + 32 * ((n0 >> 6) & 3)) : n0;
#pragma unroll 8
    for (int i = 0; i < 32; ++i) { const int kk = 2 * i + (lane >> 5); scr[kk * 33 + (lane & 31)] = W[(size_t)(k0 + kk) * N + n0 + (lane & 31)]; }
    LDS_WAIT(); asm volatile("" ::: "memory");
    const int c = lane & 7;
#pragma unroll
    for (int j = 0; j < 4; ++j) { const int n = (lane >> 3) + 8 * j; const LAS float* s = scr + (8 * c) * 33 + n;
        v4u o; o.x = pk2(s[0 * 33], s[1 * 33]); o.y = pk2(s[2 * 33], s[3 * 33]); o.z = pk2(s[4 * 33], s[5 * 33]); o.w = pk2(s[6 * 33], s[7 * 33]);
        *(v4u*)(WT + (size_t)(rowbase + n) * K + k0 + 8 * c) = o; }
    LDS_WAIT(); asm volatile("" ::: "memory");
}

struct Args { const float* in[17]; float* out; unsigned char* ws; };

__global__ void __launch_bounds__(512, 2) fwd_kernel(Args args) {
    extern __shared__ __attribute__((aligned(16))) unsigned char lds_raw[];
    LAS unsigned char* lds = (LAS unsigned char*)lds_raw;
    volatile LAS unsigned* MISC = (volatile LAS unsigned*)(lds + MISC_OFF);
    const int G = gridDim.x, bx = blockIdx.x, vcu = (G % 8 == 0) ? (bx % 8) * (G / 8) + bx / 8 : bx, NGW = G * 8;
#define PH_IDS KP_DECL int tid = threadIdx.x; asm volatile("" : "+v"(tid)); const int lane = tid & 63, wave = __builtin_amdgcn_readfirstlane(tid >> 6), gw = vcu * 8 + wave; (void)lane; (void)gw;
#define AS4 __attribute__((address_space(4)))
#define KP_DECL const AS4 unsigned char* kp_ = (const AS4 unsigned char*)__builtin_amdgcn_kernarg_segment_ptr(); asm volatile("" : "+s"(kp_)); unsigned char* const ws = *(unsigned char* const AS4*)(kp_ + 144); (void)ws;
#define KIN(i) (*(const float* const AS4*)(kp_ + 8 * (i)))
#define KOUT (*(float* const AS4*)(kp_ + 136))
#define W_MOD ((float*)(ws + WS_MOD))
#define W_ROPEC ((float*)(ws + WS_ROPE))
#define W_ROPES ((float*)(ws + WS_ROPE) + 128 * 16)
#define W_XC1 ((float*)(ws + WS_XC1))
#define W_H ((u16*)(ws + WS_H))
#define W_Y ((u16*)(ws + WS_Y))
#define W_QKV ((u16*)(ws + WS_QKV))
#define W_OC ((float*)(ws + WS_OC))
    (void)args;
    for (int u = threadIdx.x; u < (LDS_BYTES - LDSCTL_OFF) / 4; u += 512) ((LAS unsigned*)(lds + LDSCTL_OFF))[u] = 0u;
    __syncthreads();
    { KP_DECL (void)xcd_barrier_post((unsigned*)(ws + WS_CTL) + CW_BAR, MISC + 8); }
#ifdef USE_CG
#define GRID_BAR() do { asm volatile("s_waitcnt vmcnt(0)" ::: "memory"); __threadfence(); cooperative_groups::this_grid().sync(); __threadfence(); } while (0)
#else
#define GRID_BAR() do { KP_DECL XcdBarrier b_; b_.bar = (unsigned*)(ws + WS_CTL) + CW_BAR; b_.x = xb_xcc_id(); b_.st = MISC + 8; xcd_barrier(b_); } while (0)
#endif

#ifndef SKIP_P0
    {
        PH_IDS
        const float* cvec = KIN(1); const float* cctx = KIN(3); const float* w_mod = KIN(4); const float* b_mod = KIN(5); float* MOD = W_MOD; float* ROPEC = W_ROPEC; float* ROPES = W_ROPES;
        LAS float* sil = (LAS float*)lds;
        LAS float* part = (LAS float*)(lds + 20480);
        if (bx < 192) {
            for (int i = tid; i < 5120; i += 512) { const int v = i >> 10, k = i & 1023; const float cv = (v < 4) ? cvec[v * 1024 + k] : cctx[k]; sil[i] = cv / (1.0f + __expf(-cv)); }
            __syncthreads();
            for (int it = bx; it < 192; it += G) {
                const int layer = it / 96, n0 = (it % 96) * 32, ks = tid >> 5, cl = tid & 31;
                const float* W = w_mod + (size_t)layer * 1024 * 3072 + n0 + cl;
                float a0 = 0.f, a1 = 0.f, a2 = 0.f, a3 = 0.f, a4 = 0.f;
#pragma unroll 16
                for (int kk = 0; kk < 64; ++kk) { const int k = ks * 64 + kk; const float w = W[(size_t)k * 3072];
                    a0 += sil[k] * w; a1 += sil[1024 + k] * w; a2 += sil[2048 + k] * w; a3 += sil[3072 + k] * w; a4 += sil[4096 + k] * w; }
                part[(ks * 5 + 0) * 32 + cl] = a0; part[(ks * 5 + 1) * 32 + cl] = a1; part[(ks * 5 + 2) * 32 + cl] = a2; part[(ks * 5 + 3) * 32 + cl] = a3; part[(ks * 5 + 4) * 32 + cl] = a4;
                __syncthreads();
                if (tid < 160) { const int v = tid >> 5; float s = b_mod[layer * 3072 + n0 + cl];
#pragma unroll
                    for (int q = 0; q < 16; ++q) s += part[(q * 5 + v) * 32 + cl];
                    MOD[(size_t)(layer * 5 + v) * 3072 + n0 + cl] = s; }
                __syncthreads();
            }
        } else if (bx >= G - 4) {
            const int e = (bx - (G - 4)) * 512 + tid, pos = e >> 4, j = e & 15;
            const float inv = exp2f(-(float)j * (13.287712379549449f / 16.0f));
            const float ang = (float)pos * inv;
            ROPEC[e] = cosf(ang); ROPES[e] = sinf(ang);
        }
        __syncthreads();
        LAS float* scr = (LAS float*)(lds + wave * 16384);
        constexpr int I_IN = 16 * 104, I_OUT = 16 * 32, NITEMS = 2 * I_IN + 2 * I_OUT;
        for (int it = gw; it < NITEMS; it += NGW) {
            const float* Wsrc; u16* Wdst; int N_, r; bool perm;
            if (it < I_IN) { Wsrc = KIN(6); Wdst = (u16*)(ws + WS_WIN0); N_ = NIN; r = it; perm = true; }
            else if (it < 2 * I_IN) { Wsrc = KIN(11); Wdst = (u16*)(ws + WS_WIN1); N_ = NIN; r = it - I_IN; perm = true; }
            else if (it < 2 * I_IN + I_OUT) { Wsrc = KIN(7); Wdst = (u16*)(ws + WS_WOUT0); N_ = 1024; r = it - 2 * I_IN; perm = false; }
            else { Wsrc = KIN(12); Wdst = (u16*)(ws + WS_WOUT1); N_ = 1024; r = it - 2 * I_IN - I_OUT; perm = false; }
            p0_transpose_item(Wsrc, 1024, N_, Wdst, perm, scr, r, lane);
        }
    }
#endif
    GRID_BAR();

    for (int layer = 0; layer < 2; ++layer) {
#ifndef SKIP_H
        {
            PH_IDS
            const float* modl = W_MOD + (size_t)layer * 5 * 3072; u16* H = W_H;
            const float* xs = layer == 0 ? KIN(0) : KOUT; const float* cs = layer == 0 ? KIN(2) : W_XC1;
            for (int R = gw; R < RT; R += NGW) {
                const int b = R / SE, t = R % SE;
                const float* src; const float* mv;
                if (t < SEQ) { src = xs + ((size_t)b * SEQ + t) * DM; mv = modl + b * 3072; } else { src = cs + ((size_t)b * CTXL + (t - SEQ)) * DM; mv = modl + 4 * 3072; }
                f32x4 v[4]; float ss = 0.f;
#pragma unroll
                for (int j = 0; j < 4; ++j) { v[j] = *(const f32x4*)(src + 4 * lane + 256 * j); ss += (v[j].x * v[j].x + v[j].y * v[j].y) + (v[j].z * v[j].z + v[j].w * v[j].w); }
                const float rstd = 1.0f / sqrtf(wave_sum(ss) * (1.0f / DM) + 1e-6f);
#pragma unroll
                for (int j = 0; j < 4; ++j) { const f32x4 sh = *(const f32x4*)(mv + 4 * lane + 256 * j), sc = *(const f32x4*)(mv + 1024 + 4 * lane + 256 * j);
                    const f32x4 h = v[j] * rstd * (sc + 1.0f) + sh;
                    *(unsigned long long*)(H + (size_t)R * DM + 4 * lane + 256 * j) = (unsigned long long)pk2(h.x, h.y) | ((unsigned long long)pk2(h.z, h.w) << 32); }
            }
        }
#endif
        GRID_BAR();
#ifndef SKIP_G1
        {
            KP_DECL
            pg8::Gemm g{W_H, (const u16*)(ws + (layer == 0 ? WS_WIN0 : WS_WIN1)), RT, NIN, DM}; pg8::StaticOrder S; S.init(RT, NIN, G, bx);
            pg8::EpiQKV E{W_QKV, W_Y, W_ROPEC, W_ROPES, KIN(8), KIN(9), layer};
            pg8::gemm_phase<pg8::EpiQKV, pg8::StaticOrder, true, true>(lds, g, S, E);
        }
#endif
        GRID_BAR();
#ifndef SKIP_ATT
        {
            PH_IDS
            const u16* QKV = W_QKV; u16* Y = W_Y; float* OC = W_OC; const float* rpb = KIN(10); const float* sinks = KIN(15);
            const wa::lptr slot = lds + wave * 16384; LAS float* wsf = (LAS float*)(lds + SCR_OFF + wave * 256);
            const int r32 = lane & 31, hi = lane >> 5;
            if (layer == 0) {
                LAS float* biasT = (LAS float*)(lds + BIAS_OFF);
                for (int i = tid; i < 8 * 465; i += 512) biasT[i] = rpb[i] * LOG2E;
                __syncthreads();
#ifndef OLD_A
                for (int uid = vcu; uid < 1024; uid += G) {
                    const int i = uid >> 8, g = (uid & 255) >> 5, s = uid & 31, b = g >> 1, kv = g & 1, hq = kv * 4 + i; const u16* base = QKV + (size_t)b * SE * NQKV;
                    const fa::OutMulY o_{Y + ((size_t)b * SE + s * 256) * DM + hq * 64};
                    fa::attn_unit<FA_THR>((const fa::bf16*)(base + (size_t)(s * 256) * NQKV + hq * 64), (const fa::bf16*)(base + 512 + kv * 64), (const fa::bf16*)(base + 640 + kv * 64), 132, (char*)lds_raw, o_);
                }
                for (int u = 8192 + gw; u < 16896; u += NGW) {
#else
                for (int u = gw; u < 16896; u += NGW) {
#endif
                    wa::State st; st.m = -INFINITY; st.l = 0.f; float rl[16];
                    if (u < 8192) {
                        const int b = u >> 11, hq = (u >> 8) & 7, qb = u & 255; const u16* base = QKV + (size_t)b * SE * NQKV;
                        wa::SpecPlain sp{base + 512 + (hq >> 2) * 64, base + 640 + (hq >> 2) * 64, 132};
                        wa::run(sp, base + (size_t)(qb * 32 + r32) * NQKV + hq * 64, st, slot, wsf, lane, nullptr, KSEL_MIX == 0);
                        wa::row_recip(st, rl, wsf, lane);
#ifdef ABL_A
                        for (int r = 0; r < 16; ++r) rl[r] = 0.f;
#endif
                        wa::store_mul(st, rl, Y + ((size_t)b * SE + qb * 32) * DM + hq * 64, slot, lane);
                    } else if (u < 16384) {
                        const int v = u - 8192, b = v >> 11, h = (v >> 8) & 7, qb = v & 255; const u16* base = QKV + (size_t)b * SE * NQKV;
                        const int r = qb >> 1, c = 32 * (qb & 1) + r32, rs = min(max(r - 4, 0), 120), cs = min(max(c - 8, 0), 48);
                        wa::SpecNA sp{base + 1280 + h * 64, base + 1792 + h * 64, r, rs, c, cs, biasT + h * 465};
                        wa::run(sp, base + (size_t)(qb * 32 + r32) * NQKV + 768 + h * 64, st, slot, wsf, lane, nullptr, KSEL_MIX == 1);
                        wa::row_recip(st, rl, wsf, lane);
#ifdef ABL_B
                        for (int r = 0; r < 16; ++r) rl[r] = 0.f;
#endif
#ifndef SC_B
                        wa::store_mul(st, rl, Y + ((size_t)b * SE + qb * 32) * DM + 512 + h * 64, slot, lane);
#endif
                    } else {
                        const int v = u - 16384, isb = v >> 8, w = v & 255, b = w >> 6, h = (w >> 3) & 7, qb = w & 7; const u16* base = QKV + ((size_t)b * SE + SEQ) * NQKV;
                        const int kc = isb ? 1280 + h * 64 : 512 + (h >> 2) * 64, vc = isb ? 1792 + h * 64 : 640 + (h >> 2) * 64, qc = isb ? 768 + h * 64 : h * 64;
                        wa::SpecPlain sp{base + kc, base + vc, 4};
                        wa::run(sp, base + (size_t)(qb * 32 + r32) * NQKV + qc, st, slot, wsf, lane, nullptr, KSEL_MIX == 2);
                        wa::row_recip(st, rl, wsf, lane);
                        wa::store_mul(st, rl, Y + ((size_t)b * SE + SEQ + qb * 32) * DM + isb * 512 + h * 64, slot, lane);
                    }
                }
            } else {
#ifndef OLD_C
                for (int uid = vcu; uid < 2048; uid += G) {
                    const int i = uid >> 8, g = (uid & 255) >> 5, s = uid & 31, bh = 2 * g + (i >> 2), b = bh >> 2, h = bh & 3, m = (i >> 1) & 1, vh = i & 1; const u16* base = QKV + (size_t)b * SE * NQKV;
                    const fa::OutF32 o_{OC + ((size_t)b * SEQ + s * 256) * 1024 + h * 256 + m * 128 + vh * 64};
                    fa::attn_unit<FA_THR>((const fa::bf16*)(base + (size_t)(s * 256) * NQKV + (2 * h + m) * 64), (const fa::bf16*)(base + 512 + (2 * h + m) * 64), (const fa::bf16*)(base + 1024 + h * 128 + vh * 64), 132, (char*)lds_raw, o_);
                }
                for (int u = 16384 + gw; u < 24576; u += NGW) {
#else
                for (int u = gw; u < 24576; u += NGW) {
#endif
                    wa::State st; float rl[16];
                    if (u < 16384) {
                        const int b = u >> 12, pp = (u >> 8) & 15, qb = u & 255, h = pp >> 2, m = (pp >> 1) & 1, vh = pp & 1; const u16* base = QKV + (size_t)b * SE * NQKV;
                        st.m = -INFINITY; st.l = 0.f;
                        wa::SpecPlain sp{base + 512 + (2 * h + m) * 64, base + 1024 + h * 128 + vh * 64, 132};
                        wa::run(sp, base + (size_t)(qb * 32 + r32) * NQKV + (2 * h + m) * 64, st, slot, wsf, lane, nullptr, KSEL_MIX == 3);
                        wa::row_recip(st, rl, wsf, lane);
                        float* op = OC + ((size_t)b * SEQ + qb * 32) * 1024 + h * 256 + m * 128 + vh * 64 + r32;
#pragma unroll
                        for (int r = 0; r < 16; ++r) { const int q = wa::crow(r, hi); op[(size_t)q * 1024] = st.o[0][r] * rl[r]; op[(size_t)q * 1024 + 32] = st.o[1][r] * rl[r]; }
                    } else {
                        const int v = u - 16384, b = v >> 11, hq = (v >> 8) & 7, qb = v & 255, t0 = qb * 32; const u16* base = QKV + (size_t)b * SE * NQKV;
                        const int first = (t0 - 128) & ~63, ilo = first < 0 ? (-first) >> 6 : 0, ihi = min(4, (SEQ - 64 - first) >> 6);
                        st.m = sinks[hq] * LOG2E; st.l = hi == 0 ? 1.0f : 0.0f;
#ifdef CTXONLY_D
                        st.m = -INFINITY; st.l = 0.f;
                        wa::SpecWin sp{base + 2048 + (hq >> 2) * 64, base + 2176 + (hq >> 2) * 64, first + 64 * ilo, 0, t0 + r32};
#else
                        wa::SpecWin sp{base + 2048 + (hq >> 2) * 64, base + 2176 + (hq >> 2) * 64, first + 64 * ilo, ihi - ilo + 1, t0 + r32};
#endif
#ifdef DUMP_S
                        wa::run(sp, base + (size_t)(t0 + r32) * NQKV + 1536 + hq * 64, st, slot, wsf, lane, b == 0 ? (float*)(ws + WS_H + 32 * MiB) + ((size_t)t0 * 8 + hq * 32) * 64 : nullptr);
#else
                        wa::run(sp, base + (size_t)(t0 + r32) * NQKV + 1536 + hq * 64, st, slot, wsf, lane, nullptr, KSEL_MIX == 4);
#endif
                        wa::row_recip(st, rl, wsf, lane);
#ifdef ABL_D
                        for (int r = 0; r < 16; ++r) rl[r] = 0.f;
#endif
#ifndef SC_D
                        wa::store_mul(st, rl, Y + ((size_t)b * SE + t0) * DM + 512 + hq * 64, slot, lane);
#endif
#ifdef DIFF_D
                        if (b == 0) { float* dp = (float*)(ws + WS_H) + (size_t)t0 * 512 + hq * 64 + r32;
                            _Pragma("unroll") for (int r = 0; r < 16; ++r) { const int q = wa::crow(r, hi); dp[(size_t)q * 512] = st.o[0][r] * rl[r]; dp[(size_t)q * 512 + 32] = st.o[1][r] * rl[r]; } }
#endif
                    }
                }
            }
#if defined(SC_B) || defined(SC_D)
            {
                const float* rpb_ = KIN(10); const float* sinks_ = KIN(15);
                for (int task = gw; task < NB * SEQ * 8; task += NGW) {
                    const int h = task & 7, row = task >> 3, b = row >> 13, t = row & 8191; const u16* base = QKV + (size_t)b * SE * NQKV;
                    float val = 0.f; bool doit = false;
#ifdef SC_B
                    if (layer == 0) {
                        const int r = t >> 6, c = t & 63, rs = min(max(r - 4, 0), 120), cs = min(max(c - 8, 0), 48);
                        auto kf = [&](int slot, int& krow, float& bias) -> bool { if (slot < 128) { const int kr = rs + (slot >> 4), kc = cs + (slot & 15); krow = kr * 64 + kc; bias = rpb_[h * 465 + (kr - r + 7) * 31 + (kc - c + 15)] * LOG2E; return true; }
                            krow = 8192 + slot - 128; bias = 0.f; return slot < 384; };
                        val = sc::row_attn<6>(base + (size_t)t * NQKV + 768 + h * 64, base + 1280 + h * 64, base + 1792 + h * 64, kf, -INFINITY, lane); doit = true;
                    }
#endif
#ifdef SC_D
                    if (layer == 1) {
                        auto kf = [&](int slot, int& krow, float& bias) -> bool { bias = 0.f; if (slot < 257) { krow = t - 128 + slot; return krow >= 0 && krow < SEQ; } krow = 8192 + slot - 257; return slot < 513; };
                        val = sc::row_attn<9>(base + (size_t)t * NQKV + 1536 + h * 64, base + 2048 + (h >> 2) * 64, base + 2176 + (h >> 2) * 64, kf, sinks_[h] * LOG2E, lane); doit = true;
                    }
#endif
                    if (doit) { u16* yp = Y + ((size_t)b * SE + t) * DM + 512 + h * 64 + lane; const float z = __builtin_bit_cast(float, (unsigned)*yp << 16); *yp = (u16)(wa::cvtpk(val * z, 0.f) & 0xffffu); }
                }
            }
#endif
        }
#endif
        GRID_BAR();
#ifdef CHK_GEMM
        if (layer == 0) {
            PH_IDS
            const u16* H = W_H; const u16* WT = (const u16*)(ws + WS_WIN0); const u16* QKV = W_QKV;
            const int c = (CHK_GEMM) * 64 + lane, tile = c >> 8, cc = c & 255, p = 256 * tile + 128 * ((cc >> 5) & 1) + 32 * (cc >> 6) + (cc & 31);
            for (int R = gw; R < RT; R += NGW) {
                float acc = 0.f;
                for (int k = 0; k < 1024; ++k) acc += __builtin_bit_cast(float, (unsigned)H[(size_t)R * 1024 + k] << 16) * __builtin_bit_cast(float, (unsigned)WT[(size_t)p * 1024 + k] << 16);
                const float got = __builtin_bit_cast(float, (unsigned)QKV[(size_t)R * NQKV + c] << 16);
                const bool badv = fabsf(got - acc) > 0.02f + 0.01f * fabsf(acc);
                const unsigned long long m = __ballot(badv);
                if (m != 0ull && lane == 0) atomicAdd((unsigned*)(ws + WS_CTL) + 64, 1u);
            }
        }
        GRID_BAR();
#endif
#ifndef DIFF_THR
#define DIFF_THR 0.05f
#endif
#ifdef DIFF_D
        if (layer == 1) {
            PH_IDS
            const u16* QKV = W_QKV; const float* sinks_ = KIN(15); const float* dbg = (const float*)(ws + WS_H);
            float md = 0.f;
            for (int task = gw; task < 8192 * 8; task += NGW) {
                const int h = task & 7, t = task >> 3; const u16* base = QKV;
#ifdef CTXONLY_D
                auto kf = [&](int slot, int& krow, float& bias) -> bool { bias = 0.f; krow = 8192 + slot; return slot < 256; };
#elif defined(NOMASK_D)
                const int t0_ = t & ~31, first_ = (t0_ - 128) & ~63, ilo_ = first_ < 0 ? (-first_) >> 6 : 0, ihi_ = min(4, (SEQ - 64 - first_) >> 6), ks0_ = first_ + 64 * ilo_, nw_ = ihi_ - ilo_ + 1;
                auto kf = [&](int slot, int& krow, float& bias) -> bool { bias = 0.f; if (slot < 320) { krow = ks0_ + slot; return slot < 64 * nw_; } krow = 8192 + slot - 320; return slot < 576; };
#else
                auto kf = [&](int slot, int& krow, float& bias) -> bool { bias = 0.f; if (slot < 257) { krow = t - 128 + slot; return krow >= 0 && krow < SEQ; } krow = 8192 + slot - 257; return slot < 513; };
#endif
                const float val = sc::row_attn<9>(base + (size_t)t * NQKV + 1536 + h * 64, base + 2048 + (h >> 2) * 64, base + 2176 + (h >> 2) * 64, kf,
#ifdef CTXONLY_D
                    -INFINITY,
#else
                    sinks_[h] * LOG2E,
#endif
                    lane);
#ifdef DUMP_S
                float sdiff = 0.f;
                { const float qd = __builtin_bit_cast(float, (unsigned)(base + (size_t)t * NQKV + 1536 + h * 64)[lane] << 16);
                  const float* ds_ = (const float*)(ws + WS_H + 32 * MiB) + ((size_t)(t & ~31) * 8 + h * 32 + (t & 31)) * 64;
                  for (int kk = 0; kk < 64; ++kk) { int row; float bias; kf(kk, row, bias); const float kd = __builtin_bit_cast(float, (unsigned)(base + 2048 + (h >> 2) * 64)[(size_t)row * 2304 + lane] << 16);
                      const float sref = sc::wsum(qd * kd); sdiff = fmaxf(sdiff, fabsf(sref - ds_[kk])); } }
#endif
                const float dd = sc::wmax(fabsf(val - dbg[(size_t)t * 512 + h * 64 + lane]));
#ifdef DUMP_S
                if (sdiff > DIFF_THR && lane == 0) {
#else
                if (dd > DIFF_THR && lane == 0) {
#endif
#if DIFF_D == 1
                    atomicAdd((unsigned*)(ws + WS_CTL) + 64, 1u);
#elif DIFF_D == 2
                    atomicMax((unsigned*)(ws + WS_CTL) + 64, (unsigned)(8191 - t));
#elif DIFF_D == 3
                    atomicMax((unsigned*)(ws + WS_CTL) + 64, (unsigned)t);
#elif DIFF_D == 4
                    atomicOr((unsigned*)(ws + WS_CTL) + 64, 1u << (t & 31));
#elif DIFF_D == 5
                    atomicOr((unsigned*)(ws + WS_CTL) + 64, (1u << h) | (1u << (8 + ((t >> 5) & 1))));
#endif
                }
                md = dd;
            }
            (void)md;
        }
        GRID_BAR();
#endif
#ifndef SKIP_CMB
        if (layer == 1) {
            PH_IDS
            const float* clam = KIN(13); const float* subln = KIN(14); const float* OC = W_OC; u16* Y = W_Y;
            float lam;
            { const float a = clam[lane] * clam[64 + lane], b2 = clam[128 + lane] * clam[192 + lane]; lam = expf(wave_sum(a)) - expf(wave_sum(b2)) + LAM0; }
            const f32x2 g2 = *(const f32x2*)(subln + 2 * lane);
            for (int row = gw; row < NB * SEQ; row += NGW) {
                const int b = row >> 13, t = row & 8191; const size_t R = (size_t)b * SE + t;
#pragma unroll
                for (int h = 0; h < 4; ++h) {
                    const float* o0 = OC + (size_t)row * 1024 + h * 256 + 2 * lane; const f32x2 a = *(const f32x2*)o0, c2 = *(const f32x2*)(o0 + 128);
                    const f32x2 v = a - c2 * lam; const float rstd = 1.0f / sqrtf(wave_sum(v.x * v.x + v.y * v.y) * (1.0f / 128.0f) + 1e-6f);
                    const f32x2 o = v * rstd * g2 * (1.0f - LAM0);
                    unsigned* yp = (unsigned*)(Y + R * DM + h * 128 + 2 * lane); const unsigned yv = *yp;
                    *yp = wa::cvtpk(o.x * wa::bflo(yv), o.y * wa::bfhi(yv));
                }
            }
            GRID_BAR();
        }
#endif
#ifndef SKIP_G2
        {
            KP_DECL
            pg8::Gemm g{W_Y, (const u16*)(ws + (layer == 0 ? WS_WOUT0 : WS_WOUT1)), RT, DM, DM}; pg8::FlexOrder S; S.init(DM, G, bx, layer);
            pg8::EpiOut E{layer == 0 ? KIN(0) : KOUT, KOUT, KIN(2), W_XC1, W_MOD + (size_t)layer * 5 * 3072};
            pg8::gemm_phase<pg8::EpiOut, pg8::FlexOrder, true, true>(lds, g, S, E);
        }
#endif
        GRID_BAR();
    }
    PH_IDS
    float* out = KOUT; const float* fnorm = KIN(16);
    const float bad = (__hip_atomic_load((unsigned*)(ws + WS_CTL) + CW_BAR + XB_TMO, __ATOMIC_RELAXED, __HIP_MEMORY_SCOPE_AGENT) != 0u) ? __builtin_nanf("") : 0.f;
#if defined(DIFF_D) || defined(CHK_GEMM)
    const float dbgv = (float)__hip_atomic_load((unsigned*)(ws + WS_CTL) + 64, __ATOMIC_RELAXED, __HIP_MEMORY_SCOPE_AGENT);
#endif
    for (int row = gw; row < NB * SEQ; row += NGW) {
        float* p = out + (size_t)row * DM; f32x4 v[4]; float ss = 0.f;
#pragma unroll
        for (int j = 0; j < 4; ++j) { v[j] = *(const f32x4*)(p + 4 * lane + 256 * j); ss += (v[j].x * v[j].x + v[j].y * v[j].y) + (v[j].z * v[j].z + v[j].w * v[j].w); }
        const float rstd = 1.0f / sqrtf(wave_sum(ss) * (1.0f / DM) + 1e-6f);
#pragma unroll
        for (int j = 0; j < 4; ++j) { const f32x4 gn = *(const f32x4*)(fnorm + 4 * lane + 256 * j); *(f32x4*)(p + 4 * lane + 256 * j) = v[j] * rstd * gn + bad; }
#if defined(DIFF_D) || defined(CHK_GEMM)
        #ifdef DIFF_COARSE
        if (row == 0 && lane == 0) p[0] = (dbgv > 30000.f ? 4000.f : dbgv > 3000.f ? 3000.f : dbgv > 300.f ? 2000.f : dbgv > 30.f ? 1000.f : dbgv > 0.f ? 500.f : 0.f) + 100.0f;
#else
        if (row == 0 && lane == 0) p[0] = dbgv + 100.0f;
#endif
#endif
    }
}

extern "C" void kernel_launch(void* const* d_in, const int* in_sizes, int n_in, void* d_out, int out_size, void* d_ws, size_t ws_size, hipStream_t stream) {
    static int grid = 0;
    if (grid == 0) {
        if (n_in != 17 || in_sizes[0] != NB * SEQ * DM || out_size != NB * SEQ * DM || ws_size < WS_END) { fprintf(stderr, "kernel_launch: unexpected shapes / workspace (n_in %d, ws %zu)\n", n_in, ws_size); grid = -1; return; }
        int dev = 0, cus = 0, per_cu = 0;
        if (hipGetDevice(&dev) != hipSuccess || hipDeviceGetAttribute(&cus, hipDeviceAttributeMultiprocessorCount, dev) != hipSuccess) { grid = -1; return; }
        if (hipFuncSetAttribute((const void*)fwd_kernel, hipFuncAttributeMaxDynamicSharedMemorySize, LDS_BYTES) != hipSuccess) { fprintf(stderr, "kernel_launch: hipFuncSetAttribute failed\n"); grid = -1; return; }
        if (hipOccupancyMaxActiveBlocksPerMultiprocessor(&per_cu, (const void*)fwd_kernel, 512, LDS_BYTES) != hipSuccess || per_cu < 1) { fprintf(stderr, "kernel_launch: occupancy query says %d blocks per CU\n", per_cu); per_cu = 1; }
        (void)hipGetLastError();
        grid = cus;
    }
    if (grid < 0) return;
    if (hipMemsetAsync((char*)d_ws + WS_CTL, 0, CTL_ZERO_BYTES, stream) != hipSuccess) { fprintf(stderr, "kernel_launch: memset failed\n"); return; }
    Args a{};
    for (int i = 0; i < 17; ++i) a.in[i] = (const float*)d_in[i];
    a.out = (float*)d_out; a.ws = (unsigned char*)d_ws;
#ifdef USE_CG
    void* kargs[] = {&a};
    hipError_t e = hipLaunchCooperativeKernel((const void*)fwd_kernel, dim3(grid), dim3(512), kargs, LDS_BYTES, stream);
    if (e != hipSuccess) fprintf(stderr, "cooperative launch failed: %s\n", hipGetErrorString(e));
#else
    hipLaunchKernelGGL(fwd_kernel, dim3(grid), dim3(512), LDS_BYTES, stream, a);
#endif
}
```

```cpp
#include <hip/hip_runtime.h>
#include <hip/hip_bf16.h>
#include <hip/hip_cooperative_groups.h>
#include <cstdio>
#include <cstdint>
#include <cmath>
namespace pg8 {
#define PG8_LAS __attribute__((address_space(3)))
typedef unsigned short bf16_t;
typedef short bf16x8 __attribute__((ext_vector_type(8)));
typedef float f32x4 __attribute__((ext_vector_type(4)));
typedef unsigned u32x4 __attribute__((ext_vector_type(4)));
constexpr int BM = 256, BK = 64, HALF = 128, HTB = HALF * BK * 2  , STAGE_BYTES = 8 * HTB, NXCD = 8, WGM = 8;

__host__ __device__ __forceinline__ int lds_byte(int r, int c) { const int st = (r >> 4) * 2 + (c >> 5), rr = r & 15, cc = c & 31, ob = rr * 64 + cc * 2; return st * 1024 + (ob ^ (((ob >> 9) & 1) << 5)); }
__host__ __device__ __forceinline__ void stage_rc(int b, int& R, int& C) { const int st = b / 1024, sb = b % 1024, swz = sb ^ (((sb >> 9) & 1) << 5); R = (st >> 1) * 16 + swz / 64; C = (st & 1) * 32 + (swz % 64) / 2; }
__host__ __device__ __forceinline__ int perm32(int rho) { const int n = rho >> 4, i = rho & 15; return 8 * (i >> 2) + 4 * n + (i & 3); }

struct Unit { int pm, pn; };
struct Gemm { const bf16_t* A; const bf16_t* Bt; int M, N, K; };

struct StaticOrder {
    int nM, nN, nwg, G, c;
    __host__ __device__ void init(int M, int N, int G_, int c_) { nM = M / BM; nN = N / BM; nwg = nM * nN; G = G_; c = c_; }
    __host__ __device__ bool next(int i, Unit& u) const {
        const long L = (long)i * G + c; if (L >= nwg) return false;
        int wgid = (int)L; { const int q = nwg / NXCD, r = nwg % NXCD, xcd = wgid % NXCD, off = wgid / NXCD; wgid = (xcd < r ? xcd * (q + 1) : r * (q + 1) + (xcd - r) * q) + off; }
        const int nig = WGM * nN, gid = wgid / nig, fm = gid * WGM, gsz = (nM - fm) < WGM ? (nM - fm) : WGM;
        u.pm = fm + ((wgid % nig) % gsz); u.pn = (wgid % nig) / gsz; return true;
    }
    __device__ __forceinline__ void a_ready(const Unit&) const {}
    __device__ __forceinline__ void done(const Unit&) const {}
};

__device__ __forceinline__ unsigned cvt_pk_bf16(float lo, float hi) { unsigned r; asm volatile("v_cvt_pk_bf16_f32 %0, %1, %2" : "=v"(r) : "v"(lo), "v"(hi)); return r; }
typedef float f32x2 __attribute__((ext_vector_type(2)));
typedef unsigned u32x2 __attribute__((ext_vector_type(2)));
constexpr float QSCALE = 0.125f * 1.4426950408889634f;
constexpr int SE = 8448, NQKV = 2304, DMODEL = 1024;

struct EpiQKV {
    static constexpr bool PERM = false, AFTER_DRAIN = false;
    bf16_t* QKV; bf16_t* Y; const PG8_LAS float* tab; int layer;
    __device__ __forceinline__ void operator()(const f32x4 (&acc)[2][2][4][2], const Unit& u, int wr, int wc, int fr, int fq) const {
        asm volatile("" : "+v"(fr), "+v"(fq));
        const int c64 = u.pn * 4 + wc;
        int norm = 0; bool rope = false, scale = false, silu = false;
        if (layer == 0) { if (c64 < 8) { norm = 1; rope = true; scale = true; } else if (c64 < 10) { norm = 2; rope = true; } else if (c64 >= 12 && c64 < 20) scale = true; else if (c64 >= 36) silu = true; }
        else { if (c64 < 8) { rope = true; scale = true; } else if (c64 < 16) rope = true; else if (c64 >= 24 && c64 < 32) { rope = true; scale = true; } else if (c64 >= 32 && c64 < 34) rope = true; else if (c64 >= 36) silu = true; }
        const int pmb = u.pm % 33; const bool isctx = (pmb == 32); if (isctx) rope = false;
        const int hh = fq >> 1, gg = fq & 1, d0 = 32 * hh + 8 * gg;
        const PG8_LAS float* gain = tab + 4096 + (norm == 2 ? 64 : 0) + d0;
#pragma unroll
        for (int ai = 0; ai < 2; ++ai) {
            const int pr = pmb * 4 + ai * 2 + wr;
#pragma unroll
            for (int m = 0; m < 4; ++m) {
                const size_t R = (size_t)u.pm * 256 + ai * 128 + wr * 64 + m * 16 + fr;
                f32x4 v[2][2];
#pragma unroll
                for (int bj = 0; bj < 2; ++bj)
#pragma unroll
                    for (int n = 0; n < 2; ++n) v[bj][n] = acc[ai][bj][m][n];
                if (norm) {
                    float ss = 0.f;
#pragma unroll
                    for (int bj = 0; bj < 2; ++bj)
#pragma unroll
                        for (int n = 0; n < 2; ++n) { const f32x4 x = v[bj][n]; ss += (x[0] * x[0] + x[1] * x[1]) + (x[2] * x[2] + x[3] * x[3]); }
                    ss += __shfl_xor(ss, 16); ss += __shfl_xor(ss, 32);
                    const float rs = 1.0f / sqrtf(ss * (1.0f / 64.0f) + 1e-6f);
#pragma unroll
                    for (int bj = 0; bj < 2; ++bj)
#pragma unroll
                        for (int n = 0; n < 2; ++n) v[bj][n] = v[bj][n] * rs * *(const PG8_LAS f32x4*)(gain + 16 * n + 4 * bj);
                }
                if (rope) {
                    const int pos = hh ? (m * 16 + fr) : pr;
                    const PG8_LAS float* tp = tab + pos * 16 + 8 * gg;
#pragma unroll
                    for (int bj = 0; bj < 2; ++bj) { const f32x4 c4 = *(const PG8_LAS f32x4*)(tp + 4 * bj), s4 = *(const PG8_LAS f32x4*)(tp + 2048 + 4 * bj);
                        const f32x4 x1 = v[bj][0], x2 = v[bj][1]; v[bj][0] = x1 * c4 - x2 * s4; v[bj][1] = x1 * s4 + x2 * c4; }
                }
                if (scale) {
#pragma unroll
                    for (int bj = 0; bj < 2; ++bj)
#pragma unroll
                        for (int n = 0; n < 2; ++n) v[bj][n] = v[bj][n] * QSCALE;
                }
                bf16_t* dst;
                if (silu) {
#pragma unroll
                    for (int bj = 0; bj < 2; ++bj)
#pragma unroll
                        for (int n = 0; n < 2; ++n)
#pragma unroll
                            for (int e = 0; e < 4; ++e) { const float x = v[bj][n][e]; v[bj][n][e] = x * __builtin_amdgcn_rcpf(1.0f + __builtin_amdgcn_exp2f(-1.4426950408889634f * x)); }
                    dst = Y + R * DMODEL + (size_t)(c64 - 36) * 64 + d0;
                } else dst = QKV + R * NQKV + (size_t)c64 * 64 + d0;
#pragma unroll
                for (int n = 0; n < 2; ++n) { u32x4 w; w.x = cvt_pk_bf16(v[0][n][0], v[0][n][1]); w.y = cvt_pk_bf16(v[0][n][2], v[0][n][3]); w.z = cvt_pk_bf16(v[1][n][0], v[1][n][1]); w.w = cvt_pk_bf16(v[1][n][2], v[1][n][3]);
                    *(u32x4*)(dst + 16 * n) = w; }
                asm volatile("" ::: "memory");
            }
        }
    }
};

struct EpiProbe {
    static constexpr bool PERM = false, AFTER_DRAIN = false;
    bf16_t* O;
    __device__ __forceinline__ void operator()(const f32x4 (&acc)[2][2][4][2], const Unit& u, int wr, int wc, int fr, int fq) const {
        asm volatile("" : "+v"(fr), "+v"(fq));
#pragma unroll
        for (int ai = 0; ai < 2; ++ai)
#pragma unroll
            for (int m = 0; m < 4; ++m) { bf16_t* rowp = O + ((size_t)(u.pm & 63) * 256 + ai * 128 + wr * 64 + m * 16 + fr) * 3328 + u.pn * 256 + wc * 64 + 16 * fq;
#pragma unroll
                for (int bj = 0; bj < 2; ++bj) { u32x4 w; w.x = cvt_pk_bf16(acc[ai][bj][m][0][0], acc[ai][bj][m][0][1]); w.y = cvt_pk_bf16(acc[ai][bj][m][0][2], acc[ai][bj][m][0][3]); w.z = cvt_pk_bf16(acc[ai][bj][m][1][0], acc[ai][bj][m][1][1]); w.w = cvt_pk_bf16(acc[ai][bj][m][1][2], acc[ai][bj][m][1][3]);
                    *(u32x4*)(rowp + bj * 8) = w; }
                asm volatile("" ::: "memory"); }
    }
};

struct EpiOut {
    static constexpr bool PERM = false, AFTER_DRAIN = false;
    const float* xin; float* xout; const float* cin; float* cout; const float* mod;
    __device__ __forceinline__ void operator()(const f32x4 (&acc)[2][2][4][2], const Unit& u, int wr, int wc, int fr, int fq) const {
        asm volatile("" : "+v"(fr), "+v"(fq));
        const int pmb = u.pm % 33, b = u.pm / 33; const bool isctx = (pmb == 32);
        const float* src; float* dst; const float* gate;
        if (isctx) { src = cin + (size_t)b * 256 * DMODEL; dst = cout + (size_t)b * 256 * DMODEL; gate = mod + 4 * 3072 + 2048; }
        else { const size_t o = ((size_t)b * 8192 + (size_t)pmb * 256) * DMODEL; src = xin + o; dst = xout + o; gate = mod + b * 3072 + 2048; }
        const int col0 = u.pn * BM + wc * 32 + 4 * fq;
        f32x4 g[2][2], cur[2][2], nxt[2][2];
#pragma unroll
        for (int bj = 0; bj < 2; ++bj)
#pragma unroll
            for (int n = 0; n < 2; ++n) { g[bj][n] = *(const f32x4*)(gate + col0 + bj * HALF + n * 16); cur[bj][n] = *(const f32x4*)(src + (size_t)(wr * 64 + fr) * DMODEL + col0 + bj * HALF + n * 16); }
#pragma unroll
        for (int idx = 0; idx < 8; ++idx) { const int ai = idx >> 2, m = idx & 3; const size_t off = (size_t)(ai * HALF + wr * 64 + m * 16 + fr) * DMODEL + col0;
            if (idx < 7) { const int ai2 = (idx + 1) >> 2, m2 = (idx + 1) & 3; const size_t off2 = (size_t)(ai2 * HALF + wr * 64 + m2 * 16 + fr) * DMODEL + col0;
#pragma unroll
                for (int bj = 0; bj < 2; ++bj)
#pragma unroll
                    for (int n = 0; n < 2; ++n) nxt[bj][n] = *(const f32x4*)(src + off2 + bj * HALF + n * 16); }
#pragma unroll
            for (int bj = 0; bj < 2; ++bj)
#pragma unroll
                for (int n = 0; n < 2; ++n) { *(f32x4*)(dst + off + bj * HALF + n * 16) = cur[bj][n] + g[bj][n] * acc[ai][bj][m][n]; cur[bj][n] = nxt[bj][n]; }
            asm volatile("" ::: "memory"); }
    }
};
struct FlexOrder {
    StaticOrder base; int latent_only;
    __device__ void init(int N, int G_, int c_, int latent_only_) { latent_only = latent_only_; base.init(latent_only_ ? 4 * 8192 : 4 * SE, N, G_, c_); }
    __device__ bool next(int i, Unit& u) const { if (!base.next(i, u)) return false; if (latent_only) u.pm += u.pm >> 5; return true; }
    __device__ __forceinline__ void a_ready(const Unit&) const {}
    __device__ __forceinline__ void done(const Unit&) const {}
};
template <class Epi, class Sched, bool ALIGN_EPI = false, bool SP2 = false>
__device__ __forceinline__ void gemm_phase(PG8_LAS unsigned char* lds, const Gemm g, const Sched& S, const Epi& E) {
    int tid_ = threadIdx.x; asm volatile("" : "+v"(tid_));
    const int tid = tid_, wid = __builtin_amdgcn_readfirstlane(tid >> 6), lane = tid & 63, wr = wid >> 2, wc = wid & 3, fr = lane & 15, fq = lane >> 4;
    const int K = g.K, nt = K / BK;
    unsigned voffA[2], voffB[2];
#pragma unroll
    for (int i = 0; i < 2; ++i) { int R, C; stage_rc(tid * 16 + i * 8192, R, C); const int Rb = Epi::PERM ? ((R & ~31) + perm32(R & 31)) : R;
        voffA[i] = (unsigned)(R * K + C) * 2u; voffB[i] = (unsigned)(Rb * K + C) * 2u; }
    const size_t kstep = (size_t)(BK * 2);
    const size_t hstep = (size_t)HALF * K * 2;
    const size_t tstep = 2 * hstep;
    const unsigned ldsw = (unsigned)wid * 1024u;
    const int aoff = lds_byte(wr * 64 + fr, fq * 8), boff = lds_byte(wc * 32 + fr, fq * 8);
#define PG8_SA(b, h) (((b) * 2 + (h)) * HTB)
#define PG8_SB(b, h) ((4 + (b) * 2 + (h)) * HTB)
#define PG8_STAGE(bufoff, gbase, voff) do { _Pragma("unroll") for (int _i = 0; _i < 2; ++_i) \
        __builtin_amdgcn_global_load_lds((const unsigned*)((const char*)(gbase) + (voff)[_i]), (PG8_LAS unsigned*)(lds + (bufoff) + ldsw + _i * 8192), 16, 0, 0); } while (0)
#define PG8_LDA(dst, b, h) do { _Pragma("unroll") for (int m = 0; m < 4; ++m) _Pragma("unroll") for (int k = 0; k < 2; ++k) dst[m][k] = *(const PG8_LAS bf16x8*)(lds + PG8_SA(b, h) + aoff + m * 2048 + k * 1024); } while (0)
#define PG8_LDB(dst, b, h) do { _Pragma("unroll") for (int n = 0; n < 2; ++n) _Pragma("unroll") for (int k = 0; k < 2; ++k) dst[n][k] = *(const PG8_LAS bf16x8*)(lds + PG8_SB(b, h) + boff + n * 2048 + k * 1024); } while (0)
#define PG8_MMA(ai, bj, At, Bt) do { __builtin_amdgcn_s_setprio(1); _Pragma("unroll") for (int m = 0; m < 4; ++m) _Pragma("unroll") for (int n = 0; n < 2; ++n) _Pragma("unroll") for (int k = 0; k < 2; ++k) \
        acc[ai][bj][m][n] = __builtin_amdgcn_mfma_f32_16x16x32_bf16(Bt[n][k], At[m][k], acc[ai][bj][m][n], 0, 0, 0); __builtin_amdgcn_s_setprio(0); } while (0)
#define PG8_WAIT_V(n) asm volatile("s_waitcnt vmcnt(" #n ")" ::: "memory")
#define PG8_WAIT_L(n) asm volatile("s_waitcnt lgkmcnt(" #n ")" ::: "memory")
#define PG8_BAR __builtin_amdgcn_s_barrier()
#define PG8_SCHED __builtin_amdgcn_sched_barrier(0)
    Unit cur, nxt; int ui = 0;
    if (!S.next(0, cur)) return;
    f32x4 acc[2][2][4][2];
#pragma unroll
    for (int a = 0; a < 2; ++a)
#pragma unroll
        for (int b = 0; b < 2; ++b)
#pragma unroll
            for (int m = 0; m < 4; ++m)
#pragma unroll
                for (int n = 0; n < 2; ++n) acc[a][b][m][n] = (f32x4){0.f, 0.f, 0.f, 0.f};
    bf16x8 At[4][2], B0[2][2], B1[2][2];
    const char* cA = (const char*)g.A + (size_t)cur.pm * tstep; const char* cB = (const char*)g.Bt + (size_t)cur.pn * tstep;
    S.a_ready(cur);
    if constexpr (SP2) {
        PG8_STAGE(PG8_SB(0, 0), cB, voffB); PG8_STAGE(PG8_SB(0, 1), cB + hstep, voffB); PG8_STAGE(PG8_SA(0, 0), cA, voffA); PG8_STAGE(PG8_SA(0, 1), cA + hstep, voffA);
        if (wr == 1) PG8_BAR;
        PG8_WAIT_V(2); PG8_BAR;
        PG8_STAGE(PG8_SB(1, 0), cB + kstep, voffB); PG8_STAGE(PG8_SA(1, 0), cA + kstep, voffA); PG8_STAGE(PG8_SB(1, 1), cB + hstep + kstep, voffB);
        PG8_WAIT_V(6); PG8_BAR;
    } else {
        PG8_STAGE(PG8_SB(0, 0), cB, voffB); PG8_STAGE(PG8_SA(0, 0), cA, voffA); PG8_STAGE(PG8_SB(0, 1), cB + hstep, voffB); PG8_STAGE(PG8_SA(0, 1), cA + hstep, voffA);
        if (wr == 1) PG8_BAR;
        PG8_WAIT_V(4); PG8_BAR;
        PG8_STAGE(PG8_SB(1, 0), cB + kstep, voffB); PG8_STAGE(PG8_SA(1, 0), cA + kstep, voffA); PG8_STAGE(PG8_SB(1, 1), cB + hstep + kstep, voffB);
        PG8_WAIT_V(6); PG8_BAR;
    }
    for (;;) {
        const bool has_next = S.next(ui + 1, nxt);
        const char* nA = has_next ? (const char*)g.A + (size_t)nxt.pm * tstep : cA; const char* nB = has_next ? (const char*)g.Bt + (size_t)nxt.pn * tstep : cB;
        for (int t = 0; t < nt; t += 2) {
            const bool last = (t == nt - 2);
            const char* a1 = cA + (size_t)(t + 1) * kstep;
            const char* a2 = last ? nA : cA + (size_t)(t + 2) * kstep; const char* b2 = last ? nB : cB + (size_t)(t + 2) * kstep;
            const char* a3 = a2 + kstep; const char* b3 = b2 + kstep;
            if (last && has_next) S.a_ready(nxt);
            if constexpr (SP2) {
            PG8_LDB(B0, 0, 0); PG8_LDB(B1, 0, 1); PG8_SCHED; PG8_LDA(At, 0, 0); PG8_STAGE(PG8_SA(1, 1), a1 + hstep, voffA);
            PG8_WAIT_V(8); PG8_WAIT_L(0); PG8_BAR; PG8_MMA(0, 0, At, B0); PG8_MMA(0, 1, At, B1); PG8_BAR; PG8_SCHED;
            PG8_LDA(At, 0, 1); PG8_STAGE(PG8_SB(0, 0), b2, voffB); PG8_STAGE(PG8_SB(0, 1), b2 + hstep, voffB); PG8_STAGE(PG8_SA(0, 0), a2, voffA);
            PG8_WAIT_V(8); PG8_WAIT_L(0); PG8_BAR; PG8_MMA(1, 0, At, B0); PG8_MMA(1, 1, At, B1); PG8_BAR; PG8_SCHED;
            PG8_LDB(B0, 1, 0); PG8_LDB(B1, 1, 1); PG8_SCHED; PG8_LDA(At, 1, 0); PG8_STAGE(PG8_SA(0, 1), a2 + hstep, voffA);
            PG8_WAIT_V(8); PG8_WAIT_L(0); PG8_BAR; PG8_MMA(0, 0, At, B0); PG8_MMA(0, 1, At, B1); PG8_BAR; PG8_SCHED;
            PG8_LDA(At, 1, 1); PG8_STAGE(PG8_SB(1, 0), b3, voffB); PG8_STAGE(PG8_SB(1, 1), b3 + hstep, voffB); PG8_STAGE(PG8_SA(1, 0), a3, voffA);
            PG8_WAIT_V(8); PG8_WAIT_L(0); PG8_BAR; PG8_MMA(1, 0, At, B0); PG8_MMA(1, 1, At, B1); PG8_BAR; PG8_SCHED;
            } else {
            PG8_LDB(B0, 0, 0); PG8_SCHED; PG8_LDA(At, 0, 0); PG8_STAGE(PG8_SA(1, 1), a1 + hstep, voffA);
            PG8_WAIT_L(8); PG8_BAR; PG8_WAIT_L(0); PG8_MMA(0, 0, At, B0); PG8_BAR; PG8_SCHED;
            PG8_LDB(B1, 0, 1); PG8_STAGE(PG8_SB(0, 0), b2, voffB);
            PG8_BAR; PG8_WAIT_L(0); PG8_MMA(0, 1, At, B1); PG8_BAR;
            PG8_LDA(At, 0, 1); PG8_STAGE(PG8_SA(0, 0), a2, voffA);
            PG8_BAR; PG8_WAIT_L(0); PG8_MMA(1, 0, At, B0); PG8_BAR; PG8_SCHED;
            PG8_STAGE(PG8_SB(0, 1), b2 + hstep, voffB);
            PG8_WAIT_V(6); PG8_BAR; PG8_MMA(1, 1, At, B1); PG8_BAR;
            PG8_LDB(B0, 1, 0); PG8_SCHED; PG8_LDA(At, 1, 0); PG8_STAGE(PG8_SA(0, 1), a2 + hstep, voffA);
            PG8_WAIT_L(8); PG8_BAR; PG8_WAIT_L(0); PG8_MMA(0, 0, At, B0); PG8_BAR; PG8_SCHED;
            PG8_LDB(B1, 1, 1); PG8_STAGE(PG8_SB(1, 0), b3, voffB);
            PG8_BAR; PG8_WAIT_L(0); PG8_MMA(0, 1, At, B1); PG8_BAR;
            PG8_LDA(At, 1, 1); PG8_STAGE(PG8_SA(1, 0), a3, voffA);
            PG8_BAR; PG8_WAIT_L(0); PG8_MMA(1, 0, At, B0); PG8_BAR; PG8_SCHED;
            PG8_STAGE(PG8_SB(1, 1), b3 + hstep, voffB);
            PG8_WAIT_V(6); PG8_BAR; PG8_MMA(1, 1, At, B1); PG8_BAR;
            }
        }
        if constexpr (ALIGN_EPI) { if (wr == 0) PG8_BAR; }
        if constexpr (!Epi::AFTER_DRAIN) { E(acc, cur, wr, wc, fr, fq); S.done(cur); }
        if (!has_next) break;
#pragma unroll
        for (int a = 0; a < 2; ++a)
#pragma unroll
            for (int b = 0; b < 2; ++b)
#pragma unroll
                for (int m = 0; m < 4; ++m)
#pragma unroll
                    for (int n = 0; n < 2; ++n) acc[a][b][m][n] = (f32x4){0.f, 0.f, 0.f, 0.f};
        cur = nxt; cA = nA; cB = nB; ++ui;
        if constexpr (ALIGN_EPI) { if (wr == 1) PG8_BAR; }
    }
    PG8_WAIT_V(0);
    if constexpr (!ALIGN_EPI) { if (wr == 0) PG8_BAR; }
    PG8_BAR;
    if constexpr (Epi::AFTER_DRAIN) { E.fused(acc, cur, wr, wc, fr, fq, lds, wid, lane); S.done(cur); }
#undef PG8_SA
#undef PG8_SB
#undef PG8_STAGE
#undef PG8_LDA
#undef PG8_LDB
#undef PG8_MMA
#undef PG8_WAIT_V
#undef PG8_WAIT_L
#undef PG8_BAR
#undef PG8_SCHED
}
}
#define GAS __attribute__((address_space(1)))
#define LAS __attribute__((address_space(3)))
typedef unsigned short bf16;
typedef unsigned v4u __attribute__((ext_vector_type(4)));
typedef float f32x4 __attribute__((ext_vector_type(4)));
typedef short bf16x8 __attribute__((ext_vector_type(8)));
typedef GAS unsigned gu32;
typedef GAS unsigned long long gu64;
#define RLX_AGENT __ATOMIC_RELAXED, __HIP_MEMORY_SCOPE_AGENT
#define LDS_WAIT() asm volatile("s_waitcnt lgkmcnt(0)" ::: "memory")
#define VM_WAIT() asm volatile("s_waitcnt vmcnt(0)" ::: "memory")
__device__ __forceinline__ unsigned long long rt() { return __builtin_amdgcn_s_memrealtime(); }
__device__ __forceinline__ unsigned f2bf(float f) { unsigned u = __builtin_bit_cast(unsigned, f); return (u + 0x7fffu + ((u >> 16) & 1u)) >> 16; }
__device__ __forceinline__ unsigned pk2(float lo, float hi) { return f2bf(lo) | (f2bf(hi) << 16); }
#define XB_TMO      128
#define XB_XCNT(j)  (256  + 64 * (j))
#define XB_XSUB(j)  (1280 + 64 * (j))
#define XB_XGEN(j)  (2304 + 64 * (j))
#define XB_TOP      3328
#define XB_TOPGEN   3392
#define XCD_BAR_WORDS 3456
#define XB_SPIN_CAP (1u << 18)

__device__ __forceinline__ unsigned xb_ld(unsigned* p)              { return __hip_atomic_load(p, __ATOMIC_RELAXED, __HIP_MEMORY_SCOPE_AGENT); }
__device__ __forceinline__ unsigned xb_add(unsigned* p, unsigned v) { return __hip_atomic_fetch_add(p, v, __ATOMIC_RELAXED, __HIP_MEMORY_SCOPE_AGENT); }
__device__ __forceinline__ unsigned xb_xcc_id() { return (unsigned)__builtin_amdgcn_s_getreg((3 << 11) | 20) & 0xFu; }
#define XB_SPIN(cond, bar) do { unsigned _sp = 0; while (cond) { __builtin_amdgcn_s_sleep(1); \
    if ((++_sp & 255u) == 0u) { if (xb_ld(&(bar)[XB_TMO])) break; if (_sp > XB_SPIN_CAP) { atomicAdd(&(bar)[XB_TMO], 1u); break; } } } } while (0)

struct XcdBarrier {
    unsigned* bar; unsigned x;
    volatile LAS unsigned* st;
};

__device__ __forceinline__ XcdBarrier xcd_barrier_post(unsigned* bar, volatile LAS unsigned* st) {
    XcdBarrier b; b.bar = bar; b.x = xb_xcc_id(); b.st = st;
    if (threadIdx.x == 0) (void)xb_add(&bar[XB_XCNT(b.x)], 1u);
    return b;
}
__device__ __forceinline__ void xcd_barrier_complete(unsigned* bar, unsigned x, unsigned& nloc, unsigned& nx) {
    const unsigned G = gridDim.x * gridDim.y * gridDim.z;
    unsigned sum, cnt, mine, sp = 0u;
    for (;;) {
        sum = 0u; cnt = 0u; mine = 0u;
#pragma unroll
        for (unsigned j = 0; j < 16; ++j) { const unsigned c = xb_ld(&bar[XB_XCNT(j)]); sum += c; cnt += (c > 0u) ? 1u : 0u; mine = (j == x) ? c : mine; }
        if (sum == G) break;
        __builtin_amdgcn_s_sleep(1);
        if ((++sp & 255u) == 0u) { if (xb_ld(&bar[XB_TMO])) break; if (sp > XB_SPIN_CAP) { atomicAdd(&bar[XB_TMO], 1u); break; } }
    }
    nloc = mine > 0u ? mine : 1u; nx = cnt > 0u ? cnt : 1u;
}

__device__ __forceinline__ void xcd_barrier(const XcdBarrier& b) {
    asm volatile("s_waitcnt vmcnt(0)" ::: "memory");
    __syncthreads();
    if (threadIdx.x == 0) {
        unsigned* bar = b.bar;
        __builtin_amdgcn_s_waitcnt(0);
        unsigned nloc = b.st[0], nx = b.st[1];
        if (nloc == 0u) { xcd_barrier_complete(bar, b.x, nloc, nx); b.st[0] = nloc; b.st[1] = nx; }
        const unsigned old = xb_add(&bar[XB_XSUB(b.x)], 1u);
        const unsigned gen = old / nloc;
        if (old + 1u == (gen + 1u) * nloc) {
            __builtin_amdgcn_fence(__ATOMIC_RELEASE, "agent");
            asm volatile("s_waitcnt vmcnt(0)" ::: "memory");
            const unsigned og = xb_add(&bar[XB_TOP], 1u);
            const unsigned tg = og / nx;
            if (og + 1u == (tg + 1u) * nx) xb_add(&bar[XB_TOPGEN], 1u);
            else XB_SPIN(xb_ld(&bar[XB_TOPGEN]) == tg, bar);
            __builtin_amdgcn_fence(__ATOMIC_ACQUIRE, "agent");
            xb_add(&bar[XB_XGEN(b.x)], 1u);
            asm volatile("s_waitcnt vmcnt(0)" ::: "memory");
        } else {
            XB_SPIN(xb_ld(&bar[XB_XGEN(b.x)]) == gen, bar);
            __builtin_amdgcn_fence(__ATOMIC_ACQUIRE, "agent");
            asm volatile("s_waitcnt vmcnt(0)" ::: "memory");
        }
    }
    __syncthreads();
}
namespace wa {
typedef unsigned short u16;
typedef short bf16x8 __attribute__((ext_vector_type(8)));
typedef short s16x4 __attribute__((ext_vector_type(4)));
typedef float f32x16 __attribute__((ext_vector_type(16)));
typedef unsigned u32x4 __attribute__((ext_vector_type(4)));
typedef __attribute__((address_space(3))) unsigned char* lptr;
#define WA_LAS __attribute__((address_space(3)))
__device__ __forceinline__ int crow(int r, int hi) { return (r & 3) + 8 * (r >> 2) + 4 * hi; }
typedef float f32x2_t __attribute__((ext_vector_type(2))); typedef __bf16 bf16x2_t __attribute__((ext_vector_type(2)));
__device__ __forceinline__ unsigned cvtpk(float lo, float hi) { f32x2_t v = {lo, hi}; bf16x2_t b = __builtin_convertvector(v, bf16x2_t); return __builtin_bit_cast(unsigned, b); }
__device__ __forceinline__ float bflo(unsigned w) { return __builtin_bit_cast(float, w << 16); }
__device__ __forceinline__ float bfhi(unsigned w) { return __builtin_bit_cast(float, w & 0xffff0000u); }

struct TileRegs { u32x4 k[8], v[8]; };
constexpr unsigned PITCH = 2304;
__device__ __forceinline__ void tile_load(TileRegs& t, const u16* Kp, const u16* Vp, unsigned koff, unsigned voff) {
#pragma unroll
    for (int i = 0; i < 8; ++i) t.k[i] = *(const u32x4*)(Kp + (size_t)(8 * i) * PITCH + koff);
#pragma unroll
    for (int pc = 0; pc < 8; ++pc) t.v[pc] = *(const u32x4*)(Vp + (size_t)(16 * (pc & 3)) * PITCH + (pc >> 2) * 32 + voff);
}
__device__ __forceinline__ void tile_store(const TileRegs& t, lptr slot, int lane) {
#pragma unroll
    for (int i = 0; i < 8; ++i) *(WA_LAS u32x4*)(slot + (lane & 7) * 1024 + (8 * i + (lane >> 3)) * 16) = t.k[i];
#pragma unroll
    for (int pc = 0; pc < 8; ++pc) *(WA_LAS u32x4*)(slot + 8192 + pc * 1024 + lane * 16) = t.v[pc];
}
__device__ __forceinline__ void qkt(f32x16& p0, f32x16& p1, lptr slot, const bf16x8 (&qr)[4], int r32, int hi) {
    const lptr kb = slot + hi * 1024 + r32 * 16;
    const f32x16 z = {0.f, 0.f, 0.f, 0.f, 0.f, 0.f, 0.f, 0.f, 0.f, 0.f, 0.f, 0.f, 0.f, 0.f, 0.f, 0.f};
    p0 = z; p1 = z;
#pragma unroll
    for (int d0 = 0; d0 < 4; ++d0) {
        const bf16x8 b0 = *(const WA_LAS bf16x8*)(kb + d0 * 2048);
        const bf16x8 b1 = *(const WA_LAS bf16x8*)(kb + d0 * 2048 + 512);
        p0 = __builtin_amdgcn_mfma_f32_32x32x16_bf16(b0, qr[d0], p0, 0, 0, 0);
        p1 = __builtin_amdgcn_mfma_f32_32x32x16_bf16(b1, qr[d0], p1, 0, 0, 0);
    }
}
typedef short v4i16_t __attribute__((ext_vector_type(4)));
__device__ __forceinline__ s16x4 vtr(lptr p) { return __builtin_bit_cast(s16x4, __builtin_amdgcn_ds_read_tr16_b64_v4i16((WA_LAS v4i16_t*)p)); }
__device__ __forceinline__ void pv(f32x16 (&o)[2], lptr slot, const u32x4 (&pw)[4], int lane) {
    const int hi = lane >> 5;
    const lptr vb = slot + 8192 + ((lane >> 4) & 1) * 32 + (lane & 3) * 8 + (4 * hi + ((lane & 15) >> 2)) * 64;
#pragma unroll
    for (int d0 = 0; d0 < 2; ++d0)
#pragma unroll
        for (int ks = 0; ks < 4; ++ks) {
            const s16x4 lo = vtr(vb + d0 * 4096 + ks * 1024), hh = vtr(vb + d0 * 4096 + ks * 1024 + 512);
            const bf16x8 vf = (bf16x8){lo[0], lo[1], lo[2], lo[3], hh[0], hh[1], hh[2], hh[3]};
            o[d0] = __builtin_amdgcn_mfma_f32_32x32x16_bf16(__builtin_bit_cast(bf16x8, pw[ks]), vf, o[d0], 0, 0, 0);
        }
}
__device__ __forceinline__ void xhalf(float mine, float& other) {
    unsigned x = __builtin_bit_cast(unsigned, mine), y = x; asm volatile("" : "+v"(y));
    auto rr = __builtin_amdgcn_permlane32_swap(x, y, false, false);
    const unsigned lo = rr[0], hi = rr[1];
    other = __builtin_bit_cast(float, (__builtin_amdgcn_mbcnt_hi(~0u, __builtin_amdgcn_mbcnt_lo(~0u, 0u)) < 32u) ? hi : lo);
}
__device__ __forceinline__ float rowmax(const f32x16& p0, const f32x16& p1) {
    float a = fmaxf(p0[0], p1[0]);
#pragma unroll
    for (int r = 1; r < 16; ++r) a = fmaxf(a, fmaxf(p0[r], p1[r]));
    float other; xhalf(a, other);
    return fmaxf(a, other);
}
struct State { f32x16 o[2]; float m, l; };
__device__ __forceinline__ void sm_pv(State& st, f32x16& p0, f32x16& p1, lptr slot, WA_LAS float* wsf, int lane) {
    const int r32 = lane & 31, hi = lane >> 5;
    const float rm = rowmax(p0, p1);
    const float mnew = fmaxf(st.m, rm);
    const float ms = (mnew == -INFINITY) ? 0.f : mnew;
    const float alpha = __builtin_amdgcn_exp2f(st.m - ms);
    st.m = mnew;
    float ps = 0.f;
#pragma unroll
    for (int r = 0; r < 16; ++r) { p0[r] = __builtin_amdgcn_exp2f(p0[r] - ms); p1[r] = __builtin_amdgcn_exp2f(p1[r] - ms); ps += p0[r] + p1[r]; }
    st.l = st.l * alpha + ps;
    if (!__all(alpha == 1.0f)) {
        if (hi == 0) wsf[r32] = alpha;
#pragma unroll
        for (int r = 0; r < 16; ++r) { const float f = wsf[crow(r, hi)]; st.o[0][r] *= f; st.o[1][r] *= f; }
    }
    u32x4 pw[4];
#pragma unroll
    for (int i = 0; i < 4; ++i) { pw[0][i] = cvtpk(p0[2 * i], p0[2 * i + 1]); pw[1][i] = cvtpk(p0[8 + 2 * i], p0[9 + 2 * i]); pw[2][i] = cvtpk(p1[2 * i], p1[2 * i + 1]); pw[3][i] = cvtpk(p1[8 + 2 * i], p1[9 + 2 * i]); }
    pv(st.o, slot, pw, lane);
}
__device__ __forceinline__ void row_recip(const State& st, float (&rl)[16], WA_LAS float* wsf, int lane) {
    const int r32 = lane & 31, hi = lane >> 5;
    float other; xhalf(st.l, other);
    const float lt = st.l + other;
    if (hi == 0) wsf[32 + r32] = lt;
#pragma unroll
    for (int r = 0; r < 16; ++r) rl[r] = 1.0f / wsf[32 + crow(r, hi)];
}
__device__ __forceinline__ void store_mul(const State& st, const float (&rl)[16], u16* Yp, lptr stg_, int lane) {
    const int r32 = lane & 31, hi = lane >> 5; WA_LAS u16* stg = (WA_LAS u16*)stg_;
#pragma unroll
    for (int r = 0; r < 16; ++r) { const int orow = crow(r, hi);
#pragma unroll
        for (int d0 = 0; d0 < 2; ++d0) stg[orow * 64 + d0 * 32 + r32] = (u16)(cvtpk(st.o[d0][r] * rl[r], 0.f) & 0xffffu); }
    asm volatile("s_waitcnt lgkmcnt(0)" ::: "memory");
#pragma unroll
    for (int i = 0; i < 4; ++i) { const int row = i * 8 + (lane >> 3), ch = lane & 7;
        const u32x4 a = *(const WA_LAS u32x4*)(stg + row * 64 + ch * 8); u32x4* gp = (u32x4*)(Yp + (size_t)row * 1024 + ch * 8); const u32x4 y = *gp; u32x4 w;
#pragma unroll
        for (int e = 0; e < 4; ++e) w[e] = cvtpk(bflo(a[e]) * bflo(y[e]), bfhi(a[e]) * bfhi(y[e]));
        *gp = w; }
}

struct SpecPlain {
    const u16 *K, *V; int n;
    __device__ __forceinline__ int nt() const { return n; }
    __device__ __forceinline__ void tile(int j, const u16*& Kp, const u16*& Vp) const { Kp = K + (size_t)(64 * j) * PITCH; Vp = V + (size_t)(64 * j) * PITCH; }
    __device__ __forceinline__ void mask(int, f32x16&, f32x16&, int) const {}
};
struct SpecNA {
    const u16 *K, *V;
    int r, rs, c, cs; const WA_LAS float* bias;
    __device__ __forceinline__ int nt() const { return 12; }
    __device__ __forceinline__ void tile(int j, const u16*& Kp, const u16*& Vp) const { const int row = (j < 8) ? 64 * (rs + j) : 8192 + 64 * (j - 8); Kp = K + (size_t)row * PITCH; Vp = V + (size_t)row * PITCH; }
    __device__ __forceinline__ void mask(int j, f32x16& p0, f32x16& p1, int hi) const {
        if (j >= 8) return;
        const int base = (rs + j - r + 7) * 31 + 15 - c;
#pragma unroll
        for (int rr = 0; rr < 16; ++rr) {
            const int k0 = crow(rr, hi), k1 = k0 + 32;
            const bool v0 = (k0 >= cs) && (k0 <= cs + 15), v1 = (k1 >= cs) && (k1 <= cs + 15);
            const float b0 = bias[v0 ? base + k0 : 0], b1 = bias[v1 ? base + k1 : 0];
            p0[rr] = v0 ? p0[rr] + b0 : -INFINITY; p1[rr] = v1 ? p1[rr] + b1 : -INFINITY;
        }
    }
};
struct SpecWin {
    const u16 *K, *V; int ks0, nw, q;
    __device__ __forceinline__ int nt() const { return nw + 4; }
    __device__ __forceinline__ void tile(int j, const u16*& Kp, const u16*& Vp) const { const int row = (j < nw) ? ks0 + 64 * j : 8192 + 64 * (j - nw); Kp = K + (size_t)row * PITCH; Vp = V + (size_t)row * PITCH; }
    __device__ __forceinline__ void mask(int j, f32x16& p0, f32x16& p1, int hi) const {
        if (j >= nw) return;
#ifdef NOMASK_D
        return;
#endif
        const int kb = ks0 + 64 * j - q;
#pragma unroll
        for (int rr = 0; rr < 16; ++rr) { const int d0 = kb + crow(rr, hi), d1 = d0 + 32;
            if (d0 < -128 || d0 > 128) p0[rr] = -INFINITY; if (d1 < -128 || d1 > 128) p1[rr] = -INFINITY; }
    }
};
template <class Spec>
__device__ __forceinline__ void run(const Spec& sp, const u16* Qp, State& st, lptr slot, WA_LAS float* wsf, int lane, float* dumpS = nullptr, bool ksel = true) {
    const int r32 = lane & 31, hi = lane >> 5;
    bf16x8 qr[4];
#pragma unroll
    for (int d0 = 0; d0 < 4; ++d0) qr[d0] = *(const bf16x8*)(Qp + d0 * 16 + hi * 8);
    const f32x16 z = {0.f, 0.f, 0.f, 0.f, 0.f, 0.f, 0.f, 0.f, 0.f, 0.f, 0.f, 0.f, 0.f, 0.f, 0.f, 0.f};
    st.o[0] = z; st.o[1] = z;
    const int nt = sp.nt();
    TileRegs tr; const u16 *Kp, *Vp;
    const unsigned koff = (unsigned)(lane >> 3) * PITCH + (lane & 7) * 8, voff = (unsigned)(lane >> 2) * PITCH + (lane & 3) * 8;
#ifndef NOPF
    sp.tile(0, Kp, Vp); tile_load(tr, Kp, Vp, koff, voff);
#endif
    for (int j = 0; j < nt; ++j) {
#ifdef NOPF
        sp.tile(j, Kp, Vp); tile_load(tr, Kp, Vp, koff, voff);
        asm volatile("s_waitcnt vmcnt(0) lgkmcnt(0)" ::: "memory");
#endif
        tile_store(tr, slot, lane);
        asm volatile("" ::: "memory");
#ifdef NOPF
        asm volatile("s_waitcnt vmcnt(0) lgkmcnt(0)" ::: "memory");
#else
        if (j + 1 < nt) { sp.tile(j + 1, Kp, Vp); tile_load(tr, Kp, Vp, koff, voff); }
#endif
        f32x16 p0, p1;
        qkt(p0, p1, slot, qr, r32, hi);
#ifdef DUMP_S
        if (dumpS && j == 0) {
#pragma unroll
            for (int r = 0; r < 16; ++r) { dumpS[(size_t)r32 * 64 + crow(r, hi)] = p0[r]; dumpS[(size_t)r32 * 64 + 32 + crow(r, hi)] = p1[r]; }
        }
#endif
#ifdef UNIFORM_P
        p0 = p0 * 0.f; p1 = p1 * 0.f;
#endif
#ifdef KSEL
        if (ksel)
#pragma unroll
        for (int r = 0; r < 16; ++r) { if (crow(r, hi) != (KSEL)) p0[r] = -INFINITY; if (crow(r, hi) + 32 != (KSEL)) p1[r] = -INFINITY; }
#endif
        sp.mask(j, p0, p1, hi);
        sm_pv(st, p0, p1, slot, wsf, lane);
        asm volatile("" ::: "memory");
    }
}
}
namespace sc {
typedef unsigned short u16;
typedef unsigned u32x4 __attribute__((ext_vector_type(4)));
__device__ __forceinline__ float wsum(float v) {
#pragma unroll
    for (int o = 1; o < 64; o <<= 1) v += __shfl_xor(v, o);
    return v;
}
__device__ __forceinline__ float wmax(float v) {
#pragma unroll
    for (int o = 1; o < 64; o <<= 1) v = fmaxf(v, __shfl_xor(v, o));
    return v;
}
__device__ __forceinline__ void unpack8(const u32x4 w, float* f) {
#pragma unroll
    for (int e = 0; e < 4; ++e) { f[2 * e] = __builtin_bit_cast(float, w[e] << 16); f[2 * e + 1] = __builtin_bit_cast(float, w[e] & 0xffff0000u); }
}
template <int NS, class KeyFn>
__device__ __forceinline__ float row_attn(const u16* Qp, const u16* Kb, const u16* Vb, const KeyFn& kf, float sink_l2, int lane) {
    const float qd = __builtin_bit_cast(float, (unsigned)Qp[lane] << 16);
    float s[NS]; float mx = sink_l2;
#pragma unroll
    for (int i = 0; i < NS; ++i) {
        s[i] = -INFINITY;
        for (int kk = 0; kk < 64; ++kk) {
            int row; float bias; const bool ok = kf(64 * i + kk, row, bias);
            if (ok) { const float kd = __builtin_bit_cast(float, (unsigned)Kb[(size_t)row * 2304 + lane] << 16); float sc_ = wsum(qd * kd) + bias;
#ifdef UNIFORM_P
                sc_ = 0.f;
#endif
#ifdef KSEL
                if (kk != (KSEL)) sc_ = -INFINITY;
#endif
                if (lane == kk) s[i] = sc_; }
        }
        mx = fmaxf(mx, s[i]);
    }
    mx = wmax(mx);
    float l = 0.f, o = 0.f;
#pragma unroll
    for (int i = 0; i < NS; ++i) {
        float p = __builtin_amdgcn_exp2f(s[i] - mx); l += p;
#ifdef SC_PBF
        { unsigned u = __builtin_bit_cast(unsigned, p); u = (u + 0x7fffu + ((u >> 16) & 1u)) & 0xffff0000u; p = __builtin_bit_cast(float, u); }
#endif
        for (int kk = 0; kk < 64; ++kk) {
            int row; float bias; const bool ok = kf(64 * i + kk, row, bias);
            const float pk = __shfl(p, kk);
            if (ok) o += pk * __builtin_bit_cast(float, (unsigned)Vb[(size_t)row * 2304 + lane] << 16);
        }
    }
    l = wsum(l) + __builtin_amdgcn_exp2f(sink_l2 - mx);
    return o / l;
}
}
namespace fa {
using bf16=__hip_bfloat16;
using bf16x8=__attribute__((ext_vector_type(8)))short;
using s16x4=__attribute__((ext_vector_type(4)))short;
using f32x16=__attribute__((ext_vector_type(16)))float;
using u32x4=__attribute__((ext_vector_type(4)))unsigned;
constexpr int D=64,DM=2304;
constexpr int NW=8,QBLK=32,QB=QBLK*NW,KVBLK=64;
__device__ __forceinline__ int crow(int r,int hi){return (r&3)+8*(r>>2)+4*hi;}
#define SBAR() __builtin_amdgcn_sched_barrier(0)
__device__ __forceinline__ void cmask(f32x16&p0,f32x16&p1,int jb,int qrel,int hi){
  const float NEG=-INFINITY; int kb=64*jb+4*hi;
  #pragma unroll
  for(int r=0;r<16;++r){int kv=kb+(r&3)+8*(r>>2); if(kv>qrel)p0[r]=NEG; if(kv+32>qrel)p1[r]=NEG;}
}

constexpr int NSLOT=3, SLOTB=8192;
constexpr int LDS_K=0, LDS_V=NSLOT*SLOTB, LDS_WS=2*NSLOT*SLOTB, LDS_OST=LDS_WS+NW*64*4, LDS_BYTES=LDS_OST+NW*4096;
constexpr float C2=0.125f*1.4426950408889634f;
__device__ __forceinline__ void glds16(const void*gsrc,unsigned lds_dst){unsigned keep;
  asm volatile("s_mov_b32 %0, m0\n\ts_mov_b32 m0, %2\n\ts_nop 0\n\tglobal_load_lds_dwordx4 %1, off\n\ts_mov_b32 m0, %0":"=&s"(keep):"v"(gsrc),"s"(lds_dst):"memory");}
__device__ __forceinline__ float max3f(float a,float b,float c){float r;asm("v_max3_f32 %0, %1, %2, %3":"=v"(r):"v"(a),"v"(b),"v"(c));return r;}
__device__ __forceinline__ float max2f(float a,float b){float r;asm("v_max_f32_e32 %0, %1, %2":"=v"(r):"v"(a),"v"(b));return r;}
__device__ __forceinline__ float fadd_s(float a,float b){float r;asm("v_add_f32_e32 %0, %1, %2":"=v"(r):"v"(a),"v"(b));return r;}
__device__ __forceinline__ float fsub_s(float a,float b){float r;asm("v_sub_f32_e32 %0, %1, %2":"=v"(r):"v"(a),"v"(b));return r;}
typedef float f32x2_t __attribute__((ext_vector_type(2))); typedef __bf16 bf16x2_t __attribute__((ext_vector_type(2)));
__device__ __forceinline__ unsigned cvtpk_s(float lo,float hi){f32x2_t v={lo,hi};bf16x2_t b=__builtin_convertvector(v,bf16x2_t);return __builtin_bit_cast(unsigned,b);}
#define WAIT_BAR(N) asm volatile("s_waitcnt vmcnt(" #N ") lgkmcnt(0)\n\ts_barrier":::"memory")

__device__ __forceinline__ void qkt(f32x16&p0,f32x16&p1,const char*Kslot,const bf16x8*qr,const f32x16&negm,int r32,int hi){
  const char*kb=Kslot+hi*1024+r32*16;
  #pragma unroll
  for(int d0=0;d0<4;++d0){
    const bf16x8 b0=*reinterpret_cast<const bf16x8*>(kb+d0*2048);
    const bf16x8 b1=*reinterpret_cast<const bf16x8*>(kb+d0*2048+512);
    if(d0==0){p0=__builtin_amdgcn_mfma_f32_32x32x16_bf16(b0,qr[0],negm,0,0,0);p1=__builtin_amdgcn_mfma_f32_32x32x16_bf16(b1,qr[0],negm,0,0,0);}
    else{p0=__builtin_amdgcn_mfma_f32_32x32x16_bf16(b0,qr[d0],p0,0,0,0);p1=__builtin_amdgcn_mfma_f32_32x32x16_bf16(b1,qr[d0],p1,0,0,0);}}
}
typedef __attribute__((address_space(3))) const char* lds_cptr;
typedef short v4i16_t __attribute__((ext_vector_type(4)));
__device__ __forceinline__ void kload8(bf16x8*kf,lds_cptr kp){
  kf[0]=*(const __attribute__((address_space(3))) bf16x8*)(kp);      kf[1]=*(const __attribute__((address_space(3))) bf16x8*)(kp+512);
  kf[2]=*(const __attribute__((address_space(3))) bf16x8*)(kp+2048); kf[3]=*(const __attribute__((address_space(3))) bf16x8*)(kp+2560);
  kf[4]=*(const __attribute__((address_space(3))) bf16x8*)(kp+4096); kf[5]=*(const __attribute__((address_space(3))) bf16x8*)(kp+4608);
  kf[6]=*(const __attribute__((address_space(3))) bf16x8*)(kp+6144); kf[7]=*(const __attribute__((address_space(3))) bf16x8*)(kp+6656);
}
__device__ __forceinline__ void kload2(bf16x8*kf,lds_cptr kp,int j){ kf[2*j]=*(const __attribute__((address_space(3))) bf16x8*)(kp+j*2048); kf[2*j+1]=*(const __attribute__((address_space(3))) bf16x8*)(kp+j*2048+512); }
__device__ __forceinline__ s16x4 vtr(lds_cptr p){ return __builtin_bit_cast(s16x4,__builtin_amdgcn_ds_read_tr16_b64_v4i16((__attribute__((address_space(3))) v4i16_t*)p)); }
__device__ __forceinline__ float xhalf(float mine){ unsigned x=__float_as_uint(mine),y=x; asm volatile("":"+v"(y)); auto rr=__builtin_amdgcn_permlane32_swap(x,y,false,false);
  const unsigned lo=rr[0],hi_=rr[1]; return __uint_as_float((__builtin_amdgcn_mbcnt_hi(~0u,__builtin_amdgcn_mbcnt_lo(~0u,0u))<32u)?hi_:lo); }
__device__ __forceinline__ float rowmax(const f32x16&p0,const f32x16&p1){
  float a=max3f(p0[0],p0[1],p1[0]),b=max3f(p0[2],p0[3],p1[1]);a=max3f(a,p1[2],p1[3]);
  #pragma unroll
  for(int r=4;r<16;r+=4){a=max3f(a,p0[r],p0[r+1]);b=max3f(b,p0[r+2],p0[r+3]);a=max3f(a,p1[r],p1[r+1]);b=max3f(b,p1[r+2],p1[r+3]);}
  const float m=max2f(a,b);
  return max2f(m,xhalf(m));
}
__device__ __forceinline__ void pv(f32x16*o,int vb,bf16x8 pa0,bf16x8 pa1,bf16x8 pa2,bf16x8 pa3){
  #pragma unroll
  for(int d0=0;d0<2;++d0){s16x4 lo[4],hi[4];
    #pragma unroll
    for(int ks=0;ks<4;++ks){
      asm volatile("ds_read_b64_tr_b16 %0,%1 offset:%c2":"=&v"(lo[ks]):"v"(vb),"i"(d0*4096+ks*1024):"memory");
      asm volatile("ds_read_b64_tr_b16 %0,%1 offset:%c2":"=&v"(hi[ks]):"v"(vb),"i"(d0*4096+ks*1024+512):"memory");}
    asm volatile("s_waitcnt lgkmcnt(0)":::"memory");SBAR();
    #define PK(k) (bf16x8){lo[k][0],lo[k][1],lo[k][2],lo[k][3],hi[k][0],hi[k][1],hi[k][2],hi[k][3]}
    o[d0]=__builtin_amdgcn_mfma_f32_32x32x16_bf16(pa0,PK(0),o[d0],0,0,0);
    o[d0]=__builtin_amdgcn_mfma_f32_32x32x16_bf16(pa1,PK(1),o[d0],0,0,0);
    o[d0]=__builtin_amdgcn_mfma_f32_32x32x16_bf16(pa2,PK(2),o[d0],0,0,0);
    o[d0]=__builtin_amdgcn_mfma_f32_32x32x16_bf16(pa3,PK(3),o[d0],0,0,0);
    #undef PK
  }
}

#ifndef ATTN_STORE16
#define ATTN_STORE16(p,v) (*(u32x4*)(p)=(v))
#endif
template<int THRL,class Out> __device__ __forceinline__ void attn_unit(const bf16*Q0,const bf16*__restrict__ Kh,const bf16*__restrict__ Vh,const int NT,char*shm,const Out&out){
  int tid_=threadIdx.x; asm volatile("":"+v"(tid_)); const int tid=tid_,lane=tid&63,r32=lane&31,hi=lane>>5; const int wid=__builtin_amdgcn_readfirstlane(tid>>6);
  const bf16*Qw=Q0+(long)(wid*QBLK)*DM;
  const unsigned lds0=(unsigned)(uintptr_t)shm;
  float*wsf=(float*)(shm+LDS_WS)+wid*64;
  const bf16*ksrc=Kh+(long)lane*DM+wid*8;
  const bf16*vsrc=Vh+(long)(16*(wid&3)+(lane>>2))*DM+(wid>>2)*32+(lane&3)*8;
  const unsigned kdst=lds0+LDS_K+wid*1024, vdst=lds0+LDS_V+wid*1024;
  #define DMA_K(t,slot) glds16(ksrc+(long)(t)*KVBLK*DM,(unsigned)__builtin_amdgcn_readfirstlane(kdst+(slot)))
  #define DMA_V(t,slot) glds16(vsrc+(long)(t)*KVBLK*DM,(unsigned)__builtin_amdgcn_readfirstlane(vdst+(slot)))
  const int vb0=(int)(lds0+LDS_V)+((lane>>4)&1)*32+(lane&3)*8+(4*hi+((lane&15)>>2))*64;
  const char*Kbase=shm+LDS_K; bf16x8 kf[8];
  const lds_cptr shm3=(lds_cptr)shm; const lds_cptr kp0=shm3+LDS_K+hi*1024+r32*16; const lds_cptr vp0=shm3+LDS_V+((lane>>4)&1)*32+(lane&3)*8+(4*hi+((lane&15)>>2))*64;
  DMA_K(0,0);DMA_V(0,0);DMA_K(1,SLOTB);
  bf16x8 qr[4];
  #pragma unroll
  for(int d0=0;d0<4;++d0)qr[d0]=*reinterpret_cast<const bf16x8*>(&Qw[(long)r32*DM+d0*16+hi*8]);
  float mhat=0.f,l_reg=0.f;f32x16 o[2];o[0]=f32x16{};o[1]=f32x16{};f32x16 negm=f32x16{};asm volatile("":"+v"(negm));
  #define CMASK(P0,P1,t) do{}while(0)
  bool resc=false;
  #define START(P0,P1) do{ const float rm=rowmax(P0,P1); resc=false; \
    { const float dl=rm; mhat=fadd_s(mhat,dl); \
      _Pragma("unroll") for(int r=0;r<16;++r){P0[r]=fsub_s(P0[r],dl);P1[r]=fsub_s(P1[r],dl);} \
      _Pragma("unroll") for(int r=0;r<16;++r)negm[r]=-mhat; asm volatile("":"+v"(negm)); } \
    _Pragma("unroll") for(int r=0;r<16;++r)P0[r]=__builtin_amdgcn_exp2f(P0[r]); }while(0)
  #define RESC() do{ if(resc){ asm volatile("s_waitcnt lgkmcnt(0)":::"memory"); \
      _Pragma("unroll") for(int d_=0;d_<2;++d_) _Pragma("unroll") for(int r=0;r<16;++r)o[d_][r]*=wsf[crow(r,hi)]; } }while(0)
  f32x16 pA0,pA1,pB0,pB1;
  int sl_prev=0,sl_cur=0,sl_next=SLOTB;
  #define ROT() do{sl_prev=sl_cur;sl_cur=sl_next;sl_next=(sl_next==(NSLOT-1)*SLOTB)?0:sl_next+SLOTB;}while(0)
  DMA_K(2,2*SLOTB);
  WAIT_BAR(3);
  qkt(pA0,pA1,Kbase,qr,negm,r32,hi);asm volatile("s_nop 15\n\ts_nop 7":"+v"(pA0),"+v"(pA1));CMASK(pA0,pA1,0);
  START(pA0,pA1);
  _Pragma("unroll") for(int r=0;r<16;++r)pA1[r]=__builtin_amdgcn_exp2f(pA1[r]);
  WAIT_BAR(0);
  DMA_K(3,0);DMA_V(1,SLOTB);
  ROT();
  kload8(kf,kp0+sl_cur);
  WAIT_BAR(2);
  s16x4 vlo[8],vhi[8]; u32x4 pw0,pw1,pw2,pw3;
  #define PKW(P,B) cvtpk_s(P[B],P[B+1])
  #define PAF(k) __builtin_bit_cast(bf16x8,pw##k)
  #define VFR(i) (bf16x8){vlo[i][0],vlo[i][1],vlo[i][2],vlo[i][3],vhi[i][0],vhi[i][1],vhi[i][2],vhi[i][3]}
  #define PIN(x) asm volatile("":"+v"(x))
  #define MX3(a,b,c) __builtin_fmaxf(__builtin_fmaxf((a),(b)),(c))
  #define GAPA(MF,A0,A1,A2,A3,W0,W1,PW) do{ MF; sacc+=A0; sacc+=A1; sacc+=A2; sacc+=A3; PIN(sacc); W0; W1; PIN(PW); SBAR(); }while(0)
  #define EX(v) __builtin_amdgcn_exp2f(v)
  #define GAPB(MF,X,B) do{ MF; X[B]=EX(X[B]); X[B+1]=EX(X[B+1]); X[B+2]=EX(X[B+2]); X[B+3]=EX(X[B+3]); PIN(X); SBAR(); }while(0)
  #define VRD(i) do{ vlo[i]=vtr(vp_+(((i)>>2)*4096+((i)&3)*1024)); vhi[i]=vtr(vp_+(((i)>>2)*4096+((i)&3)*1024+512)); }while(0)
  #define KRD(G,j) do{ if(G){ kload2(kf,kp0+sl_next,j); SBAR(); } }while(0)
  #define STEP(C0,C1,P0,P1,t,GK,GV,GL) do{ SBAR(); \
    const lds_cptr vp_=vp0+sl_prev; \
    VRD(0); SBAR(); float sacc=(P0[0]+P0[1]); \
    GAPA(C0=__builtin_amdgcn_mfma_f32_32x32x16_bf16(kf[0],qr[0],negm,0,0,0), P0[2],P0[3],P0[4],P0[5],     pw0[0]=PKW(P0,0), pw0[1]=PKW(P0,2), pw0); \
    VRD(4); SBAR(); GAPA(C1=__builtin_amdgcn_mfma_f32_32x32x16_bf16(kf[1],qr[0],negm,0,0,0), P0[6],P0[7],P0[8],P0[9],     pw0[2]=PKW(P0,4), pw0[3]=PKW(P0,6), pw0); \
    VRD(1); SBAR(); GAPA(C0=__builtin_amdgcn_mfma_f32_32x32x16_bf16(kf[2],qr[1],C0,0,0,0),   P0[10],P0[11],P0[12],P0[13], pw1[0]=PKW(P0,8), pw1[1]=PKW(P0,10), pw1); \
    VRD(5); SBAR(); GAPA(C1=__builtin_amdgcn_mfma_f32_32x32x16_bf16(kf[3],qr[1],C1,0,0,0),   P0[14],P0[15],P1[0],P1[1],   pw1[2]=PKW(P0,12),pw1[3]=PKW(P0,14), pw1); \
    VRD(2); SBAR(); GAPA(C0=__builtin_amdgcn_mfma_f32_32x32x16_bf16(kf[4],qr[2],C0,0,0,0),   P1[2],P1[3],P1[4],P1[5],     pw2[0]=PKW(P1,0), pw2[1]=PKW(P1,2), pw2); \
    VRD(6); SBAR(); GAPA(C1=__builtin_amdgcn_mfma_f32_32x32x16_bf16(kf[5],qr[2],C1,0,0,0),   P1[6],P1[7],P1[8],P1[9],     pw2[2]=PKW(P1,4), pw2[3]=PKW(P1,6), pw2); \
    VRD(3); SBAR(); GAPA(C0=__builtin_amdgcn_mfma_f32_32x32x16_bf16(kf[6],qr[3],C0,0,0,0),   P1[10],P1[11],P1[12],P1[13], pw3[0]=PKW(P1,8), pw3[1]=PKW(P1,10), pw3); \
    VRD(7); SBAR(); GAPA(C1=__builtin_amdgcn_mfma_f32_32x32x16_bf16(kf[7],qr[3],C1,0,0,0),   P1[14],P1[15],0.f,0.f,       pw3[2]=PKW(P1,12),pw3[3]=PKW(P1,14), pw3); \
    l_reg+=sacc; \
    if(GK){DMA_K((t)+3,sl_cur);} if(GV){DMA_V((t)+1,sl_next);} \
    CMASK(C0,C1,t); \
    { float a=MX3(C0[0],C0[1],C1[0]),b=MX3(C0[2],C0[3],C1[1]); a=MX3(a,C1[2],C1[3]); \
      _Pragma("unroll") for(int r=4;r<16;r+=4){a=MX3(a,C0[r],C0[r+1]);b=MX3(b,C0[r+2],C0[r+3]);a=MX3(a,C1[r],C1[r+1]);b=MX3(b,C1[r+2],C1[r+3]);} \
      float rm=__builtin_fmaxf(a,b); rm=__builtin_fmaxf(rm,xhalf(rm)); \
      resc=false; \
      if(__builtin_expect(__any(rm>(float)THRL),0)){ const float dl=__builtin_fmaxf(rm,0.f); mhat+=dl; \
        _Pragma("unroll") for(int r=0;r<16;++r){C0[r]-=dl;C1[r]-=dl;} \
        _Pragma("unroll") for(int r=0;r<16;++r)negm[r]=-mhat; asm volatile("":"+v"(negm)); \
        const float f=__builtin_amdgcn_exp2f(-dl); l_reg*=f; if(hi==0)wsf[r32]=f; resc=true; } } \
    SBAR(); \
    GAPB(o[0]=__builtin_amdgcn_mfma_f32_32x32x16_bf16(PAF(0),VFR(0),o[0],0,0,0), C0,0); \
    GAPB(o[1]=__builtin_amdgcn_mfma_f32_32x32x16_bf16(PAF(0),VFR(4),o[1],0,0,0), C0,4); \
    KRD(GL,0); GAPB(o[0]=__builtin_amdgcn_mfma_f32_32x32x16_bf16(PAF(1),VFR(1),o[0],0,0,0), C0,8); \
    KRD(GL,1); GAPB(o[1]=__builtin_amdgcn_mfma_f32_32x32x16_bf16(PAF(1),VFR(5),o[1],0,0,0), C0,12); \
    KRD(GL,2); GAPB(o[0]=__builtin_amdgcn_mfma_f32_32x32x16_bf16(PAF(2),VFR(2),o[0],0,0,0), C1,0); \
    KRD(GL,3); GAPB(o[1]=__builtin_amdgcn_mfma_f32_32x32x16_bf16(PAF(2),VFR(6),o[1],0,0,0), C1,4); \
    GAPB(o[0]=__builtin_amdgcn_mfma_f32_32x32x16_bf16(PAF(3),VFR(3),o[0],0,0,0), C1,8); \
    GAPB(o[1]=__builtin_amdgcn_mfma_f32_32x32x16_bf16(PAF(3),VFR(7),o[1],0,0,0), C1,12); \
    }while(0)
  int t=1;
  #undef CMASK
  #define CMASK(P0,P1,t) do{}while(0)
  for(;t+5<NT;t+=2){
    STEP(pB0,pB1,pA0,pA1,t,true,true,true);     WAIT_BAR(2); RESC(); ROT();
    STEP(pA0,pA1,pB0,pB1,t+1,true,true,true);   WAIT_BAR(2); RESC(); ROT();
  }
  #undef CMASK
  #define CMASK(P0,P1,t) do{}while(0)
  #define ENDW(tt) do{ if((tt)+3<NT){WAIT_BAR(2);} else if((tt)+2<NT){WAIT_BAR(1);} else {WAIT_BAR(0);} }while(0)
  for(;t+1<NT;t+=2){
    STEP(pB0,pB1,pA0,pA1,t,(t+3<NT),(t+1<NT),(t+1<NT));       ENDW(t);   RESC(); ROT();
    STEP(pA0,pA1,pB0,pB1,t+1,(t+4<NT),(t+2<NT),(t+2<NT));     ENDW(t+1); RESC(); ROT();
  }
  STEP(pB0,pB1,pA0,pA1,NT-1,false,false,false); RESC();
  { float sacc=pB0[0]+pB0[1]; _Pragma("unroll") for(int r=2;r<16;++r)sacc+=pB0[r]; _Pragma("unroll") for(int r=0;r<16;++r)sacc+=pB1[r]; l_reg+=sacc;
    pw0=(u32x4){PKW(pB0,0),PKW(pB0,2),PKW(pB0,4),PKW(pB0,6)};pw1=(u32x4){PKW(pB0,8),PKW(pB0,10),PKW(pB0,12),PKW(pB0,14)};pw2=(u32x4){PKW(pB1,0),PKW(pB1,2),PKW(pB1,4),PKW(pB1,6)};pw3=(u32x4){PKW(pB1,8),PKW(pB1,10),PKW(pB1,12),PKW(pB1,14)};
    SBAR(); pv(o,vb0+sl_cur,PAF(0),PAF(1),PAF(2),PAF(3)); }
  #undef PKW
  #undef PAF
  #undef VFR
  #undef PIN
  #undef MX3
  #undef GAPA
  #undef GAPB
  #undef EX
  #undef VRD
  #undef KRD
  #undef STEP
  #undef ENDW
  l_reg+=xhalf(l_reg);
  if(hi==0)wsf[32+r32]=l_reg;asm volatile("s_waitcnt lgkmcnt(0)":::"memory");
  float rli[16];
  #pragma unroll
  for(int r=0;r<16;++r)rli[r]=__builtin_amdgcn_rcpf(wsf[32+crow(r,hi)]);
  out(o,rli,wid,lane,shm);
  asm volatile("s_waitcnt lgkmcnt(0)\n\ts_barrier":::"memory");
  #undef DMA_K
  #undef DMA_V
  #undef CMASK
  #undef START
  #undef RESC
  #undef ROT
}
struct OutMulY {
  unsigned short* Y0;
  __device__ __forceinline__ void operator()(const f32x16 (&o)[2],const float (&rli)[16],int wid,int lane,char*shm)const{
    const int r32=lane&31,hi=lane>>5; unsigned short*stg=(unsigned short*)(shm+LDS_OST)+wid*2048;
    #pragma unroll
    for(int r=0;r<16;++r){const int orow=crow(r,hi);
      #pragma unroll
      for(int d0=0;d0<2;++d0)stg[orow*64+d0*32+r32]=(unsigned short)(cvtpk_s(o[d0][r]*rli[r],0.f)&0xffffu);}
    asm volatile("s_waitcnt lgkmcnt(0)":::"memory");
    unsigned short*Yw=Y0+(long)(wid*QBLK)*1024;
    #pragma unroll
    for(int i=0;i<4;++i){const int row=i*8+(lane>>3),ch=lane&7; const u32x4 a=*(const u32x4*)(stg+row*64+ch*8); u32x4*gp=(u32x4*)(Yw+(long)row*1024+ch*8); const u32x4 y=*gp; u32x4 w;
      #pragma unroll
      for(int e=0;e<4;++e)w[e]=cvtpk_s(__uint_as_float(a[e]<<16)*__uint_as_float(y[e]<<16),__uint_as_float(a[e]&0xffff0000u)*__uint_as_float(y[e]&0xffff0000u));
      *gp=w;}
  }
};
struct OutF32 {
  float* O0;
  __device__ __forceinline__ void operator()(const f32x16 (&o)[2],const float (&rli)[16],int wid,int lane,char*)const{
    const int r32=lane&31,hi=lane>>5; float*op=O0+(long)(wid*QBLK)*1024+r32;
    #pragma unroll
    for(int r=0;r<16;++r){const int q=crow(r,hi); op[(long)q*1024]=o[0][r]*rli[r]; op[(long)q*1024+32]=o[1][r]*rli[r];}
  }
};
constexpr int ATTN_LDS_BYTES=LDS_BYTES;
#undef SBAR
#undef WAIT_BAR
}
namespace fa {
constexpr int C_SLOTB=16384, C_LDS_K=0, C_LDS_V=NSLOT*C_SLOTB, C_LDS_WS=2*NSLOT*C_SLOTB, C_LDS_X=C_LDS_WS+NW*64*4, C_LDS_BYTES=C_LDS_X;
#define SBAR() __builtin_amdgcn_sched_barrier(0)
#define WAIT_BAR(N) asm volatile("s_waitcnt vmcnt(" #N ") lgkmcnt(0)\n\ts_barrier":::"memory")
__device__ __forceinline__ void pv4(f32x16*o,int vb,bf16x8 pa0,bf16x8 pa1,bf16x8 pa2,bf16x8 pa3){
  #pragma unroll
  for(int d0=0;d0<4;++d0){s16x4 lo[4],hi[4];
    #pragma unroll
    for(int ks=0;ks<4;++ks){
      asm volatile("ds_read_b64_tr_b16 %0,%1 offset:%c2":"=&v"(lo[ks]):"v"(vb),"i"(d0*4096+ks*1024):"memory");
      asm volatile("ds_read_b64_tr_b16 %0,%1 offset:%c2":"=&v"(hi[ks]):"v"(vb),"i"(d0*4096+ks*1024+512):"memory");}
    asm volatile("s_waitcnt lgkmcnt(0)":::"memory");SBAR();
    #define PK(k) (bf16x8){lo[k][0],lo[k][1],lo[k][2],lo[k][3],hi[k][0],hi[k][1],hi[k][2],hi[k][3]}
    o[d0]=__builtin_amdgcn_mfma_f32_32x32x16_bf16(pa0,PK(0),o[d0],0,0,0);
    o[d0]=__builtin_amdgcn_mfma_f32_32x32x16_bf16(pa1,PK(1),o[d0],0,0,0);
    o[d0]=__builtin_amdgcn_mfma_f32_32x32x16_bf16(pa2,PK(2),o[d0],0,0,0);
    o[d0]=__builtin_amdgcn_mfma_f32_32x32x16_bf16(pa3,PK(3),o[d0],0,0,0);
    #undef PK
  }
}
template<int THRL,class Out> __device__ __forceinline__ void attn_unit_c(const bf16*Q0,const bf16*__restrict__ Kh,const bf16*__restrict__ Vh,const int NT,char*shm,const Out&out){
  int tid_=threadIdx.x; asm volatile("":"+v"(tid_)); const int tid=tid_,lane=tid&63,r32=lane&31,hi=lane>>5; const int wid=__builtin_amdgcn_readfirstlane(tid>>6); const int msub=wid>>2;
  const bf16*Qw=Q0+(long)((wid&3)*QBLK)*DM+msub*64;
  const unsigned lds0=(unsigned)(uintptr_t)shm;
  float*wsf=(float*)(shm+C_LDS_WS)+wid*64;
  const bf16*ksrc=Kh+(long)lane*DM+wid*8;
  const bf16*vsrc=Vh+(long)(16*(wid&3)+(lane>>2))*DM+(wid>>2)*32+(lane&3)*8;
  const unsigned kdst=lds0+C_LDS_K+wid*1024, vdst=lds0+C_LDS_V+wid*1024;
  #define DMA_K(t,slot) do{ glds16(ksrc+(long)(t)*KVBLK*DM,(unsigned)__builtin_amdgcn_readfirstlane(kdst+(slot))); glds16(ksrc+64+(long)(t)*KVBLK*DM,(unsigned)__builtin_amdgcn_readfirstlane(kdst+(slot)+8192)); }while(0)
  #define DMA_V(t,slot) do{ glds16(vsrc+(long)(t)*KVBLK*DM,(unsigned)__builtin_amdgcn_readfirstlane(vdst+(slot))); glds16(vsrc+64+(long)(t)*KVBLK*DM,(unsigned)__builtin_amdgcn_readfirstlane(vdst+(slot)+8192)); }while(0)
  const int vb0=(int)(lds0+C_LDS_V)+((lane>>4)&1)*32+(lane&3)*8+(4*hi+((lane&15)>>2))*64;
  const char*Kbase=shm+C_LDS_K+msub*8192; bf16x8 kf[8];
  const lds_cptr shm3=(lds_cptr)shm; const lds_cptr kp0=shm3+C_LDS_K+msub*8192+hi*1024+r32*16; const lds_cptr vp0=shm3+C_LDS_V+((lane>>4)&1)*32+(lane&3)*8+(4*hi+((lane&15)>>2))*64;
  DMA_K(0,0);DMA_V(0,0);DMA_K(1,C_SLOTB);
  bf16x8 qr[4];
  #pragma unroll
  for(int d0=0;d0<4;++d0)qr[d0]=*reinterpret_cast<const bf16x8*>(&Qw[(long)r32*DM+d0*16+hi*8]);
  float mhat=0.f,l_reg=0.f;f32x16 o[4];o[0]=f32x16{};o[1]=f32x16{};o[2]=f32x16{};o[3]=f32x16{};f32x16 negm=f32x16{};asm volatile("":"+v"(negm));
  bool resc=false;
  #define RESC() do{ if(resc){ asm volatile("s_waitcnt lgkmcnt(0)":::"memory"); \
      _Pragma("unroll") for(int d_=0;d_<4;++d_) _Pragma("unroll") for(int r=0;r<16;++r)o[d_][r]*=wsf[crow(r,hi)]; } }while(0)
  f32x16 C0,C1; u32x4 pwA[4],pwB[4];
  int sl_prev=0,sl_cur=0,sl_next=C_SLOTB;
  #define ROT() do{sl_prev=sl_cur;sl_cur=sl_next;sl_next=(sl_next==(NSLOT-1)*C_SLOTB)?0:sl_next+C_SLOTB;}while(0)
  DMA_K(2,2*C_SLOTB);
  WAIT_BAR(6);
  qkt(C0,C1,Kbase,qr,negm,r32,hi);asm volatile("s_nop 15\n\ts_nop 7":"+v"(C0),"+v"(C1));
  { const float rm=rowmax(C0,C1); mhat=fadd_s(mhat,rm);
    _Pragma("unroll") for(int r=0;r<16;++r){C0[r]=fsub_s(C0[r],rm);C1[r]=fsub_s(C1[r],rm);}
    _Pragma("unroll") for(int r=0;r<16;++r)negm[r]=-mhat; asm volatile("":"+v"(negm));
    float sacc=0.f;
    _Pragma("unroll") for(int r=0;r<16;++r){C0[r]=__builtin_amdgcn_exp2f(C0[r]);C1[r]=__builtin_amdgcn_exp2f(C1[r]);sacc+=C0[r]+C1[r];}
    l_reg+=sacc;
    _Pragma("unroll") for(int i=0;i<4;++i){pwA[0][i]=cvtpk_s(C0[2*i],C0[2*i+1]);pwA[1][i]=cvtpk_s(C0[8+2*i],C0[9+2*i]);pwA[2][i]=cvtpk_s(C1[2*i],C1[2*i+1]);pwA[3][i]=cvtpk_s(C1[8+2*i],C1[9+2*i]);} }
  WAIT_BAR(0);
  DMA_K(3,0);DMA_V(1,C_SLOTB);
  ROT();
  kload8(kf,kp0+sl_cur);
  WAIT_BAR(4);
  s16x4 vlo[8],vhi[8];
  #define PAF(PW,k) __builtin_bit_cast(bf16x8,PW[k])
  #define VFR(i) (bf16x8){vlo[i][0],vlo[i][1],vlo[i][2],vlo[i][3],vhi[i][0],vhi[i][1],vhi[i][2],vhi[i][3]}
  #define PIN(x) asm volatile("":"+v"(x))
  #define MX3(a,b,c) __builtin_fmaxf(__builtin_fmaxf((a),(b)),(c))
  #define EX(v) __builtin_amdgcn_exp2f(v)
  #define VRD(i) do{ vlo[i]=vtr(vp_+(((i)>>2)*4096+((i)&3)*1024)); vhi[i]=vtr(vp_+(((i)>>2)*4096+((i)&3)*1024+512)); }while(0)
  #define VRD2(i) do{ vlo[i]=vtr(vp_+((2+((i)>>2))*4096+((i)&3)*1024)); vhi[i]=vtr(vp_+((2+((i)>>2))*4096+((i)&3)*1024+512)); }while(0)
  #define KRD(G,j) do{ if(G){ kload2(kf,kp0+sl_next,j); SBAR(); } }while(0)
  #define QKM(C,KF,Q,INIT) do{ C=__builtin_amdgcn_mfma_f32_32x32x16_bf16(KF,Q,INIT,0,0,0); SBAR(); }while(0)
  #define GAPC(MF,X,B,W,EXTRA) do{ MF; X[B]=EX(X[B]); X[B+1]=EX(X[B+1]); sacc+=X[B]; sacc+=X[B+1]; W=cvtpk_s(X[B],X[B+1]); PIN(sacc); PIN(W); EXTRA; SBAR(); }while(0)
  #define STEPC(PWP,PWC,t,GK,GV,GL) do{ SBAR(); \
    const lds_cptr vp_=vp0+sl_prev; \
    VRD(0); SBAR(); QKM(C0,kf[0],qr[0],negm); \
    VRD(4); SBAR(); QKM(C1,kf[1],qr[0],negm); \
    VRD(1); SBAR(); QKM(C0,kf[2],qr[1],C0); \
    VRD(5); SBAR(); QKM(C1,kf[3],qr[1],C1); \
    VRD(2); SBAR(); QKM(C0,kf[4],qr[2],C0); \
    VRD(6); SBAR(); QKM(C1,kf[5],qr[2],C1); \
    VRD(3); SBAR(); QKM(C0,kf[6],qr[3],C0); \
    VRD(7); SBAR(); QKM(C1,kf[7],qr[3],C1); \
    if(GK){DMA_K((t)+3,sl_cur);} if(GV){DMA_V((t)+1,sl_next);} \
    { float a=MX3(C0[0],C0[1],C1[0]),b=MX3(C0[2],C0[3],C1[1]); a=MX3(a,C1[2],C1[3]); \
      _Pragma("unroll") for(int r=4;r<16;r+=4){a=MX3(a,C0[r],C0[r+1]);b=MX3(b,C0[r+2],C0[r+3]);a=MX3(a,C1[r],C1[r+1]);b=MX3(b,C1[r+2],C1[r+3]);} \
      float rm=__builtin_fmaxf(a,b); rm=__builtin_fmaxf(rm,xhalf(rm)); \
      resc=false; \
      if(__builtin_expect(__any(rm>(float)THRL),0)){ const float dl=__builtin_fmaxf(rm,0.f); mhat+=dl; \
        _Pragma("unroll") for(int r=0;r<16;++r){C0[r]-=dl;C1[r]-=dl;} \
        _Pragma("unroll") for(int r=0;r<16;++r)negm[r]=-mhat; asm volatile("":"+v"(negm)); \
        const float f=__builtin_amdgcn_exp2f(-dl); l_reg*=f; if(hi==0)wsf[r32]=f; resc=true; } } \
    SBAR(); float sacc=0.f; \
    GAPC(o[0]=__builtin_amdgcn_mfma_f32_32x32x16_bf16(PAF(PWP,0),VFR(0),o[0],0,0,0), C0,0, PWC[0][0], VRD2(0)); \
    GAPC(o[1]=__builtin_amdgcn_mfma_f32_32x32x16_bf16(PAF(PWP,0),VFR(4),o[1],0,0,0), C0,2, PWC[0][1], VRD2(4)); \
    GAPC(o[0]=__builtin_amdgcn_mfma_f32_32x32x16_bf16(PAF(PWP,1),VFR(1),o[0],0,0,0), C0,4, PWC[0][2], VRD2(1)); \
    GAPC(o[1]=__builtin_amdgcn_mfma_f32_32x32x16_bf16(PAF(PWP,1),VFR(5),o[1],0,0,0), C0,6, PWC[0][3], VRD2(5)); \
    GAPC(o[0]=__builtin_amdgcn_mfma_f32_32x32x16_bf16(PAF(PWP,2),VFR(2),o[0],0,0,0), C0,8, PWC[1][0], VRD2(2)); \
    GAPC(o[1]=__builtin_amdgcn_mfma_f32_32x32x16_bf16(PAF(PWP,2),VFR(6),o[1],0,0,0), C0,10,PWC[1][1], VRD2(6)); \
    GAPC(o[0]=__builtin_amdgcn_mfma_f32_32x32x16_bf16(PAF(PWP,3),VFR(3),o[0],0,0,0), C0,12,PWC[1][2], VRD2(3)); \
    GAPC(o[1]=__builtin_amdgcn_mfma_f32_32x32x16_bf16(PAF(PWP,3),VFR(7),o[1],0,0,0), C0,14,PWC[1][3], VRD2(7)); \
    GAPC(o[2]=__builtin_amdgcn_mfma_f32_32x32x16_bf16(PAF(PWP,0),VFR(0),o[2],0,0,0), C1,0, PWC[2][0], ); \
    GAPC(o[3]=__builtin_amdgcn_mfma_f32_32x32x16_bf16(PAF(PWP,0),VFR(4),o[3],0,0,0), C1,2, PWC[2][1], ); \
    KRD(GL,0); GAPC(o[2]=__builtin_amdgcn_mfma_f32_32x32x16_bf16(PAF(PWP,1),VFR(1),o[2],0,0,0), C1,4, PWC[2][2], ); \
    KRD(GL,1); GAPC(o[3]=__builtin_amdgcn_mfma_f32_32x32x16_bf16(PAF(PWP,1),VFR(5),o[3],0,0,0), C1,6, PWC[2][3], ); \
    KRD(GL,2); GAPC(o[2]=__builtin_amdgcn_mfma_f32_32x32x16_bf16(PAF(PWP,2),VFR(2),o[2],0,0,0), C1,8, PWC[3][0], ); \
    KRD(GL,3); GAPC(o[3]=__builtin_amdgcn_mfma_f32_32x32x16_bf16(PAF(PWP,2),VFR(6),o[3],0,0,0), C1,10,PWC[3][1], ); \
    GAPC(o[2]=__builtin_amdgcn_mfma_f32_32x32x16_bf16(PAF(PWP,3),VFR(3),o[2],0,0,0), C1,12,PWC[3][2], ); \
    GAPC(o[3]=__builtin_amdgcn_mfma_f32_32x32x16_bf16(PAF(PWP,3),VFR(7),o[3],0,0,0), C1,14,PWC[3][3], ); \
    l_reg+=sacc; \
    }while(0)
  int t=1;
  for(;t+5<NT;t+=2){
    STEPC(pwA,pwB,t,true,true,true);     WAIT_BAR(4); RESC(); ROT();
    STEPC(pwB,pwA,t+1,true,true,true);   WAIT_BAR(4); RESC(); ROT();
  }
  #define ENDW(tt) do{ if((tt)+3<NT){WAIT_BAR(4);} else if((tt)+2<NT){WAIT_BAR(2);} else {WAIT_BAR(0);} }while(0)
  for(;t+1<NT;t+=2){
    STEPC(pwA,pwB,t,(t+3<NT),(t+1<NT),(t+1<NT));       ENDW(t);   RESC(); ROT();
    STEPC(pwB,pwA,t+1,(t+4<NT),(t+2<NT),(t+2<NT));     ENDW(t+1); RESC(); ROT();
  }
  STEPC(pwA,pwB,NT-1,false,false,false); RESC();
  SBAR(); pv4(o,vb0+sl_cur,PAF(pwB,0),PAF(pwB,1),PAF(pwB,2),PAF(pwB,3));
  #undef PAF
  #undef VFR
  #undef PIN
  #undef MX3
  #undef EX
  #undef VRD
  #undef VRD2
  #undef KRD
  #undef QKM
  #undef GAPC
  #undef STEPC
  #undef ENDW
  l_reg+=xhalf(l_reg);
  if(hi==0)wsf[32+r32]=l_reg;asm volatile("s_waitcnt lgkmcnt(0)":::"memory");
  float rli[16];
  #pragma unroll
  for(int r=0;r<16;++r)rli[r]=__builtin_amdgcn_rcpf(wsf[32+crow(r,hi)]);
  asm volatile("s_waitcnt lgkmcnt(0)\n\ts_barrier":::"memory");
  out(o,rli,wid,lane,shm);
  asm volatile("s_waitcnt lgkmcnt(0)\n\ts_barrier":::"memory");
  #undef DMA_K
  #undef DMA_V
  #undef RESC
  #undef ROT
}
struct OutF32C {
  float* O0;
  __device__ __forceinline__ void operator()(const f32x16 (&o)[4],const float (&rli)[16],int wid,int lane,char*)const{
    const int r32=lane&31,hi=lane>>5; float*op=O0+(long)((wid&3)*QBLK)*1024+(wid>>2)*128+r32;
    #pragma unroll
    for(int r=0;r<16;++r){const int q=crow(r,hi);
      #pragma unroll
      for(int db=0;db<4;++db)op[(long)q*1024+db*32]=o[db][r]*rli[r];}
  }
};
#undef SBAR
#undef WAIT_BAR
}
typedef float f32x2 __attribute__((ext_vector_type(2)));
#ifndef KSEL_MIX
#define KSEL_MIX 0
#endif
#ifndef FA_THR
#define FA_THR 8
#endif
constexpr int NB = 4, SEQ = 8192, CTXL = 256, DM = 1024, SE = SEQ + CTXL, RT = NB * SE, NIN = 3328, NQKV = 2304;
constexpr float LOG2E = 1.4426950408889634f, LAM0 = 0.35550906759f;
constexpr size_t MiB = 1u << 20;
constexpr size_t WS_CTL = 0, CTL_ZERO_BYTES = 1 * MiB;
constexpr size_t WS_MOD = 1 * MiB;
constexpr size_t WS_ROPE = 1 * MiB + 256 * 1024;
constexpr size_t WS_WIN0 = 2 * MiB, WS_WIN1 = 10 * MiB;
constexpr size_t WS_WOUT0 = 18 * MiB, WS_WOUT1 = 20 * MiB;
constexpr size_t WS_XC1 = 24 * MiB;
constexpr size_t WS_H = 32 * MiB;
constexpr size_t WS_Y = 100 * MiB;
constexpr size_t WS_QKV = 168 * MiB;
constexpr size_t WS_OC = 320 * MiB;
constexpr size_t WS_END = 448 * MiB;
static_assert(WS_H + (size_t)RT * DM * 2 <= WS_Y && WS_Y + (size_t)RT * DM * 2 <= WS_QKV && WS_QKV + (size_t)RT * NQKV * 2 <= WS_OC && WS_OC + (size_t)32768 * 1024 * 4 <= WS_END, "ws map");
constexpr int CW_BAR = 4096;
constexpr int RING_BYTES = 131072, SCR_OFF = RING_BYTES, BIAS_OFF = SCR_OFF + 2048, TAB_OFF = BIAS_OFF, TAB_FLOATS = 4096 + 128, LDSCTL_OFF = 150016, MISC_OFF = LDSCTL_OFF + 320, LDS_BYTES = 148 * 1024;
static_assert(BIAS_OFF + 8 * 465 * 4 <= LDSCTL_OFF && TAB_OFF + TAB_FLOATS * 4 <= LDSCTL_OFF && MISC_OFF + 128 <= LDS_BYTES, "LDS map");

typedef unsigned short u16;
__device__ __forceinline__ float wave_sum(float v) {
#pragma unroll
    for (int o = 1; o < 64; o <<= 1) v += __shfl_xor(v, o);
    return v;
}
__device__ __forceinline__ void p0_transpose_item(const float* W, int K, int N, u16* WT, bool perm, LAS float* scr, int item, int lane) {
    const int nblk = N / 32, kb = item / nblk, nb = item % nblk, k0 = 64 * kb, n0 = 32 * nb;
    const int rowbase = perm ? (256 * (n0 >> 8) + 32 * ((n0 >> 6) & 3) + 8 * ((n0 >> 5) & 1)) : n0;
#pragma unroll 8
    for (int i = 0; i < 32; ++i) { const int kk = 2 * i + (lane >> 5); scr[kk * 33 + (lane & 31)] = W[(size_t)(k0 + kk) * N + n0 + (lane & 31)]; }
    LDS_WAIT(); asm volatile("" ::: "memory");
    const int c = lane & 7;
#pragma unroll
    for (int j = 0; j < 4; ++j) { const int n = (lane >> 3) + 8 * j; const LAS float* s = scr + (8 * c) * 33 + n;
        const int rr = perm ? (128 * ((n >> 2) & 1) + 16 * (n >> 4) + 4 * ((n >> 3) & 1) + (n & 3)) : n;
        v4u o; o.x = pk2(s[0 * 33], s[1 * 33]); o.y = pk2(s[2 * 33], s[3 * 33]); o.z = pk2(s[4 * 33], s[5 * 33]); o.w = pk2(s[6 * 33], s[7 * 33]);
        *(v4u*)(WT + (size_t)(rowbase + rr) * K + k0 + 8 * c) = o; }
    LDS_WAIT(); asm volatile("" ::: "memory");
}

struct Args { const float* in[17]; float* out; unsigned char* ws; };

__global__ void __launch_bounds__(512, 2) fwd_kernel(Args args) {
    extern __shared__ __attribute__((aligned(16))) unsigned char lds_raw[];
    LAS unsigned char* lds = (LAS unsigned char*)lds_raw;
    volatile LAS unsigned* MISC = (volatile LAS unsigned*)(lds + MISC_OFF);
    const int G = gridDim.x, bx = blockIdx.x, vcu = (G % 8 == 0) ? (bx % 8) * (G / 8) + bx / 8 : bx, NGW = G * 8;
#define PH_IDS KP_DECL int tid = threadIdx.x; asm volatile("" : "+v"(tid)); const int lane = tid & 63, wave = __builtin_amdgcn_readfirstlane(tid >> 6), gw = vcu * 8 + wave; (void)lane; (void)gw;
#define AS4 __attribute__((address_space(4)))
#define KP_DECL const AS4 unsigned char* kp_ = (const AS4 unsigned char*)__builtin_amdgcn_kernarg_segment_ptr(); asm volatile("" : "+s"(kp_)); unsigned char* const ws = *(unsigned char* const AS4*)(kp_ + 144); (void)ws;
#define KIN(i) (*(const float* const AS4*)(kp_ + 8 * (i)))
#define KOUT (*(float* const AS4*)(kp_ + 136))
#define W_MOD ((float*)(ws + WS_MOD))
#define W_ROPEC ((float*)(ws + WS_ROPE))
#define W_ROPES ((float*)(ws + WS_ROPE) + 128 * 16)
#define W_XC1 ((float*)(ws + WS_XC1))
#define W_H ((u16*)(ws + WS_H))
#define W_Y ((u16*)(ws + WS_Y))
#define W_QKV ((u16*)(ws + WS_QKV))
#define W_OC ((float*)(ws + WS_OC))
    (void)args;
    for (int u = threadIdx.x; u < (LDS_BYTES - LDSCTL_OFF) / 4; u += 512) ((LAS unsigned*)(lds + LDSCTL_OFF))[u] = 0u;
    __syncthreads();
    { KP_DECL (void)xcd_barrier_post((unsigned*)(ws + WS_CTL) + CW_BAR, MISC + 8); }
#ifdef USE_CG
#define GRID_BAR() do { asm volatile("s_waitcnt vmcnt(0)" ::: "memory"); __threadfence(); cooperative_groups::this_grid().sync(); __threadfence(); } while (0)
#else
#define GRID_BAR() do { KP_DECL XcdBarrier b_; b_.bar = (unsigned*)(ws + WS_CTL) + CW_BAR; b_.x = xb_xcc_id(); b_.st = MISC + 8; xcd_barrier(b_); } while (0)
#endif

#ifndef SKIP_P0
    {
        PH_IDS
        const float* cvec = KIN(1); const float* cctx = KIN(3); const float* w_mod = KIN(4); const float* b_mod = KIN(5); float* MOD = W_MOD; float* ROPEC = W_ROPEC; float* ROPES = W_ROPES;
        LAS float* sil = (LAS float*)lds;
        LAS float* part = (LAS float*)(lds + 20480);
        if (bx < 192) {
            for (int i = tid; i < 5120; i += 512) { const int v = i >> 10, k = i & 1023; const float cv = (v < 4) ? cvec[v * 1024 + k] : cctx[k]; sil[i] = cv / (1.0f + __expf(-cv)); }
            __syncthreads();
            for (int it = bx; it < 192; it += G) {
                const int layer = it / 96, n0 = (it % 96) * 32, ks = tid >> 5, cl = tid & 31;
                const float* W = w_mod + (size_t)layer * 1024 * 3072 + n0 + cl;
                float a0 = 0.f, a1 = 0.f, a2 = 0.f, a3 = 0.f, a4 = 0.f;
#pragma unroll 16
                for (int kk = 0; kk < 64; ++kk) { const int k = ks * 64 + kk; const float w = W[(size_t)k * 3072];
                    a0 += sil[k] * w; a1 += sil[1024 + k] * w; a2 += sil[2048 + k] * w; a3 += sil[3072 + k] * w; a4 += sil[4096 + k] * w; }
                part[(ks * 5 + 0) * 32 + cl] = a0; part[(ks * 5 + 1) * 32 + cl] = a1; part[(ks * 5 + 2) * 32 + cl] = a2; part[(ks * 5 + 3) * 32 + cl] = a3; part[(ks * 5 + 4) * 32 + cl] = a4;
                __syncthreads();
                if (tid < 160) { const int v = tid >> 5; float s = b_mod[layer * 3072 + n0 + cl];
#pragma unroll
                    for (int q = 0; q < 16; ++q) s += part[(q * 5 + v) * 32 + cl];
                    MOD[(size_t)(layer * 5 + v) * 3072 + n0 + cl] = s; }
                __syncthreads();
            }
        } else if (bx >= G - 4) {
            const int e = (bx - (G - 4)) * 512 + tid, pos = e >> 4, j = e & 15;
            const float inv = exp2f(-(float)j * (13.287712379549449f / 16.0f));
            const float ang = (float)pos * inv;
            ROPEC[e] = cosf(ang); ROPES[e] = sinf(ang);
        }
        __syncthreads();
        LAS float* scr = (LAS float*)(lds + wave * 16384);
        constexpr int I_IN = 16 * 104, I_OUT = 16 * 32, NITEMS = 2 * I_IN + 2 * I_OUT;
        for (int it = gw; it < NITEMS; it += NGW) {
            const float* Wsrc; u16* Wdst; int N_, r; bool perm;
            if (it < I_IN) { Wsrc = KIN(6); Wdst = (u16*)(ws + WS_WIN0); N_ = NIN; r = it; perm = true; }
            else if (it < 2 * I_IN) { Wsrc = KIN(11); Wdst = (u16*)(ws + WS_WIN1); N_ = NIN; r = it - I_IN; perm = true; }
            else if (it < 2 * I_IN + I_OUT) { Wsrc = KIN(7); Wdst = (u16*)(ws + WS_WOUT0); N_ = 1024; r = it - 2 * I_IN; perm = false; }
            else { Wsrc = KIN(12); Wdst = (u16*)(ws + WS_WOUT1); N_ = 1024; r = it - 2 * I_IN - I_OUT; perm = false; }
            p0_transpose_item(Wsrc, 1024, N_, Wdst, perm, scr, r, lane);
        }
    }
#endif
    GRID_BAR();

    for (int layer = 0; layer < 2; ++layer) {
#ifndef SKIP_H
        {
            PH_IDS
            const float* modl = W_MOD + (size_t)layer * 5 * 3072; u16* H = W_H;
            const float* xs = layer == 0 ? KIN(0) : KOUT; const float* cs = layer == 0 ? KIN(2) : W_XC1;
            for (int R = gw; R < RT; R += NGW) {
                const int b = R / SE, t = R % SE;
                const float* src; const float* mv;
                if (t < SEQ) { src = xs + ((size_t)b * SEQ + t) * DM; mv = modl + b * 3072; } else { src = cs + ((size_t)b * CTXL + (t - SEQ)) * DM; mv = modl + 4 * 3072; }
                f32x4 v[4]; float ss = 0.f;
#pragma unroll
                for (int j = 0; j < 4; ++j) { v[j] = *(const f32x4*)(src + 4 * lane + 256 * j); ss += (v[j].x * v[j].x + v[j].y * v[j].y) + (v[j].z * v[j].z + v[j].w * v[j].w); }
                const float rstd = 1.0f / sqrtf(wave_sum(ss) * (1.0f / DM) + 1e-6f);
#pragma unroll
                for (int j = 0; j < 4; ++j) { const f32x4 sh = *(const f32x4*)(mv + 4 * lane + 256 * j), sc = *(const f32x4*)(mv + 1024 + 4 * lane + 256 * j);
                    const f32x4 h = v[j] * rstd * (sc + 1.0f) + sh;
                    *(unsigned long long*)(H + (size_t)R * DM + 4 * lane + 256 * j) = (unsigned long long)pk2(h.x, h.y) | ((unsigned long long)pk2(h.z, h.w) << 32); }
            }
        }
#endif
        GRID_BAR();
#ifndef SKIP_G1
        {
            KP_DECL
            { LAS float* tabw = (LAS float*)(lds + TAB_OFF); const float* rc = W_ROPEC; const float* g8 = KIN(8); const float* g9 = KIN(9);
              int tid0 = threadIdx.x; asm volatile("" : "+v"(tid0));
              for (int i = tid0; i < TAB_FLOATS; i += 512) tabw[i] = i < 4096 ? rc[i] : (i < 4160 ? g8[i - 4096] : g9[i - 4160]);
              __syncthreads(); }
            pg8::Gemm g{W_H, (const u16*)(ws + (layer == 0 ? WS_WIN0 : WS_WIN1)), RT, NIN, DM}; pg8::StaticOrder S; S.init(RT, NIN, G, bx);
            pg8::EpiQKV E{W_QKV, W_Y, (const LAS float*)(lds + TAB_OFF), layer};
            pg8::gemm_phase<pg8::EpiQKV, pg8::StaticOrder, true, true>(lds, g, S, E);
#ifdef PROBE_G1
            __syncthreads();
            pg8::gemm_phase<pg8::EpiQKV, pg8::StaticOrder, true, true>(lds, g, S, E);
#endif
#ifdef PROBE_G1B
            __syncthreads();
            { pg8::EpiProbe E2{(u16*)(ws + WS_OC)}; pg8::gemm_phase<pg8::EpiProbe, pg8::StaticOrder, true, true>(lds, g, S, E2); }
#endif
        }
#endif
        GRID_BAR();
#ifndef SKIP_ATT
        {
            PH_IDS
            const u16* QKV = W_QKV; u16* Y = W_Y; float* OC = W_OC; const float* rpb = KIN(10); const float* sinks = KIN(15);
            const wa::lptr slot = lds + wave * 16384; LAS float* wsf = (LAS float*)(lds + SCR_OFF + wave * 256);
            const int r32 = lane & 31, hi = lane >> 5;
            if (layer == 0) {
                LAS float* biasT = (LAS float*)(lds + BIAS_OFF);
                for (int i = tid; i < 8 * 465; i += 512) biasT[i] = rpb[i] * LOG2E;
                __syncthreads();
#ifndef OLD_A
                for (int uid = vcu; uid < 1024; uid += G) {
                    const int i = uid >> 8, g = (uid & 255) >> 5, s = uid & 31, b = g >> 1, kv = g & 1, hq = kv * 4 + i; const u16* base = QKV + (size_t)b * SE * NQKV;
                    const fa::OutMulY o_{Y + ((size_t)b * SE + s * 256) * DM + hq * 64};
                    fa::attn_unit<FA_THR>((const fa::bf16*)(base + (size_t)(s * 256) * NQKV + hq * 64), (const fa::bf16*)(base + 512 + kv * 64), (const fa::bf16*)(base + 640 + kv * 64), 132, (char*)lds_raw, o_);
                }
                for (int u = 8192 + gw; u < 16896; u += NGW) {
#else
                for (int u = gw; u < 16896; u += NGW) {
#endif
                    wa::State st; st.m = -INFINITY; st.l = 0.f; float rl[16];
                    if (u < 8192) {
                        const int b = u >> 11, hq = (u >> 8) & 7, qb = u & 255; const u16* base = QKV + (size_t)b * SE * NQKV;
                        wa::SpecPlain sp{base + 512 + (hq >> 2) * 64, base + 640 + (hq >> 2) * 64, 132};
                        wa::run(sp, base + (size_t)(qb * 32 + r32) * NQKV + hq * 64, st, slot, wsf, lane, nullptr, KSEL_MIX == 0);
                        wa::row_recip(st, rl, wsf, lane);
#ifdef ABL_A
                        for (int r = 0; r < 16; ++r) rl[r] = 0.f;
#endif
                        wa::store_mul(st, rl, Y + ((size_t)b * SE + qb * 32) * DM + hq * 64, slot, lane);
                    } else if (u < 16384) {
                        const int v = u - 8192, b = v >> 11, h = (v >> 8) & 7, qb = v & 255; const u16* base = QKV + (size_t)b * SE * NQKV;
                        const int r = qb >> 1, c = 32 * (qb & 1) + r32, rs = min(max(r - 4, 0), 120), cs = min(max(c - 8, 0), 48);
                        wa::SpecNA sp{base + 1280 + h * 64, base + 1792 + h * 64, r, rs, c, cs, biasT + h * 465};
                        wa::run(sp, base + (size_t)(qb * 32 + r32) * NQKV + 768 + h * 64, st, slot, wsf, lane, nullptr, KSEL_MIX == 1);
                        wa::row_recip(st, rl, wsf, lane);
#ifdef ABL_B
                        for (int r = 0; r < 16; ++r) rl[r] = 0.f;
#endif
#ifndef SC_B
                        wa::store_mul(st, rl, Y + ((size_t)b * SE + qb * 32) * DM + 512 + h * 64, slot, lane);
#endif
                    } else {
                        const int v = u - 16384, isb = v >> 8, w = v & 255, b = w >> 6, h = (w >> 3) & 7, qb = w & 7; const u16* base = QKV + ((size_t)b * SE + SEQ) * NQKV;
                        const int kc = isb ? 1280 + h * 64 : 512 + (h >> 2) * 64, vc = isb ? 1792 + h * 64 : 640 + (h >> 2) * 64, qc = isb ? 768 + h * 64 : h * 64;
                        wa::SpecPlain sp{base + kc, base + vc, 4};
                        wa::run(sp, base + (size_t)(qb * 32 + r32) * NQKV + qc, st, slot, wsf, lane, nullptr, KSEL_MIX == 2);
                        wa::row_recip(st, rl, wsf, lane);
                        wa::store_mul(st, rl, Y + ((size_t)b * SE + SEQ + qb * 32) * DM + isb * 512 + h * 64, slot, lane);
                    }
                }
            } else {
#ifndef OLD_C
#ifdef C_TWOPASS
                for (int uid = vcu; uid < 2048; uid += G) {
                    const int i = uid >> 8, g = (uid & 255) >> 5, s = uid & 31, bh = 2 * g + (i >> 2), b = bh >> 2, h = bh & 3, m = (i >> 1) & 1, vh = i & 1; const u16* base = QKV + (size_t)b * SE * NQKV;
                    const fa::OutF32 o_{OC + ((size_t)b * SEQ + s * 256) * 1024 + h * 256 + m * 128 + vh * 64};
                    fa::attn_unit<FA_THR>((const fa::bf16*)(base + (size_t)(s * 256) * NQKV + (2 * h + m) * 64), (const fa::bf16*)(base + 512 + (2 * h + m) * 64), (const fa::bf16*)(base + 1024 + h * 128 + vh * 64), 132, (char*)lds_raw, o_);
                }
#else
                for (int uid = vcu; uid < 1024; uid += G) {
                    const int i = uid >> 8, g = (uid & 255) >> 5, s = (uid & 31) + 32 * (i & 1), bh = 2 * g + (i >> 1), b = bh >> 2, h = bh & 3; const u16* base = QKV + (size_t)b * SE * NQKV;
                    const fa::OutF32C o_{OC + ((size_t)b * SEQ + s * 128) * 1024 + h * 256};
                    fa::attn_unit_c<FA_THR>((const fa::bf16*)(base + (size_t)(s * 128) * NQKV + (2 * h) * 64), (const fa::bf16*)(base + 512 + (2 * h) * 64), (const fa::bf16*)(base + 1024 + h * 128), 132, (char*)lds_raw, o_);
                }
#endif
                for (int u = 16384 + gw; u < 24576; u += NGW) {
#else
                for (int u = gw; u < 24576; u += NGW) {
#endif
                    wa::State st; float rl[16];
                    if (u < 16384) {
                        const int b = u >> 12, pp = (u >> 8) & 15, qb = u & 255, h = pp >> 2, m = (pp >> 1) & 1, vh = pp & 1; const u16* base = QKV + (size_t)b * SE * NQKV;
                        st.m = -INFINITY; st.l = 0.f;
                        wa::SpecPlain sp{base + 512 + (2 * h + m) * 64, base + 1024 + h * 128 + vh * 64, 132};
                        wa::run(sp, base + (size_t)(qb * 32 + r32) * NQKV + (2 * h + m) * 64, st, slot, wsf, lane, nullptr, KSEL_MIX == 3);
                        wa::row_recip(st, rl, wsf, lane);
                        float* op = OC + ((size_t)b * SEQ + qb * 32) * 1024 + h * 256 + m * 128 + vh * 64 + r32;
#pragma unroll
                        for (int r = 0; r < 16; ++r) { const int q = wa::crow(r, hi); op[(size_t)q * 1024] = st.o[0][r] * rl[r]; op[(size_t)q * 1024 + 32] = st.o[1][r] * rl[r]; }
                    } else {
                        const int v = u - 16384, b = v >> 11, hq = (v >> 8) & 7, qb = v & 255, t0 = qb * 32; const u16* base = QKV + (size_t)b * SE * NQKV;
                        const int first = (t0 - 128) & ~63, ilo = first < 0 ? (-first) >> 6 : 0, ihi = min(4, (SEQ - 64 - first) >> 6);
                        st.m = sinks[hq] * LOG2E; st.l = hi == 0 ? 1.0f : 0.0f;
#ifdef CTXONLY_D
                        st.m = -INFINITY; st.l = 0.f;
                        wa::SpecWin sp{base + 2048 + (hq >> 2) * 64, base + 2176 + (hq >> 2) * 64, first + 64 * ilo, 0, t0 + r32};
#else
                        wa::SpecWin sp{base + 2048 + (hq >> 2) * 64, base + 2176 + (hq >> 2) * 64, first + 64 * ilo, ihi - ilo + 1, t0 + r32};
#endif
#ifdef DUMP_S
                        wa::run(sp, base + (size_t)(t0 + r32) * NQKV + 1536 + hq * 64, st, slot, wsf, lane, b == 0 ? (float*)(ws + WS_H + 32 * MiB) + ((size_t)t0 * 8 + hq * 32) * 64 : nullptr);
#else
                        wa::run(sp, base + (size_t)(t0 + r32) * NQKV + 1536 + hq * 64, st, slot, wsf, lane, nullptr, KSEL_MIX == 4);
#endif
                        wa::row_recip(st, rl, wsf, lane);
#ifdef ABL_D
                        for (int r = 0; r < 16; ++r) rl[r] = 0.f;
#endif
#ifndef SC_D
                        wa::store_mul(st, rl, Y + ((size_t)b * SE + t0) * DM + 512 + hq * 64, slot, lane);
#endif
#ifdef DIFF_D
                        if (b == 0) { float* dp = (float*)(ws + WS_H) + (size_t)t0 * 512 + hq * 64 + r32;
                            _Pragma("unroll") for (int r = 0; r < 16; ++r) { const int q = wa::crow(r, hi); dp[(size_t)q * 512] = st.o[0][r] * rl[r]; dp[(size_t)q * 512 + 32] = st.o[1][r] * rl[r]; } }
#endif
                    }
                }
            }
#if defined(SC_B) || defined(SC_D)
            {
                const float* rpb_ = KIN(10); const float* sinks_ = KIN(15);
                for (int task = gw; task < NB * SEQ * 8; task += NGW) {
                    const int h = task & 7, row = task >> 3, b = row >> 13, t = row & 8191; const u16* base = QKV + (size_t)b * SE * NQKV;
                    float val = 0.f; bool doit = false;
#ifdef SC_B
                    if (layer == 0) {
                        const int r = t >> 6, c = t & 63, rs = min(max(r - 4, 0), 120), cs = min(max(c - 8, 0), 48);
                        auto kf = [&](int slot, int& krow, float& bias) -> bool { if (slot < 128) { const int kr = rs + (slot >> 4), kc = cs + (slot & 15); krow = kr * 64 + kc; bias = rpb_[h * 465 + (kr - r + 7) * 31 + (kc - c + 15)] * LOG2E; return true; }
                            krow = 8192 + slot - 128; bias = 0.f; return slot < 384; };
                        val = sc::row_attn<6>(base + (size_t)t * NQKV + 768 + h * 64, base + 1280 + h * 64, base + 1792 + h * 64, kf, -INFINITY, lane); doit = true;
                    }
#endif
#ifdef SC_D
                    if (layer == 1) {
                        auto kf = [&](int slot, int& krow, float& bias) -> bool { bias = 0.f; if (slot < 257) { krow = t - 128 + slot; return krow >= 0 && krow < SEQ; } krow = 8192 + slot - 257; return slot < 513; };
                        val = sc::row_attn<9>(base + (size_t)t * NQKV + 1536 + h * 64, base + 2048 + (h >> 2) * 64, base + 2176 + (h >> 2) * 64, kf, sinks_[h] * LOG2E, lane); doit = true;
                    }
#endif
                    if (doit) { u16* yp = Y + ((size_t)b * SE + t) * DM + 512 + h * 64 + lane; const float z = __builtin_bit_cast(float, (unsigned)*yp << 16); *yp = (u16)(wa::cvtpk(val * z, 0.f) & 0xffffu); }
                }
            }
#endif
        }
#endif
        GRID_BAR();
#ifdef CHK_GEMM
        if (layer == 0) {
            PH_IDS
            const u16* H = W_H; const u16* WT = (const u16*)(ws + WS_WIN0); const u16* QKV = W_QKV;
            const int c = (CHK_GEMM) * 64 + lane, tile = c >> 8, cc = c & 255, p = 256 * tile + 128 * ((cc >> 5) & 1) + 32 * (cc >> 6) + (cc & 31);
            for (int R = gw; R < RT; R += NGW) {
                float acc = 0.f;
                for (int k = 0; k < 1024; ++k) acc += __builtin_bit_cast(float, (unsigned)H[(size_t)R * 1024 + k] << 16) * __builtin_bit_cast(float, (unsigned)WT[(size_t)p * 1024 + k] << 16);
                const float got = __builtin_bit_cast(float, (unsigned)QKV[(size_t)R * NQKV + c] << 16);
                const bool badv = fabsf(got - acc) > 0.02f + 0.01f * fabsf(acc);
                const unsigned long long m = __ballot(badv);
                if (m != 0ull && lane == 0) atomicAdd((unsigned*)(ws + WS_CTL) + 64, 1u);
            }
        }
        GRID_BAR();
#endif
#ifndef DIFF_THR
#define DIFF_THR 0.05f
#endif
#ifdef DIFF_D
        if (layer == 1) {
            PH_IDS
            const u16* QKV = W_QKV; const float* sinks_ = KIN(15); const float* dbg = (const float*)(ws + WS_H);
            float md = 0.f;
            for (int task = gw; task < 8192 * 8; task += NGW) {
                const int h = task & 7, t = task >> 3; const u16* base = QKV;
#ifdef CTXONLY_D
                auto kf = [&](int slot, int& krow, float& bias) -> bool { bias = 0.f; krow = 8192 + slot; return slot < 256; };
#elif defined(NOMASK_D)
                const int t0_ = t & ~31, first_ = (t0_ - 128) & ~63, ilo_ = first_ < 0 ? (-first_) >> 6 : 0, ihi_ = min(4, (SEQ - 64 - first_) >> 6), ks0_ = first_ + 64 * ilo_, nw_ = ihi_ - ilo_ + 1;
                auto kf = [&](int slot, int& krow, float& bias) -> bool { bias = 0.f; if (slot < 320) { krow = ks0_ + slot; return slot < 64 * nw_; } krow = 8192 + slot - 320; return slot < 576; };
#else
                auto kf = [&](int slot, int& krow, float& bias) -> bool { bias = 0.f; if (slot < 257) { krow = t - 128 + slot; return krow >= 0 && krow < SEQ; } krow = 8192 + slot - 257; return slot < 513; };
#endif
                const float val = sc::row_attn<9>(base + (size_t)t * NQKV + 1536 + h * 64, base + 2048 + (h >> 2) * 64, base + 2176 + (h >> 2) * 64, kf,
#ifdef CTXONLY_D
                    -INFINITY,
#else
                    sinks_[h] * LOG2E,
#endif
                    lane);
#ifdef DUMP_S
                float sdiff = 0.f;
                { const float qd = __builtin_bit_cast(float, (unsigned)(base + (size_t)t * NQKV + 1536 + h * 64)[lane] << 16);
                  const float* ds_ = (const float*)(ws + WS_H + 32 * MiB) + ((size_t)(t & ~31) * 8 + h * 32 + (t & 31)) * 64;
                  for (int kk = 0; kk < 64; ++kk) { int row; float bias; kf(kk, row, bias); const float kd = __builtin_bit_cast(float, (unsigned)(base + 2048 + (h >> 2) * 64)[(size_t)row * 2304 + lane] << 16);
                      const float sref = sc::wsum(qd * kd); sdiff = fmaxf(sdiff, fabsf(sref - ds_[kk])); } }
#endif
                const float dd = sc::wmax(fabsf(val - dbg[(size_t)t * 512 + h * 64 + lane]));
#ifdef DUMP_S
                if (sdiff > DIFF_THR && lane == 0) {
#else
                if (dd > DIFF_THR && lane == 0) {
#endif
#if DIFF_D == 1
                    atomicAdd((unsigned*)(ws + WS_CTL) + 64, 1u);
#elif DIFF_D == 2
                    atomicMax((unsigned*)(ws + WS_CTL) + 64, (unsigned)(8191 - t));
#elif DIFF_D == 3
                    atomicMax((unsigned*)(ws + WS_CTL) + 64, (unsigned)t);
#elif DIFF_D == 4
                    atomicOr((unsigned*)(ws + WS_CTL) + 64, 1u << (t & 31));
#elif DIFF_D == 5
                    atomicOr((unsigned*)(ws + WS_CTL) + 64, (1u << h) | (1u << (8 + ((t >> 5) & 1))));
#endif
                }
                md = dd;
            }
            (void)md;
        }
        GRID_BAR();
#endif
#ifndef SKIP_CMB
        if (layer == 1) {
            PH_IDS
            const float* clam = KIN(13); const float* subln = KIN(14); const float* OC = W_OC; u16* Y = W_Y;
            float lam;
            { const float a = clam[lane] * clam[64 + lane], b2 = clam[128 + lane] * clam[192 + lane]; lam = expf(wave_sum(a)) - expf(wave_sum(b2)) + LAM0; }
            const f32x2 g2 = *(const f32x2*)(subln + 2 * lane);
            for (int row = gw; row < NB * SEQ; row += NGW) {
                const int b = row >> 13, t = row & 8191; const size_t R = (size_t)b * SE + t;
#pragma unroll
                for (int h = 0; h < 4; ++h) {
                    const float* o0 = OC + (size_t)row * 1024 + h * 256 + 2 * lane; const f32x2 a = *(const f32x2*)o0, c2 = *(const f32x2*)(o0 + 128);
                    const f32x2 v = a - c2 * lam; const float rstd = 1.0f / sqrtf(wave_sum(v.x * v.x + v.y * v.y) * (1.0f / 128.0f) + 1e-6f);
                    const f32x2 o = v * rstd * g2 * (1.0f - LAM0);
                    unsigned* yp = (unsigned*)(Y + R * DM + h * 128 + 2 * lane); const unsigned yv = *yp;
                    *yp = wa::cvtpk(o.x * wa::bflo(yv), o.y * wa::bfhi(yv));
                }
            }
            GRID_BAR();
        }
#endif
#ifndef SKIP_G2
        {
            KP_DECL
            pg8::Gemm g{W_Y, (const u16*)(ws + (layer == 0 ? WS_WOUT0 : WS_WOUT1)), RT, DM, DM}; pg8::FlexOrder S; S.init(DM, G, bx, layer);
            pg8::EpiOut E{layer == 0 ? KIN(0) : KOUT, KOUT, KIN(2), W_XC1, W_MOD + (size_t)layer * 5 * 3072};
            pg8::gemm_phase<pg8::EpiOut, pg8::FlexOrder, true, true>(lds, g, S, E);
        }
#endif
        GRID_BAR();
    }
    PH_IDS
    float* out = KOUT; const float* fnorm = KIN(16);
    const float bad = (__hip_atomic_load((unsigned*)(ws + WS_CTL) + CW_BAR + XB_TMO, __ATOMIC_RELAXED, __HIP_MEMORY_SCOPE_AGENT) != 0u) ? __builtin_nanf("") : 0.f;
#if defined(DIFF_D) || defined(CHK_GEMM)
    const float dbgv = (float)__hip_atomic_load((unsigned*)(ws + WS_CTL) + 64, __ATOMIC_RELAXED, __HIP_MEMORY_SCOPE_AGENT);
#endif
    for (int row = gw; row < NB * SEQ; row += NGW) {
        float* p = out + (size_t)row * DM; f32x4 v[4]; float ss = 0.f;
#pragma unroll
        for (int j = 0; j < 4; ++j) { v[j] = *(const f32x4*)(p + 4 * lane + 256 * j); ss += (v[j].x * v[j].x + v[j].y * v[j].y) + (v[j].z * v[j].z + v[j].w * v[j].w); }
        const float rstd = 1.0f / sqrtf(wave_sum(ss) * (1.0f / DM) + 1e-6f);
#pragma unroll
        for (int j = 0; j < 4; ++j) { const f32x4 gn = *(const f32x4*)(fnorm + 4 * lane + 256 * j); *(f32x4*)(p + 4 * lane + 256 * j) = v[j] * rstd * gn + bad; }
#if defined(DIFF_D) || defined(CHK_GEMM)
        #ifdef DIFF_COARSE
        if (row == 0 && lane == 0) p[0] = (dbgv > 30000.f ? 4000.f : dbgv > 3000.f ? 3000.f : dbgv > 300.f ? 2000.f : dbgv > 30.f ? 1000.f : dbgv > 0.f ? 500.f : 0.f) + 100.0f;
#else
        if (row == 0 && lane == 0) p[0] = dbgv + 100.0f;
#endif
#endif
    }
}

extern "C" void kernel_launch(void* const* d_in, const int* in_sizes, int n_in, void* d_out, int out_size, void* d_ws, size_t ws_size, hipStream_t stream) {
    static int grid = 0;
    if (grid == 0) {
        if (n_in != 17 || in_sizes[0] != NB * SEQ * DM || out_size != NB * SEQ * DM || ws_size < WS_END) { fprintf(stderr, "kernel_launch: unexpected shapes / workspace (n_in %d, ws %zu)\n", n_in, ws_size); grid = -1; return; }
        int dev = 0, cus = 0, per_cu = 0;
        if (hipGetDevice(&dev) != hipSuccess || hipDeviceGetAttribute(&cus, hipDeviceAttributeMultiprocessorCount, dev) != hipSuccess) { grid = -1; return; }
        if (hipFuncSetAttribute((const void*)fwd_kernel, hipFuncAttributeMaxDynamicSharedMemorySize, LDS_BYTES) != hipSuccess) { fprintf(stderr, "kernel_launch: hipFuncSetAttribute failed\n"); grid = -1; return; }
        if (hipOccupancyMaxActiveBlocksPerMultiprocessor(&per_cu, (const void*)fwd_kernel, 512, LDS_BYTES) != hipSuccess || per_cu < 1) { fprintf(stderr, "kernel_launch: occupancy query says %d blocks per CU\n", per_cu); per_cu = 1; }
        (void)hipGetLastError();
        grid = cus;
    }
    if (grid < 0) return;
    if (hipMemsetAsync((char*)d_ws + WS_CTL, 0, CTL_ZERO_BYTES, stream) != hipSuccess) { fprintf(stderr, "kernel_launch: memset failed\n"); return; }
    Args a{};
    for (int i = 0; i < 17; ++i) a.in[i] = (const float*)d_in[i];
    a.out = (float*)d_out; a.ws = (unsigned char*)d_ws;
#ifdef USE_CG
    void* kargs[] = {&a};
    hipError_t e = hipLaunchCooperativeKernel((const void*)fwd_kernel, dim3(grid), dim3(512), kargs, LDS_BYTES, stream);
    if (e != hipSuccess) fprintf(stderr, "cooperative launch failed: %s\n", hipGetErrorString(e));
#else
    hipLaunchKernelGGL(fwd_kernel, dim3(grid), dim3(512), LDS_BYTES, stream, a);
#endif
}
```

```cpp
#include <hip/hip_runtime.h>
#include <hip/hip_bf16.h>
#include <hip/hip_cooperative_groups.h>
#include <cstdio>
#include <cstdint>
#include <cmath>
namespace pg8 {
#define PG8_LAS __attribute__((address_space(3)))
typedef unsigned short bf16_t;
typedef short bf16x8 __attribute__((ext_vector_type(8)));
typedef float f32x4 __attribute__((ext_vector_type(4)));
typedef unsigned u32x4 __attribute__((ext_vector_type(4)));
constexpr int BM = 256, BK = 64, HALF = 128, HTB = HALF * BK * 2  , STAGE_BYTES = 8 * HTB, NXCD = 8, WGM = 8;

__host__ __device__ __forceinline__ int lds_byte(int r, int c) { const int st = (r >> 4) * 2 + (c >> 5), rr = r & 15, cc = c & 31, ob = rr * 64 + cc * 2; return st * 1024 + (ob ^ (((ob >> 9) & 1) << 5)); }
__host__ __device__ __forceinline__ void stage_rc(int b, int& R, int& C) { const int st = b / 1024, sb = b % 1024, swz = sb ^ (((sb >> 9) & 1) << 5); R = (st >> 1) * 16 + swz / 64; C = (st & 1) * 32 + (swz % 64) / 2; }
__host__ __device__ __forceinline__ int perm32(int rho) { const int n = rho >> 4, i = rho & 15; return 8 * (i >> 2) + 4 * n + (i & 3); }

struct Unit { int pm, pn; };
struct Gemm { const bf16_t* A; const bf16_t* Bt; int M, N, K; };

struct StaticOrder {
    int nM, nN, nwg, G, c;
    __host__ __device__ void init(int M, int N, int G_, int c_) { nM = M / BM; nN = N / BM; nwg = nM * nN; G = G_; c = c_; }
    __host__ __device__ bool next(int i, Unit& u) const {
        const long L = (long)i * G + c; if (L >= nwg) return false;
        int wgid = (int)L; { const int q = nwg / NXCD, r = nwg % NXCD, xcd = wgid % NXCD, off = wgid / NXCD; wgid = (xcd < r ? xcd * (q + 1) : r * (q + 1) + (xcd - r) * q) + off; }
        const int nig = WGM * nN, gid = wgid / nig, fm = gid * WGM, gsz = (nM - fm) < WGM ? (nM - fm) : WGM;
        u.pm = fm + ((wgid % nig) % gsz); u.pn = (wgid % nig) / gsz; return true;
    }
    __device__ __forceinline__ void a_ready(const Unit&) const {}
    __device__ __forceinline__ void done(const Unit&) const {}
};

__device__ __forceinline__ unsigned cvt_pk_bf16(float lo, float hi) { unsigned r; asm volatile("v_cvt_pk_bf16_f32 %0, %1, %2" : "=v"(r) : "v"(lo), "v"(hi)); return r; }
typedef float f32x2 __attribute__((ext_vector_type(2)));
typedef unsigned u32x2 __attribute__((ext_vector_type(2)));
constexpr float QSCALE = 0.125f * 1.4426950408889634f;
constexpr int SE = 8448, NQKV = 2304, DMODEL = 1024;

struct EpiQKV {
    static constexpr bool PERM = false, AFTER_DRAIN = false;
    bf16_t* QKV; bf16_t* Y; const PG8_LAS float* tab; int layer;
    __device__ __forceinline__ void operator()(const f32x4 (&acc)[2][2][4][2], const Unit& u, int wr, int wc, int fr, int fq) const {
        asm volatile("" : "+v"(fr), "+v"(fq));
        const int c64 = u.pn * 4 + wc;
        int norm = 0; bool rope = false, scale = false, silu = false;
        if (layer == 0) { if (c64 < 8) { norm = 1; rope = true; scale = true; } else if (c64 < 10) { norm = 2; rope = true; } else if (c64 >= 12 && c64 < 20) scale = true; else if (c64 >= 36) silu = true; }
        else { if (c64 < 8) { rope = true; scale = true; } else if (c64 < 16) rope = true; else if (c64 >= 24 && c64 < 32) { rope = true; scale = true; } else if (c64 >= 32 && c64 < 34) rope = true; else if (c64 >= 36) silu = true; }
        const int pmb = u.pm % 33; const bool isctx = (pmb == 32); if (isctx) rope = false;
        const int hh = fq >> 1, gg = fq & 1, d0 = 32 * hh + 8 * gg;
        const PG8_LAS float* gain = tab + 4096 + (norm == 2 ? 64 : 0) + d0;
#pragma unroll
        for (int ai = 0; ai < 2; ++ai) {
            const int pr = pmb * 4 + ai * 2 + wr;
#pragma unroll
            for (int m = 0; m < 4; ++m) {
                const size_t R = (size_t)u.pm * 256 + ai * 128 + wr * 64 + m * 16 + fr;
                f32x4 v[2][2];
#pragma unroll
                for (int bj = 0; bj < 2; ++bj)
#pragma unroll
                    for (int n = 0; n < 2; ++n) v[bj][n] = acc[ai][bj][m][n];
                if (norm) {
                    float ss = 0.f;
#pragma unroll
                    for (int bj = 0; bj < 2; ++bj)
#pragma unroll
                        for (int n = 0; n < 2; ++n) { const f32x4 x = v[bj][n]; ss += (x[0] * x[0] + x[1] * x[1]) + (x[2] * x[2] + x[3] * x[3]); }
                    ss += __shfl_xor(ss, 16); ss += __shfl_xor(ss, 32);
                    const float rs = 1.0f / sqrtf(ss * (1.0f / 64.0f) + 1e-6f);
#pragma unroll
                    for (int bj = 0; bj < 2; ++bj)
#pragma unroll
                        for (int n = 0; n < 2; ++n) v[bj][n] = v[bj][n] * rs * *(const PG8_LAS f32x4*)(gain + 16 * n + 4 * bj);
                }
                if (rope) {
                    const int pos = hh ? (m * 16 + fr) : pr;
                    const PG8_LAS float* tp = tab + pos * 16 + 8 * gg;
#pragma unroll
                    for (int bj = 0; bj < 2; ++bj) { const f32x4 c4 = *(const PG8_LAS f32x4*)(tp + 4 * bj), s4 = *(const PG8_LAS f32x4*)(tp + 2048 + 4 * bj);
                        const f32x4 x1 = v[bj][0], x2 = v[bj][1]; v[bj][0] = x1 * c4 - x2 * s4; v[bj][1] = x1 * s4 + x2 * c4; }
                }
                if (scale) {
#pragma unroll
                    for (int bj = 0; bj < 2; ++bj)
#pragma unroll
                        for (int n = 0; n < 2; ++n) v[bj][n] = v[bj][n] * QSCALE;
                }
                bf16_t* dst;
                if (silu) {
#pragma unroll
                    for (int bj = 0; bj < 2; ++bj)
#pragma unroll
                        for (int n = 0; n < 2; ++n)
#pragma unroll
                            for (int e = 0; e < 4; ++e) { const float x = v[bj][n][e]; v[bj][n][e] = x * __builtin_amdgcn_rcpf(1.0f + __builtin_amdgcn_exp2f(-1.4426950408889634f * x)); }
                    dst = Y + R * DMODEL + (size_t)(c64 - 36) * 64 + d0;
                } else dst = QKV + R * NQKV + (size_t)c64 * 64 + d0;
#pragma unroll
                for (int n = 0; n < 2; ++n) { u32x4 w; w.x = cvt_pk_bf16(v[0][n][0], v[0][n][1]); w.y = cvt_pk_bf16(v[0][n][2], v[0][n][3]); w.z = cvt_pk_bf16(v[1][n][0], v[1][n][1]); w.w = cvt_pk_bf16(v[1][n][2], v[1][n][3]);
                    *(u32x4*)(dst + 16 * n) = w; }
                asm volatile("" ::: "memory");
            }
        }
    }
};

struct EpiProbe {
    static constexpr bool PERM = false, AFTER_DRAIN = false;
    bf16_t* O;
    __device__ __forceinline__ void operator()(const f32x4 (&acc)[2][2][4][2], const Unit& u, int wr, int wc, int fr, int fq) const {
        asm volatile("" : "+v"(fr), "+v"(fq));
#pragma unroll
        for (int ai = 0; ai < 2; ++ai)
#pragma unroll
            for (int m = 0; m < 4; ++m) { bf16_t* rowp = O + ((size_t)(u.pm & 63) * 256 + ai * 128 + wr * 64 + m * 16 + fr) * 3328 + u.pn * 256 + wc * 64 + 16 * fq;
#pragma unroll
                for (int bj = 0; bj < 2; ++bj) { u32x4 w; w.x = cvt_pk_bf16(acc[ai][bj][m][0][0], acc[ai][bj][m][0][1]); w.y = cvt_pk_bf16(acc[ai][bj][m][0][2], acc[ai][bj][m][0][3]); w.z = cvt_pk_bf16(acc[ai][bj][m][1][0], acc[ai][bj][m][1][1]); w.w = cvt_pk_bf16(acc[ai][bj][m][1][2], acc[ai][bj][m][1][3]);
                    *(u32x4*)(rowp + bj * 8) = w; }
                asm volatile("" ::: "memory"); }
    }
};

struct EpiOut {
    static constexpr bool PERM = false, AFTER_DRAIN = false;
    const float* xin; float* xout; const float* cin; float* cout; const float* mod;
    __device__ __forceinline__ void operator()(const f32x4 (&acc)[2][2][4][2], const Unit& u, int wr, int wc, int fr, int fq) const {
        asm volatile("" : "+v"(fr), "+v"(fq));
        const int pmb = u.pm % 33, b = u.pm / 33; const bool isctx = (pmb == 32);
        const float* src; float* dst; const float* gate;
        if (isctx) { src = cin + (size_t)b * 256 * DMODEL; dst = cout + (size_t)b * 256 * DMODEL; gate = mod + 4 * 3072 + 2048; }
        else { const size_t o = ((size_t)b * 8192 + (size_t)pmb * 256) * DMODEL; src = xin + o; dst = xout + o; gate = mod + b * 3072 + 2048; }
        const int col0 = u.pn * BM + wc * 32 + 4 * fq;
        f32x4 g[2][2], cur[2][2], nxt[2][2];
#pragma unroll
        for (int bj = 0; bj < 2; ++bj)
#pragma unroll
            for (int n = 0; n < 2; ++n) { g[bj][n] = *(const f32x4*)(gate + col0 + bj * HALF + n * 16); cur[bj][n] = *(const f32x4*)(src + (size_t)(wr * 64 + fr) * DMODEL + col0 + bj * HALF + n * 16); }
#pragma unroll
        for (int idx = 0; idx < 8; ++idx) { const int ai = idx >> 2, m = idx & 3; const size_t off = (size_t)(ai * HALF + wr * 64 + m * 16 + fr) * DMODEL + col0;
            if (idx < 7) { const int ai2 = (idx + 1) >> 2, m2 = (idx + 1) & 3; const size_t off2 = (size_t)(ai2 * HALF + wr * 64 + m2 * 16 + fr) * DMODEL + col0;
#pragma unroll
                for (int bj = 0; bj < 2; ++bj)
#pragma unroll
                    for (int n = 0; n < 2; ++n) nxt[bj][n] = *(const f32x4*)(src + off2 + bj * HALF + n * 16); }
#pragma unroll
            for (int bj = 0; bj < 2; ++bj)
#pragma unroll
                for (int n = 0; n < 2; ++n) { *(f32x4*)(dst + off + bj * HALF + n * 16) = cur[bj][n] + g[bj][n] * acc[ai][bj][m][n]; cur[bj][n] = nxt[bj][n]; }
            asm volatile("" ::: "memory"); }
    }
};
struct FlexOrder {
    StaticOrder base; int latent_only;
    __device__ void init(int N, int G_, int c_, int latent_only_) { latent_only = latent_only_; base.init(latent_only_ ? 4 * 8192 : 4 * SE, N, G_, c_); }
    __device__ bool next(int i, Unit& u) const { if (!base.next(i, u)) return false; if (latent_only) u.pm += u.pm >> 5; return true; }
    __device__ __forceinline__ void a_ready(const Unit&) const {}
    __device__ __forceinline__ void done(const Unit&) const {}
};
template <class Epi, class Sched, bool ALIGN_EPI = false, bool SP2 = false>
__device__ __forceinline__ void gemm_phase(PG8_LAS unsigned char* lds, const Gemm g, const Sched& S, const Epi& E) {
    int tid_ = threadIdx.x; asm volatile("" : "+v"(tid_));
    const int tid = tid_, wid = __builtin_amdgcn_readfirstlane(tid >> 6), lane = tid & 63, wr = wid >> 2, wc = wid & 3, fr = lane & 15, fq = lane >> 4;
    const int K = g.K, nt = K / BK;
    unsigned voffA[2], voffB[2];
#pragma unroll
    for (int i = 0; i < 2; ++i) { int R, C; stage_rc(tid * 16 + i * 8192, R, C); const int Rb = Epi::PERM ? ((R & ~31) + perm32(R & 31)) : R;
        voffA[i] = (unsigned)(R * K + C) * 2u; voffB[i] = (unsigned)(Rb * K + C) * 2u; }
    const size_t kstep = (size_t)(BK * 2);
    const size_t hstep = (size_t)HALF * K * 2;
    const size_t tstep = 2 * hstep;
    const unsigned ldsw = (unsigned)wid * 1024u;
    const int aoff = lds_byte(wr * 64 + fr, fq * 8), boff = lds_byte(wc * 32 + fr, fq * 8);
#define PG8_SA(b, h) (((b) * 2 + (h)) * HTB)
#define PG8_SB(b, h) ((4 + (b) * 2 + (h)) * HTB)
#define PG8_STAGE(bufoff, gbase, voff) do { _Pragma("unroll") for (int _i = 0; _i < 2; ++_i) \
        __builtin_amdgcn_global_load_lds((const unsigned*)((const char*)(gbase) + (voff)[_i]), (PG8_LAS unsigned*)(lds + (bufoff) + ldsw + _i * 8192), 16, 0, 0); } while (0)
#define PG8_LDA(dst, b, h) do { _Pragma("unroll") for (int m = 0; m < 4; ++m) _Pragma("unroll") for (int k = 0; k < 2; ++k) dst[m][k] = *(const PG8_LAS bf16x8*)(lds + PG8_SA(b, h) + aoff + m * 2048 + k * 1024); } while (0)
#define PG8_LDB(dst, b, h) do { _Pragma("unroll") for (int n = 0; n < 2; ++n) _Pragma("unroll") for (int k = 0; k < 2; ++k) dst[n][k] = *(const PG8_LAS bf16x8*)(lds + PG8_SB(b, h) + boff + n * 2048 + k * 1024); } while (0)
#define PG8_MMA(ai, bj, At, Bt) do { __builtin_amdgcn_s_setprio(1); _Pragma("unroll") for (int m = 0; m < 4; ++m) _Pragma("unroll") for (int n = 0; n < 2; ++n) _Pragma("unroll") for (int k = 0; k < 2; ++k) \
        acc[ai][bj][m][n] = __builtin_amdgcn_mfma_f32_16x16x32_bf16(Bt[n][k], At[m][k], acc[ai][bj][m][n], 0, 0, 0); __builtin_amdgcn_s_setprio(0); } while (0)
#define PG8_WAIT_V(n) asm volatile("s_waitcnt vmcnt(" #n ")" ::: "memory")
#define PG8_WAIT_L(n) asm volatile("s_waitcnt lgkmcnt(" #n ")" ::: "memory")
#define PG8_BAR __builtin_amdgcn_s_barrier()
#define PG8_SCHED __builtin_amdgcn_sched_barrier(0)
    Unit cur, nxt; int ui = 0;
    if (!S.next(0, cur)) return;
    f32x4 acc[2][2][4][2];
#pragma unroll
    for (int a = 0; a < 2; ++a)
#pragma unroll
        for (int b = 0; b < 2; ++b)
#pragma unroll
            for (int m = 0; m < 4; ++m)
#pragma unroll
                for (int n = 0; n < 2; ++n) acc[a][b][m][n] = (f32x4){0.f, 0.f, 0.f, 0.f};
    bf16x8 At[4][2], B0[2][2], B1[2][2];
    const char* cA = (const char*)g.A + (size_t)cur.pm * tstep; const char* cB = (const char*)g.Bt + (size_t)cur.pn * tstep;
    S.a_ready(cur);
    if constexpr (SP2) {
        PG8_STAGE(PG8_SB(0, 0), cB, voffB); PG8_STAGE(PG8_SB(0, 1), cB + hstep, voffB); PG8_STAGE(PG8_SA(0, 0), cA, voffA); PG8_STAGE(PG8_SA(0, 1), cA + hstep, voffA);
        if (wr == 1) PG8_BAR;
        PG8_WAIT_V(2); PG8_BAR;
        PG8_STAGE(PG8_SB(1, 0), cB + kstep, voffB); PG8_STAGE(PG8_SA(1, 0), cA + kstep, voffA); PG8_STAGE(PG8_SB(1, 1), cB + hstep + kstep, voffB);
        PG8_WAIT_V(6); PG8_BAR;
    } else {
        PG8_STAGE(PG8_SB(0, 0), cB, voffB); PG8_STAGE(PG8_SA(0, 0), cA, voffA); PG8_STAGE(PG8_SB(0, 1), cB + hstep, voffB); PG8_STAGE(PG8_SA(0, 1), cA + hstep, voffA);
        if (wr == 1) PG8_BAR;
        PG8_WAIT_V(4); PG8_BAR;
        PG8_STAGE(PG8_SB(1, 0), cB + kstep, voffB); PG8_STAGE(PG8_SA(1, 0), cA + kstep, voffA); PG8_STAGE(PG8_SB(1, 1), cB + hstep + kstep, voffB);
        PG8_WAIT_V(6); PG8_BAR;
    }
    for (;;) {
        const bool has_next = S.next(ui + 1, nxt);
        const char* nA = has_next ? (const char*)g.A + (size_t)nxt.pm * tstep : cA; const char* nB = has_next ? (const char*)g.Bt + (size_t)nxt.pn * tstep : cB;
        for (int t = 0; t < nt; t += 2) {
            const bool last = (t == nt - 2);
            const char* a1 = cA + (size_t)(t + 1) * kstep;
            const char* a2 = last ? nA : cA + (size_t)(t + 2) * kstep; const char* b2 = last ? nB : cB + (size_t)(t + 2) * kstep;
            const char* a3 = a2 + kstep; const char* b3 = b2 + kstep;
            if (last && has_next) S.a_ready(nxt);
            if constexpr (SP2) {
            PG8_LDB(B0, 0, 0); PG8_LDB(B1, 0, 1); PG8_SCHED; PG8_LDA(At, 0, 0); PG8_STAGE(PG8_SA(1, 1), a1 + hstep, voffA);
            PG8_WAIT_V(8); PG8_WAIT_L(0); PG8_BAR; PG8_MMA(0, 0, At, B0); PG8_MMA(0, 1, At, B1); PG8_BAR; PG8_SCHED;
            PG8_LDA(At, 0, 1); PG8_STAGE(PG8_SB(0, 0), b2, voffB); PG8_STAGE(PG8_SB(0, 1), b2 + hstep, voffB); PG8_STAGE(PG8_SA(0, 0), a2, voffA);
            PG8_WAIT_V(8); PG8_WAIT_L(0); PG8_BAR; PG8_MMA(1, 0, At, B0); PG8_MMA(1, 1, At, B1); PG8_BAR; PG8_SCHED;
            PG8_LDB(B0, 1, 0); PG8_LDB(B1, 1, 1); PG8_SCHED; PG8_LDA(At, 1, 0); PG8_STAGE(PG8_SA(0, 1), a2 + hstep, voffA);
            PG8_WAIT_V(8); PG8_WAIT_L(0); PG8_BAR; PG8_MMA(0, 0, At, B0); PG8_MMA(0, 1, At, B1); PG8_BAR; PG8_SCHED;
            PG8_LDA(At, 1, 1); PG8_STAGE(PG8_SB(1, 0), b3, voffB); PG8_STAGE(PG8_SB(1, 1), b3 + hstep, voffB); PG8_STAGE(PG8_SA(1, 0), a3, voffA);
            PG8_WAIT_V(8); PG8_WAIT_L(0); PG8_BAR; PG8_MMA(1, 0, At, B0); PG8_MMA(1, 1, At, B1); PG8_BAR; PG8_SCHED;
            } else {
            PG8_LDB(B0, 0, 0); PG8_SCHED; PG8_LDA(At, 0, 0); PG8_STAGE(PG8_SA(1, 1), a1 + hstep, voffA);
            PG8_WAIT_L(8); PG8_BAR; PG8_WAIT_L(0); PG8_MMA(0, 0, At, B0); PG8_BAR; PG8_SCHED;
            PG8_LDB(B1, 0, 1); PG8_STAGE(PG8_SB(0, 0), b2, voffB);
            PG8_BAR; PG8_WAIT_L(0); PG8_MMA(0, 1, At, B1); PG8_BAR;
            PG8_LDA(At, 0, 1); PG8_STAGE(PG8_SA(0, 0), a2, voffA);
            PG8_BAR; PG8_WAIT_L(0); PG8_MMA(1, 0, At, B0); PG8_BAR; PG8_SCHED;
            PG8_STAGE(PG8_SB(0, 1), b2 + hstep, voffB);
            PG8_WAIT_V(6); PG8_BAR; PG8_MMA(1, 1, At, B1); PG8_BAR;
            PG8_LDB(B0, 1, 0); PG8_SCHED; PG8_LDA(At, 1, 0); PG8_STAGE(PG8_SA(0, 1), a2 + hstep, voffA);
            PG8_WAIT_L(8); PG8_BAR; PG8_WAIT_L(0); PG8_MMA(0, 0, At, B0); PG8_BAR; PG8_SCHED;
            PG8_LDB(B1, 1, 1); PG8_STAGE(PG8_SB(1, 0), b3, voffB);
            PG8_BAR; PG8_WAIT_L(0); PG8_MMA(0, 1, At, B1); PG8_BAR;
            PG8_LDA(At, 1, 1); PG8_STAGE(PG8_SA(1, 0), a3, voffA);
            PG8_BAR; PG8_WAIT_L(0); PG8_MMA(1, 0, At, B0); PG8_BAR; PG8_SCHED;
            PG8_STAGE(PG8_SB(1, 1), b3 + hstep, voffB);
            PG8_WAIT_V(6); PG8_BAR; PG8_MMA(1, 1, At, B1); PG8_BAR;
            }
        }
        if constexpr (ALIGN_EPI) { if (wr == 0) PG8_BAR; }
        if constexpr (!Epi::AFTER_DRAIN) { E(acc, cur, wr, wc, fr, fq); S.done(cur); }
        if (!has_next) break;
#pragma unroll
        for (int a = 0; a < 2; ++a)
#pragma unroll
            for (int b = 0; b < 2; ++b)
#pragma unroll
                for (int m = 0; m < 4; ++m)
#pragma unroll
                    for (int n = 0; n < 2; ++n) acc[a][b][m][n] = (f32x4){0.f, 0.f, 0.f, 0.f};
        cur = nxt; cA = nA; cB = nB; ++ui;
        if constexpr (ALIGN_EPI) { if (wr == 1) PG8_BAR; }
    }
    PG8_WAIT_V(0);
    if constexpr (!ALIGN_EPI) { if (wr == 0) PG8_BAR; }
    PG8_BAR;
    if constexpr (Epi::AFTER_DRAIN) { E.fused(acc, cur, wr, wc, fr, fq, lds, wid, lane); S.done(cur); }
#undef PG8_SA
#undef PG8_SB
#undef PG8_STAGE
#undef PG8_LDA
#undef PG8_LDB
#undef PG8_MMA
#undef PG8_WAIT_V
#undef PG8_WAIT_L
#undef PG8_BAR
#undef PG8_SCHED
}
}
#define GAS __attribute__((address_space(1)))
#define LAS __attribute__((address_space(3)))
typedef unsigned short bf16;
typedef unsigned v4u __attribute__((ext_vector_type(4)));
typedef float f32x4 __attribute__((ext_vector_type(4)));
typedef short bf16x8 __attribute__((ext_vector_type(8)));
typedef GAS unsigned gu32;
typedef GAS unsigned long long gu64;
#define RLX_AGENT __ATOMIC_RELAXED, __HIP_MEMORY_SCOPE_AGENT
#define LDS_WAIT() asm volatile("s_waitcnt lgkmcnt(0)" ::: "memory")
#define VM_WAIT() asm volatile("s_waitcnt vmcnt(0)" ::: "memory")
__device__ __forceinline__ unsigned long long rt() { return __builtin_amdgcn_s_memrealtime(); }
__device__ __forceinline__ unsigned f2bf(float f) { unsigned u = __builtin_bit_cast(unsigned, f); return (u + 0x7fffu + ((u >> 16) & 1u)) >> 16; }
__device__ __forceinline__ unsigned pk2(float lo, float hi) { return f2bf(lo) | (f2bf(hi) << 16); }
#define XB_TMO      128
#define XB_XCNT(j)  (256  + 64 * (j))
#define XB_XSUB(j)  (1280 + 64 * (j))
#define XB_XGEN(j)  (2304 + 64 * (j))
#define XB_TOP      3328
#define XB_TOPGEN   3392
#define XCD_BAR_WORDS 3456
#define XB_SPIN_CAP (1u << 18)

__device__ __forceinline__ unsigned xb_ld(unsigned* p)              { return __hip_atomic_load(p, __ATOMIC_RELAXED, __HIP_MEMORY_SCOPE_AGENT); }
__device__ __forceinline__ unsigned xb_add(unsigned* p, unsigned v) { return __hip_atomic_fetch_add(p, v, __ATOMIC_RELAXED, __HIP_MEMORY_SCOPE_AGENT); }
__device__ __forceinline__ unsigned xb_xcc_id() { return (unsigned)__builtin_amdgcn_s_getreg((3 << 11) | 20) & 0xFu; }
#define XB_SPIN(cond, bar) do { unsigned _sp = 0; while (cond) { __builtin_amdgcn_s_sleep(1); \
    if ((++_sp & 255u) == 0u) { if (xb_ld(&(bar)[XB_TMO])) break; if (_sp > XB_SPIN_CAP) { atomicAdd(&(bar)[XB_TMO], 1u); break; } } } } while (0)

struct XcdBarrier {
    unsigned* bar; unsigned x;
    volatile LAS unsigned* st;
};

__device__ __forceinline__ XcdBarrier xcd_barrier_post(unsigned* bar, volatile LAS unsigned* st) {
    XcdBarrier b; b.bar = bar; b.x = xb_xcc_id(); b.st = st;
    if (threadIdx.x == 0) (void)xb_add(&bar[XB_XCNT(b.x)], 1u);
    return b;
}
__device__ __forceinline__ void xcd_barrier_complete(unsigned* bar, unsigned x, unsigned& nloc, unsigned& nx) {
    const unsigned G = gridDim.x * gridDim.y * gridDim.z;
    unsigned sum, cnt, mine, sp = 0u;
    for (;;) {
        sum = 0u; cnt = 0u; mine = 0u;
#pragma unroll
        for (unsigned j = 0; j < 16; ++j) { const unsigned c = xb_ld(&bar[XB_XCNT(j)]); sum += c; cnt += (c > 0u) ? 1u : 0u; mine = (j == x) ? c : mine; }
        if (sum == G) break;
        __builtin_amdgcn_s_sleep(1);
        if ((++sp & 255u) == 0u) { if (xb_ld(&bar[XB_TMO])) break; if (sp > XB_SPIN_CAP) { atomicAdd(&bar[XB_TMO], 1u); break; } }
    }
    nloc = mine > 0u ? mine : 1u; nx = cnt > 0u ? cnt : 1u;
}

__device__ __forceinline__ void xcd_barrier(const XcdBarrier& b) {
    asm volatile("s_waitcnt vmcnt(0)" ::: "memory");
    __syncthreads();
    if (threadIdx.x == 0) {
        unsigned* bar = b.bar;
        __builtin_amdgcn_s_waitcnt(0);
        unsigned nloc = b.st[0], nx = b.st[1];
        if (nloc == 0u) { xcd_barrier_complete(bar, b.x, nloc, nx); b.st[0] = nloc; b.st[1] = nx; }
        const unsigned old = xb_add(&bar[XB_XSUB(b.x)], 1u);
        const unsigned gen = old / nloc;
        if (old + 1u == (gen + 1u) * nloc) {
            __builtin_amdgcn_fence(__ATOMIC_RELEASE, "agent");
            asm volatile("s_waitcnt vmcnt(0)" ::: "memory");
            const unsigned og = xb_add(&bar[XB_TOP], 1u);
            const unsigned tg = og / nx;
            if (og + 1u == (tg + 1u) * nx) xb_add(&bar[XB_TOPGEN], 1u);
            else XB_SPIN(xb_ld(&bar[XB_TOPGEN]) == tg, bar);
            __builtin_amdgcn_fence(__ATOMIC_ACQUIRE, "agent");
            xb_add(&bar[XB_XGEN(b.x)], 1u);
            asm volatile("s_waitcnt vmcnt(0)" ::: "memory");
        } else {
            XB_SPIN(xb_ld(&bar[XB_XGEN(b.x)]) == gen, bar);
            __builtin_amdgcn_fence(__ATOMIC_ACQUIRE, "agent");
            asm volatile("s_waitcnt vmcnt(0)" ::: "memory");
        }
    }
    __syncthreads();
}
namespace wa {
typedef unsigned short u16;
typedef short bf16x8 __attribute__((ext_vector_type(8)));
typedef short s16x4 __attribute__((ext_vector_type(4)));
typedef float f32x16 __attribute__((ext_vector_type(16)));
typedef unsigned u32x4 __attribute__((ext_vector_type(4)));
typedef __attribute__((address_space(3))) unsigned char* lptr;
#define WA_LAS __attribute__((address_space(3)))
__device__ __forceinline__ int crow(int r, int hi) { return (r & 3) + 8 * (r >> 2) + 4 * hi; }
typedef float f32x2_t __attribute__((ext_vector_type(2))); typedef __bf16 bf16x2_t __attribute__((ext_vector_type(2)));
__device__ __forceinline__ unsigned cvtpk(float lo, float hi) { f32x2_t v = {lo, hi}; bf16x2_t b = __builtin_convertvector(v, bf16x2_t); return __builtin_bit_cast(unsigned, b); }
__device__ __forceinline__ float bflo(unsigned w) { return __builtin_bit_cast(float, w << 16); }
__device__ __forceinline__ float bfhi(unsigned w) { return __builtin_bit_cast(float, w & 0xffff0000u); }

struct TileRegs { u32x4 k[8], v[8]; };
constexpr unsigned PITCH = 2304;
__device__ __forceinline__ void tile_load(TileRegs& t, const u16* Kp, const u16* Vp, unsigned koff, unsigned voff) {
#pragma unroll
    for (int i = 0; i < 8; ++i) t.k[i] = *(const u32x4*)(Kp + (size_t)(8 * i) * PITCH + koff);
#pragma unroll
    for (int pc = 0; pc < 8; ++pc) t.v[pc] = *(const u32x4*)(Vp + (size_t)(16 * (pc & 3)) * PITCH + (pc >> 2) * 32 + voff);
}
__device__ __forceinline__ void tile_store(const TileRegs& t, lptr slot, int lane) {
#pragma unroll
    for (int i = 0; i < 8; ++i) *(WA_LAS u32x4*)(slot + (lane & 7) * 1024 + (8 * i + (lane >> 3)) * 16) = t.k[i];
#pragma unroll
    for (int pc = 0; pc < 8; ++pc) *(WA_LAS u32x4*)(slot + 8192 + pc * 1024 + lane * 16) = t.v[pc];
}
__device__ __forceinline__ void qkt(f32x16& p0, f32x16& p1, lptr slot, const bf16x8 (&qr)[4], int r32, int hi) {
    const lptr kb = slot + hi * 1024 + r32 * 16;
    const f32x16 z = {0.f, 0.f, 0.f, 0.f, 0.f, 0.f, 0.f, 0.f, 0.f, 0.f, 0.f, 0.f, 0.f, 0.f, 0.f, 0.f};
    p0 = z; p1 = z;
#pragma unroll
    for (int d0 = 0; d0 < 4; ++d0) {
        const bf16x8 b0 = *(const WA_LAS bf16x8*)(kb + d0 * 2048);
        const bf16x8 b1 = *(const WA_LAS bf16x8*)(kb + d0 * 2048 + 512);
        p0 = __builtin_amdgcn_mfma_f32_32x32x16_bf16(b0, qr[d0], p0, 0, 0, 0);
        p1 = __builtin_amdgcn_mfma_f32_32x32x16_bf16(b1, qr[d0], p1, 0, 0, 0);
    }
}
typedef short v4i16_t __attribute__((ext_vector_type(4)));
__device__ __forceinline__ s16x4 vtr(lptr p) { return __builtin_bit_cast(s16x4, __builtin_amdgcn_ds_read_tr16_b64_v4i16((WA_LAS v4i16_t*)p)); }
__device__ __forceinline__ void pv(f32x16 (&o)[2], lptr slot, const u32x4 (&pw)[4], int lane) {
    const int hi = lane >> 5;
    const lptr vb = slot + 8192 + ((lane >> 4) & 1) * 32 + (lane & 3) * 8 + (4 * hi + ((lane & 15) >> 2)) * 64;
#pragma unroll
    for (int d0 = 0; d0 < 2; ++d0)
#pragma unroll
        for (int ks = 0; ks < 4; ++ks) {
            const s16x4 lo = vtr(vb + d0 * 4096 + ks * 1024), hh = vtr(vb + d0 * 4096 + ks * 1024 + 512);
            const bf16x8 vf = (bf16x8){lo[0], lo[1], lo[2], lo[3], hh[0], hh[1], hh[2], hh[3]};
            o[d0] = __builtin_amdgcn_mfma_f32_32x32x16_bf16(__builtin_bit_cast(bf16x8, pw[ks]), vf, o[d0], 0, 0, 0);
        }
}
__device__ __forceinline__ void xhalf(float mine, float& other) {
    unsigned x = __builtin_bit_cast(unsigned, mine), y = x; asm volatile("" : "+v"(y));
    auto rr = __builtin_amdgcn_permlane32_swap(x, y, false, false);
    const unsigned lo = rr[0], hi = rr[1];
    other = __builtin_bit_cast(float, (__builtin_amdgcn_mbcnt_hi(~0u, __builtin_amdgcn_mbcnt_lo(~0u, 0u)) < 32u) ? hi : lo);
}
__device__ __forceinline__ float rowmax(const f32x16& p0, const f32x16& p1) {
    float a = fmaxf(p0[0], p1[0]);
#pragma unroll
    for (int r = 1; r < 16; ++r) a = fmaxf(a, fmaxf(p0[r], p1[r]));
    float other; xhalf(a, other);
    return fmaxf(a, other);
}
struct State { f32x16 o[2]; float m, l; };
__device__ __forceinline__ void sm_pv(State& st, f32x16& p0, f32x16& p1, lptr slot, WA_LAS float* wsf, int lane) {
    const int r32 = lane & 31, hi = lane >> 5;
    const float rm = rowmax(p0, p1);
    const float mnew = fmaxf(st.m, rm);
    const float ms = (mnew == -INFINITY) ? 0.f : mnew;
    const float alpha = __builtin_amdgcn_exp2f(st.m - ms);
    st.m = mnew;
    float ps = 0.f;
#pragma unroll
    for (int r = 0; r < 16; ++r) { p0[r] = __builtin_amdgcn_exp2f(p0[r] - ms); p1[r] = __builtin_amdgcn_exp2f(p1[r] - ms); ps += p0[r] + p1[r]; }
    st.l = st.l * alpha + ps;
    if (!__all(alpha == 1.0f)) {
        if (hi == 0) wsf[r32] = alpha;
#pragma unroll
        for (int r = 0; r < 16; ++r) { const float f = wsf[crow(r, hi)]; st.o[0][r] *= f; st.o[1][r] *= f; }
    }
    u32x4 pw[4];
#pragma unroll
    for (int i = 0; i < 4; ++i) { pw[0][i] = cvtpk(p0[2 * i], p0[2 * i + 1]); pw[1][i] = cvtpk(p0[8 + 2 * i], p0[9 + 2 * i]); pw[2][i] = cvtpk(p1[2 * i], p1[2 * i + 1]); pw[3][i] = cvtpk(p1[8 + 2 * i], p1[9 + 2 * i]); }
    pv(st.o, slot, pw, lane);
}
__device__ __forceinline__ void row_recip(const State& st, float (&rl)[16], WA_LAS float* wsf, int lane) {
    const int r32 = lane & 31, hi = lane >> 5;
    float other; xhalf(st.l, other);
    const float lt = st.l + other;
    if (hi == 0) wsf[32 + r32] = lt;
#pragma unroll
    for (int r = 0; r < 16; ++r) rl[r] = 1.0f / wsf[32 + crow(r, hi)];
}
__device__ __forceinline__ void store_mul(const State& st, const float (&rl)[16], u16* Yp, lptr stg_, int lane) {
    const int r32 = lane & 31, hi = lane >> 5; WA_LAS u16* stg = (WA_LAS u16*)stg_;
#pragma unroll
    for (int r = 0; r < 16; ++r) { const int orow = crow(r, hi);
#pragma unroll
        for (int d0 = 0; d0 < 2; ++d0) stg[orow * 64 + d0 * 32 + r32] = (u16)(cvtpk(st.o[d0][r] * rl[r], 0.f) & 0xffffu); }
    asm volatile("s_waitcnt lgkmcnt(0)" ::: "memory");
#pragma unroll
    for (int i = 0; i < 4; ++i) { const int row = i * 8 + (lane >> 3), ch = lane & 7;
        const u32x4 a = *(const WA_LAS u32x4*)(stg + row * 64 + ch * 8); u32x4* gp = (u32x4*)(Yp + (size_t)row * 1024 + ch * 8); const u32x4 y = *gp; u32x4 w;
#pragma unroll
        for (int e = 0; e < 4; ++e) w[e] = cvtpk(bflo(a[e]) * bflo(y[e]), bfhi(a[e]) * bfhi(y[e]));
        *gp = w; }
}

struct SpecPlain {
    const u16 *K, *V; int n;
    __device__ __forceinline__ int nt() const { return n; }
    __device__ __forceinline__ void tile(int j, const u16*& Kp, const u16*& Vp) const { Kp = K + (size_t)(64 * j) * PITCH; Vp = V + (size_t)(64 * j) * PITCH; }
    __device__ __forceinline__ void mask(int, f32x16&, f32x16&, int) const {}
};
struct SpecNA {
    const u16 *K, *V;
    int r, rs, c, cs; const WA_LAS float* bias;
    __device__ __forceinline__ int nt() const { return 12; }
    __device__ __forceinline__ void tile(int j, const u16*& Kp, const u16*& Vp) const { const int row = (j < 8) ? 64 * (rs + j) : 8192 + 64 * (j - 8); Kp = K + (size_t)row * PITCH; Vp = V + (size_t)row * PITCH; }
    __device__ __forceinline__ void mask(int j, f32x16& p0, f32x16& p1, int hi) const {
        if (j >= 8) return;
        const int base = (rs + j - r + 7) * 31 + 15 - c;
#pragma unroll
        for (int rr = 0; rr < 16; ++rr) {
            const int k0 = crow(rr, hi), k1 = k0 + 32;
            const bool v0 = (k0 >= cs) && (k0 <= cs + 15), v1 = (k1 >= cs) && (k1 <= cs + 15);
            const float b0 = bias[v0 ? base + k0 : 0], b1 = bias[v1 ? base + k1 : 0];
            p0[rr] = v0 ? p0[rr] + b0 : -INFINITY; p1[rr] = v1 ? p1[rr] + b1 : -INFINITY;
        }
    }
};
struct SpecWin {
    const u16 *K, *V; int ks0, nw, q;
    __device__ __forceinline__ int nt() const { return nw + 4; }
    __device__ __forceinline__ void tile(int j, const u16*& Kp, const u16*& Vp) const { const int row = (j < nw) ? ks0 + 64 * j : 8192 + 64 * (j - nw); Kp = K + (size_t)row * PITCH; Vp = V + (size_t)row * PITCH; }
    __device__ __forceinline__ void mask(int j, f32x16& p0, f32x16& p1, int hi) const {
        if (j >= nw) return;
#ifdef NOMASK_D
        return;
#endif
        const int kb = ks0 + 64 * j - q;
#pragma unroll
        for (int rr = 0; rr < 16; ++rr) { const int d0 = kb + crow(rr, hi), d1 = d0 + 32;
            if (d0 < -128 || d0 > 128) p0[rr] = -INFINITY; if (d1 < -128 || d1 > 128) p1[rr] = -INFINITY; }
    }
};
template <class Spec>
__device__ __forceinline__ void run(const Spec& sp, const u16* Qp, State& st, lptr slot, WA_LAS float* wsf, int lane, float* dumpS = nullptr, bool ksel = true) {
    const int r32 = lane & 31, hi = lane >> 5;
    bf16x8 qr[4];
#pragma unroll
    for (int d0 = 0; d0 < 4; ++d0) qr[d0] = *(const bf16x8*)(Qp + d0 * 16 + hi * 8);
    const f32x16 z = {0.f, 0.f, 0.f, 0.f, 0.f, 0.f, 0.f, 0.f, 0.f, 0.f, 0.f, 0.f, 0.f, 0.f, 0.f, 0.f};
    st.o[0] = z; st.o[1] = z;
    const int nt = sp.nt();
    TileRegs tr; const u16 *Kp, *Vp;
    const unsigned koff = (unsigned)(lane >> 3) * PITCH + (lane & 7) * 8, voff = (unsigned)(lane >> 2) * PITCH + (lane & 3) * 8;
#ifndef NOPF
    sp.tile(0, Kp, Vp); tile_load(tr, Kp, Vp, koff, voff);
#endif
    for (int j = 0; j < nt; ++j) {
#ifdef NOPF
        sp.tile(j, Kp, Vp); tile_load(tr, Kp, Vp, koff, voff);
        asm volatile("s_waitcnt vmcnt(0) lgkmcnt(0)" ::: "memory");
#endif
        tile_store(tr, slot, lane);
        asm volatile("" ::: "memory");
#ifdef NOPF
        asm volatile("s_waitcnt vmcnt(0) lgkmcnt(0)" ::: "memory");
#else
        if (j + 1 < nt) { sp.tile(j + 1, Kp, Vp); tile_load(tr, Kp, Vp, koff, voff); }
#endif
        f32x16 p0, p1;
        qkt(p0, p1, slot, qr, r32, hi);
#ifdef DUMP_S
        if (dumpS && j == 0) {
#pragma unroll
            for (int r = 0; r < 16; ++r) { dumpS[(size_t)r32 * 64 + crow(r, hi)] = p0[r]; dumpS[(size_t)r32 * 64 + 32 + crow(r, hi)] = p1[r]; }
        }
#endif
#ifdef UNIFORM_P
        p0 = p0 * 0.f; p1 = p1 * 0.f;
#endif
#ifdef KSEL
        if (ksel)
#pragma unroll
        for (int r = 0; r < 16; ++r) { if (crow(r, hi) != (KSEL)) p0[r] = -INFINITY; if (crow(r, hi) + 32 != (KSEL)) p1[r] = -INFINITY; }
#endif
        sp.mask(j, p0, p1, hi);
        sm_pv(st, p0, p1, slot, wsf, lane);
        asm volatile("" ::: "memory");
    }
}
}
namespace fa {
using bf16=__hip_bfloat16;
using bf16x8=__attribute__((ext_vector_type(8)))short;
using s16x4=__attribute__((ext_vector_type(4)))short;
using f32x16=__attribute__((ext_vector_type(16)))float;
using u32x4=__attribute__((ext_vector_type(4)))unsigned;
constexpr int D=64,DM=2304;
constexpr int NW=8,QBLK=32,QB=QBLK*NW,KVBLK=64;
__device__ __forceinline__ int crow(int r,int hi){return (r&3)+8*(r>>2)+4*hi;}
#define SBAR() __builtin_amdgcn_sched_barrier(0)
__device__ __forceinline__ void cmask(f32x16&p0,f32x16&p1,int jb,int qrel,int hi){
  const float NEG=-INFINITY; int kb=64*jb+4*hi;
  #pragma unroll
  for(int r=0;r<16;++r){int kv=kb+(r&3)+8*(r>>2); if(kv>qrel)p0[r]=NEG; if(kv+32>qrel)p1[r]=NEG;}
}

constexpr int NSLOT=3, SLOTB=8192;
constexpr int LDS_K=0, LDS_V=NSLOT*SLOTB, LDS_WS=2*NSLOT*SLOTB, LDS_OST=LDS_WS+NW*64*4, LDS_BYTES=LDS_OST+NW*4096;
constexpr float C2=0.125f*1.4426950408889634f;
__device__ __forceinline__ void glds16(const void*gsrc,unsigned lds_dst){unsigned keep;
  asm volatile("s_mov_b32 %0, m0\n\ts_mov_b32 m0, %2\n\ts_nop 0\n\tglobal_load_lds_dwordx4 %1, off\n\ts_mov_b32 m0, %0":"=&s"(keep):"v"(gsrc),"s"(lds_dst):"memory");}
__device__ __forceinline__ float max3f(float a,float b,float c){float r;asm("v_max3_f32 %0, %1, %2, %3":"=v"(r):"v"(a),"v"(b),"v"(c));return r;}
__device__ __forceinline__ float max2f(float a,float b){float r;asm("v_max_f32_e32 %0, %1, %2":"=v"(r):"v"(a),"v"(b));return r;}
__device__ __forceinline__ float fadd_s(float a,float b){float r;asm("v_add_f32_e32 %0, %1, %2":"=v"(r):"v"(a),"v"(b));return r;}
__device__ __forceinline__ float fsub_s(float a,float b){float r;asm("v_sub_f32_e32 %0, %1, %2":"=v"(r):"v"(a),"v"(b));return r;}
typedef float f32x2_t __attribute__((ext_vector_type(2))); typedef __bf16 bf16x2_t __attribute__((ext_vector_type(2)));
__device__ __forceinline__ unsigned cvtpk_s(float lo,float hi){f32x2_t v={lo,hi};bf16x2_t b=__builtin_convertvector(v,bf16x2_t);return __builtin_bit_cast(unsigned,b);}
#define WAIT_BAR(N) asm volatile("s_waitcnt vmcnt(" #N ") lgkmcnt(0)\n\ts_barrier":::"memory")

__device__ __forceinline__ void qkt(f32x16&p0,f32x16&p1,const char*Kslot,const bf16x8*qr,const f32x16&negm,int r32,int hi){
  const char*kb=Kslot+hi*1024+r32*16;
  #pragma unroll
  for(int d0=0;d0<4;++d0){
    const bf16x8 b0=*reinterpret_cast<const bf16x8*>(kb+d0*2048);
    const bf16x8 b1=*reinterpret_cast<const bf16x8*>(kb+d0*2048+512);
    if(d0==0){p0=__builtin_amdgcn_mfma_f32_32x32x16_bf16(b0,qr[0],negm,0,0,0);p1=__builtin_amdgcn_mfma_f32_32x32x16_bf16(b1,qr[0],negm,0,0,0);}
    else{p0=__builtin_amdgcn_mfma_f32_32x32x16_bf16(b0,qr[d0],p0,0,0,0);p1=__builtin_amdgcn_mfma_f32_32x32x16_bf16(b1,qr[d0],p1,0,0,0);}}
}
typedef __attribute__((address_space(3))) const char* lds_cptr;
typedef short v4i16_t __attribute__((ext_vector_type(4)));
__device__ __forceinline__ void kload8(bf16x8*kf,lds_cptr kp){
  kf[0]=*(const __attribute__((address_space(3))) bf16x8*)(kp);      kf[1]=*(const __attribute__((address_space(3))) bf16x8*)(kp+512);
  kf[2]=*(const __attribute__((address_space(3))) bf16x8*)(kp+2048); kf[3]=*(const __attribute__((address_space(3))) bf16x8*)(kp+2560);
  kf[4]=*(const __attribute__((address_space(3))) bf16x8*)(kp+4096); kf[5]=*(const __attribute__((address_space(3))) bf16x8*)(kp+4608);
  kf[6]=*(const __attribute__((address_space(3))) bf16x8*)(kp+6144); kf[7]=*(const __attribute__((address_space(3))) bf16x8*)(kp+6656);
}
__device__ __forceinline__ void kload2(bf16x8*kf,lds_cptr kp,int j){ kf[2*j]=*(const __attribute__((address_space(3))) bf16x8*)(kp+j*2048); kf[2*j+1]=*(const __attribute__((address_space(3))) bf16x8*)(kp+j*2048+512); }
__device__ __forceinline__ s16x4 vtr(lds_cptr p){ return __builtin_bit_cast(s16x4,__builtin_amdgcn_ds_read_tr16_b64_v4i16((__attribute__((address_space(3))) v4i16_t*)p)); }
__device__ __forceinline__ float xhalf(float mine){ unsigned x=__float_as_uint(mine),y=x; asm volatile("":"+v"(y)); auto rr=__builtin_amdgcn_permlane32_swap(x,y,false,false);
  const unsigned lo=rr[0],hi_=rr[1]; return __uint_as_float((__builtin_amdgcn_mbcnt_hi(~0u,__builtin_amdgcn_mbcnt_lo(~0u,0u))<32u)?hi_:lo); }
__device__ __forceinline__ float rowmax(const f32x16&p0,const f32x16&p1){
  float a=max3f(p0[0],p0[1],p1[0]),b=max3f(p0[2],p0[3],p1[1]);a=max3f(a,p1[2],p1[3]);
  #pragma unroll
  for(int r=4;r<16;r+=4){a=max3f(a,p0[r],p0[r+1]);b=max3f(b,p0[r+2],p0[r+3]);a=max3f(a,p1[r],p1[r+1]);b=max3f(b,p1[r+2],p1[r+3]);}
  const float m=max2f(a,b);
  return max2f(m,xhalf(m));
}
__device__ __forceinline__ void pv(f32x16*o,int vb,bf16x8 pa0,bf16x8 pa1,bf16x8 pa2,bf16x8 pa3){
  #pragma unroll
  for(int d0=0;d0<2;++d0){s16x4 lo[4],hi[4];
    #pragma unroll
    for(int ks=0;ks<4;++ks){
      asm volatile("ds_read_b64_tr_b16 %0,%1 offset:%c2":"=&v"(lo[ks]):"v"(vb),"i"(d0*4096+ks*1024):"memory");
      asm volatile("ds_read_b64_tr_b16 %0,%1 offset:%c2":"=&v"(hi[ks]):"v"(vb),"i"(d0*4096+ks*1024+512):"memory");}
    asm volatile("s_waitcnt lgkmcnt(0)":::"memory");SBAR();
    #define PK(k) (bf16x8){lo[k][0],lo[k][1],lo[k][2],lo[k][3],hi[k][0],hi[k][1],hi[k][2],hi[k][3]}
    o[d0]=__builtin_amdgcn_mfma_f32_32x32x16_bf16(pa0,PK(0),o[d0],0,0,0);
    o[d0]=__builtin_amdgcn_mfma_f32_32x32x16_bf16(pa1,PK(1),o[d0],0,0,0);
    o[d0]=__builtin_amdgcn_mfma_f32_32x32x16_bf16(pa2,PK(2),o[d0],0,0,0);
    o[d0]=__builtin_amdgcn_mfma_f32_32x32x16_bf16(pa3,PK(3),o[d0],0,0,0);
    #undef PK
  }
}

#ifndef ATTN_STORE16
#define ATTN_STORE16(p,v) (*(u32x4*)(p)=(v))
#endif
template<int THRL,class TM,class Out> __device__ __forceinline__ void attn_unit(const TM&tm,const bf16*__restrict__ Kh,const bf16*__restrict__ Vh,const int NT,char*shm,const Out&out){
  int tid_=threadIdx.x; asm volatile("":"+v"(tid_)); const int tid=tid_,lane=tid&63,r32=lane&31,hi=lane>>5; const int wid=__builtin_amdgcn_readfirstlane(tid>>6);
  const bf16*Qw=tm.qrow(wid);
  const unsigned lds0=(unsigned)(uintptr_t)shm;
  float*wsf=(float*)(shm+LDS_WS)+wid*64;
  const bf16*ksrc=Kh+(long)lane*DM+wid*8;
  const bf16*vsrc=Vh+(long)(16*(wid&3)+(lane>>2))*DM+(wid>>2)*32+(lane&3)*8;
  const unsigned kdst=lds0+LDS_K+wid*1024, vdst=lds0+LDS_V+wid*1024;
  #define DMA_K(t,slot) glds16(ksrc+tm.off(t),(unsigned)__builtin_amdgcn_readfirstlane(kdst+(slot)))
  #define DMA_V(t,slot) glds16(vsrc+tm.off(t),(unsigned)__builtin_amdgcn_readfirstlane(vdst+(slot)))
  const int vb0=(int)(lds0+LDS_V)+((lane>>4)&1)*32+(lane&3)*8+(4*hi+((lane&15)>>2))*64;
  const char*Kbase=shm+LDS_K; bf16x8 kf[8];
  const lds_cptr shm3=(lds_cptr)shm; const lds_cptr kp0=shm3+LDS_K+hi*1024+r32*16; const lds_cptr vp0=shm3+LDS_V+((lane>>4)&1)*32+(lane&3)*8+(4*hi+((lane&15)>>2))*64;
  DMA_K(0,0);DMA_V(0,0);DMA_K(1,SLOTB);
  bf16x8 qr[4];
  #pragma unroll
  for(int d0=0;d0<4;++d0)qr[d0]=*reinterpret_cast<const bf16x8*>(&Qw[(long)r32*DM+d0*16+hi*8]);
  float mhat=0.f,l_reg=0.f;f32x16 o[2];o[0]=f32x16{};o[1]=f32x16{};f32x16 negm=f32x16{};asm volatile("":"+v"(negm));
  #define CMASK(P0,P1,t) tm.mask(P0,P1,t,hi)
  bool resc=false;
  #define START(P0,P1) do{ const float rm=rowmax(P0,P1); resc=false; \
    { const float dl=rm; mhat=fadd_s(mhat,dl); \
      _Pragma("unroll") for(int r=0;r<16;++r){P0[r]=fsub_s(P0[r],dl);P1[r]=fsub_s(P1[r],dl);} \
      _Pragma("unroll") for(int r=0;r<16;++r)negm[r]=-mhat; asm volatile("":"+v"(negm)); } \
    _Pragma("unroll") for(int r=0;r<16;++r)P0[r]=__builtin_amdgcn_exp2f(P0[r]); }while(0)
  #define RESC() do{ if(resc){ asm volatile("s_waitcnt lgkmcnt(0)":::"memory"); \
      _Pragma("unroll") for(int d_=0;d_<2;++d_) _Pragma("unroll") for(int r=0;r<16;++r)o[d_][r]*=wsf[crow(r,hi)]; } }while(0)
  f32x16 pA0,pA1,pB0,pB1;
  int sl_prev=0,sl_cur=0,sl_next=SLOTB;
  #define ROT() do{sl_prev=sl_cur;sl_cur=sl_next;sl_next=(sl_next==(NSLOT-1)*SLOTB)?0:sl_next+SLOTB;}while(0)
  DMA_K(2,2*SLOTB);
  WAIT_BAR(3);
  qkt(pA0,pA1,Kbase,qr,negm,r32,hi);asm volatile("s_nop 15\n\ts_nop 7":"+v"(pA0),"+v"(pA1));CMASK(pA0,pA1,0);
  START(pA0,pA1);
  { const float sk=tm.sink(); if(sk!=-INFINITY&&hi==0)l_reg+=__builtin_amdgcn_exp2f(sk-mhat); }
  _Pragma("unroll") for(int r=0;r<16;++r)pA1[r]=__builtin_amdgcn_exp2f(pA1[r]);
  WAIT_BAR(0);
  DMA_K(3,0);DMA_V(1,SLOTB);
  ROT();
  kload8(kf,kp0+sl_cur);
  WAIT_BAR(2);
  s16x4 vlo[8],vhi[8]; u32x4 pw0,pw1,pw2,pw3;
  #define PKW(P,B) cvtpk_s(P[B],P[B+1])
  #define PAF(k) __builtin_bit_cast(bf16x8,pw##k)
  #define VFR(i) (bf16x8){vlo[i][0],vlo[i][1],vlo[i][2],vlo[i][3],vhi[i][0],vhi[i][1],vhi[i][2],vhi[i][3]}
  #define PIN(x) asm volatile("":"+v"(x))
  #define MX3(a,b,c) __builtin_fmaxf(__builtin_fmaxf((a),(b)),(c))
  #define GAPA(MF,A0,A1,A2,A3,W0,W1,PW) do{ MF; sacc+=A0; sacc+=A1; sacc+=A2; sacc+=A3; PIN(sacc); W0; W1; PIN(PW); SBAR(); }while(0)
  #define EX(v) __builtin_amdgcn_exp2f(v)
  #define GAPB(MF,X,B) do{ MF; X[B]=EX(X[B]); X[B+1]=EX(X[B+1]); X[B+2]=EX(X[B+2]); X[B+3]=EX(X[B+3]); PIN(X); SBAR(); }while(0)
  #define VRD(i) do{ vlo[i]=vtr(vp_+(((i)>>2)*4096+((i)&3)*1024)); vhi[i]=vtr(vp_+(((i)>>2)*4096+((i)&3)*1024+512)); }while(0)
  #define KRD(G,j) do{ if(G){ kload2(kf,kp0+sl_next,j); SBAR(); } }while(0)
  #define STEP(C0,C1,P0,P1,t,GK,GV,GL) do{ SBAR(); \
    const lds_cptr vp_=vp0+sl_prev; \
    VRD(0); SBAR(); float sacc=(P0[0]+P0[1]); \
    GAPA(C0=__builtin_amdgcn_mfma_f32_32x32x16_bf16(kf[0],qr[0],negm,0,0,0), P0[2],P0[3],P0[4],P0[5],     pw0[0]=PKW(P0,0), pw0[1]=PKW(P0,2), pw0); \
    VRD(4); SBAR(); GAPA(C1=__builtin_amdgcn_mfma_f32_32x32x16_bf16(kf[1],qr[0],negm,0,0,0), P0[6],P0[7],P0[8],P0[9],     pw0[2]=PKW(P0,4), pw0[3]=PKW(P0,6), pw0); \
    VRD(1); SBAR(); GAPA(C0=__builtin_amdgcn_mfma_f32_32x32x16_bf16(kf[2],qr[1],C0,0,0,0),   P0[10],P0[11],P0[12],P0[13], pw1[0]=PKW(P0,8), pw1[1]=PKW(P0,10), pw1); \
    VRD(5); SBAR(); GAPA(C1=__builtin_amdgcn_mfma_f32_32x32x16_bf16(kf[3],qr[1],C1,0,0,0),   P0[14],P0[15],P1[0],P1[1],   pw1[2]=PKW(P0,12),pw1[3]=PKW(P0,14), pw1); \
    VRD(2); SBAR(); GAPA(C0=__builtin_amdgcn_mfma_f32_32x32x16_bf16(kf[4],qr[2],C0,0,0,0),   P1[2],P1[3],P1[4],P1[5],     pw2[0]=PKW(P1,0), pw2[1]=PKW(P1,2), pw2); \
    VRD(6); SBAR(); GAPA(C1=__builtin_amdgcn_mfma_f32_32x32x16_bf16(kf[5],qr[2],C1,0,0,0),   P1[6],P1[7],P1[8],P1[9],     pw2[2]=PKW(P1,4), pw2[3]=PKW(P1,6), pw2); \
    VRD(3); SBAR(); GAPA(C0=__builtin_amdgcn_mfma_f32_32x32x16_bf16(kf[6],qr[3],C0,0,0,0),   P1[10],P1[11],P1[12],P1[13], pw3[0]=PKW(P1,8), pw3[1]=PKW(P1,10), pw3); \
    VRD(7); SBAR(); GAPA(C1=__builtin_amdgcn_mfma_f32_32x32x16_bf16(kf[7],qr[3],C1,0,0,0),   P1[14],P1[15],0.f,0.f,       pw3[2]=PKW(P1,12),pw3[3]=PKW(P1,14), pw3); \
    l_reg+=sacc; \
    if(GK){DMA_K((t)+3,sl_cur);} if(GV){DMA_V((t)+1,sl_next);} \
    CMASK(C0,C1,t); \
    { float a=MX3(C0[0],C0[1],C1[0]),b=MX3(C0[2],C0[3],C1[1]); a=MX3(a,C1[2],C1[3]); \
      _Pragma("unroll") for(int r=4;r<16;r+=4){a=MX3(a,C0[r],C0[r+1]);b=MX3(b,C0[r+2],C0[r+3]);a=MX3(a,C1[r],C1[r+1]);b=MX3(b,C1[r+2],C1[r+3]);} \
      float rm=__builtin_fmaxf(a,b); rm=__builtin_fmaxf(rm,xhalf(rm)); \
      resc=false; \
      if(__builtin_expect(__any(rm>(float)THRL),0)){ const float dl=__builtin_fmaxf(rm,0.f); mhat+=dl; \
        _Pragma("unroll") for(int r=0;r<16;++r){C0[r]-=dl;C1[r]-=dl;} \
        _Pragma("unroll") for(int r=0;r<16;++r)negm[r]=-mhat; asm volatile("":"+v"(negm)); \
        const float f=__builtin_amdgcn_exp2f(-dl); l_reg*=f; if(hi==0)wsf[r32]=f; resc=true; } } \
    SBAR(); \
    GAPB(o[0]=__builtin_amdgcn_mfma_f32_32x32x16_bf16(PAF(0),VFR(0),o[0],0,0,0), C0,0); \
    GAPB(o[1]=__builtin_amdgcn_mfma_f32_32x32x16_bf16(PAF(0),VFR(4),o[1],0,0,0), C0,4); \
    KRD(GL,0); GAPB(o[0]=__builtin_amdgcn_mfma_f32_32x32x16_bf16(PAF(1),VFR(1),o[0],0,0,0), C0,8); \
    KRD(GL,1); GAPB(o[1]=__builtin_amdgcn_mfma_f32_32x32x16_bf16(PAF(1),VFR(5),o[1],0,0,0), C0,12); \
    KRD(GL,2); GAPB(o[0]=__builtin_amdgcn_mfma_f32_32x32x16_bf16(PAF(2),VFR(2),o[0],0,0,0), C1,0); \
    KRD(GL,3); GAPB(o[1]=__builtin_amdgcn_mfma_f32_32x32x16_bf16(PAF(2),VFR(6),o[1],0,0,0), C1,4); \
    GAPB(o[0]=__builtin_amdgcn_mfma_f32_32x32x16_bf16(PAF(3),VFR(3),o[0],0,0,0), C1,8); \
    GAPB(o[1]=__builtin_amdgcn_mfma_f32_32x32x16_bf16(PAF(3),VFR(7),o[1],0,0,0), C1,12); \
    }while(0)
  int t=1;
  for(;t+5<NT;t+=2){
    STEP(pB0,pB1,pA0,pA1,t,true,true,true);     WAIT_BAR(2); RESC(); ROT();
    STEP(pA0,pA1,pB0,pB1,t+1,true,true,true);   WAIT_BAR(2); RESC(); ROT();
  }
  #define ENDW(tt) do{ if((tt)+3<NT){WAIT_BAR(2);} else if((tt)+2<NT){WAIT_BAR(1);} else {WAIT_BAR(0);} }while(0)
  for(;t+1<NT;t+=2){
    STEP(pB0,pB1,pA0,pA1,t,(t+3<NT),(t+1<NT),(t+1<NT));       ENDW(t);   RESC(); ROT();
    STEP(pA0,pA1,pB0,pB1,t+1,(t+4<NT),(t+2<NT),(t+2<NT));     ENDW(t+1); RESC(); ROT();
  }
  STEP(pB0,pB1,pA0,pA1,NT-1,false,false,false); RESC();
  { float sacc=pB0[0]+pB0[1]; _Pragma("unroll") for(int r=2;r<16;++r)sacc+=pB0[r]; _Pragma("unroll") for(int r=0;r<16;++r)sacc+=pB1[r]; l_reg+=sacc;
    pw0=(u32x4){PKW(pB0,0),PKW(pB0,2),PKW(pB0,4),PKW(pB0,6)};pw1=(u32x4){PKW(pB0,8),PKW(pB0,10),PKW(pB0,12),PKW(pB0,14)};pw2=(u32x4){PKW(pB1,0),PKW(pB1,2),PKW(pB1,4),PKW(pB1,6)};pw3=(u32x4){PKW(pB1,8),PKW(pB1,10),PKW(pB1,12),PKW(pB1,14)};
    SBAR(); pv(o,vb0+sl_cur,PAF(0),PAF(1),PAF(2),PAF(3)); }
  #undef PKW
  #undef PAF
  #undef VFR
  #undef PIN
  #undef MX3
  #undef GAPA
  #undef GAPB
  #undef EX
  #undef VRD
  #undef KRD
  #undef STEP
  #undef ENDW
  l_reg+=xhalf(l_reg);
  if(hi==0)wsf[32+r32]=l_reg;asm volatile("s_waitcnt lgkmcnt(0)":::"memory");
  float rli[16];
  #pragma unroll
  for(int r=0;r<16;++r)rli[r]=__builtin_amdgcn_rcpf(wsf[32+crow(r,hi)]);
  out(o,rli,wid,lane,shm);
  asm volatile("s_waitcnt lgkmcnt(0)\n\ts_barrier":::"memory");
  #undef DMA_K
  #undef DMA_V
  #undef CMASK
  #undef START
  #undef RESC
  #undef ROT
}
struct PlainMap {
  const bf16* Q0;
  __device__ __forceinline__ long off(int t)const{return (long)t*KVBLK*DM;}
  __device__ __forceinline__ void mask(f32x16&,f32x16&,int,int)const{}
  __device__ __forceinline__ float sink()const{return -INFINITY;}
  __device__ __forceinline__ const bf16* qrow(int wid)const{return Q0+(long)(wid*QBLK)*DM;}
};
struct OutMulY {
  unsigned short* Y0;
  __device__ __forceinline__ void operator()(const f32x16 (&o)[2],const float (&rli)[16],int wid,int lane,char*shm)const{
    const int r32=lane&31,hi=lane>>5; unsigned short*stg=(unsigned short*)(shm+LDS_OST)+wid*2048;
    #pragma unroll
    for(int r=0;r<16;++r){const int orow=crow(r,hi);
      #pragma unroll
      for(int d0=0;d0<2;++d0)stg[orow*64+d0*32+r32]=(unsigned short)(cvtpk_s(o[d0][r]*rli[r],0.f)&0xffffu);}
    asm volatile("s_waitcnt lgkmcnt(0)":::"memory");
    unsigned short*Yw=Y0+(long)(wid*QBLK)*1024;
    #pragma unroll
    for(int i=0;i<4;++i){const int row=i*8+(lane>>3),ch=lane&7; const u32x4 a=*(const u32x4*)(stg+row*64+ch*8); u32x4*gp=(u32x4*)(Yw+(long)row*1024+ch*8); const u32x4 y=*gp; u32x4 w;
      #pragma unroll
      for(int e=0;e<4;++e)w[e]=cvtpk_s(__uint_as_float(a[e]<<16)*__uint_as_float(y[e]<<16),__uint_as_float(a[e]&0xffff0000u)*__uint_as_float(y[e]&0xffff0000u));
      *gp=w;}
  }
};
struct OutF32 {
  float* O0;
  __device__ __forceinline__ void operator()(const f32x16 (&o)[2],const float (&rli)[16],int wid,int lane,char*)const{
    const int r32=lane&31,hi=lane>>5; float*op=O0+(long)(wid*QBLK)*1024+r32;
    #pragma unroll
    for(int r=0;r<16;++r){const int q=crow(r,hi); op[(long)q*1024]=o[0][r]*rli[r]; op[(long)q*1024+32]=o[1][r]*rli[r];}
  }
};
struct OutMulYW {
  unsigned short* Yw;
  __device__ __forceinline__ void operator()(const f32x16 (&o)[2],const float (&rli)[16],int wid,int lane,char*shm)const{ const OutMulY t{Yw-(long)(wid*QBLK)*1024}; t(o,rli,wid,lane,shm); }
};
struct WinMap {
  const bf16* Qw_; int ks0, nw, q; float sk;
  __device__ __forceinline__ long off(int t)const{ const int row=(t<4)?8192+64*t:((t<4+nw)?ks0+64*(t-4):8192); return (long)row*DM; }
  __device__ __forceinline__ void mask(f32x16&c0,f32x16&c1,int t,int hi)const{
    if(t<4)return;
    if(t>=4+nw){ _Pragma("unroll") for(int r=0;r<16;++r){c0[r]=-INFINITY;c1[r]=-INFINITY;} return; }
    const int kb=ks0+64*(t-4)-q;
    _Pragma("unroll") for(int r=0;r<16;++r){ const int d0=kb+crow(r,hi),d1=d0+32; if(d0<-128||d0>128)c0[r]=-INFINITY; if(d1<-128||d1>128)c1[r]=-INFINITY; }
  }
  __device__ __forceinline__ float sink()const{return sk;}
  __device__ __forceinline__ const bf16* qrow(int)const{return Qw_;}
};
struct NAMap {
  const bf16* Qw_; int rs0, nr, r, rs, c, cs; const float* bias;
  __device__ __forceinline__ long off(int t)const{ const int row=(t<4)?8192+64*t:((t<4+nr)?64*(rs0+t-4):8192); return (long)row*DM; }
  __device__ __forceinline__ void mask(f32x16&c0,f32x16&c1,int t,int hi)const{
    if(t<4)return;
    const int kr=rs0+t-4;
    if(t>=4+nr||kr<rs||kr>rs+7){ _Pragma("unroll") for(int r_=0;r_<16;++r_){c0[r_]=-INFINITY;c1[r_]=-INFINITY;} return; }
    const int base=(kr-r+7)*31+15-c;
    _Pragma("unroll") for(int r_=0;r_<16;++r_){ const int k0=crow(r_,hi),k1=k0+32; const bool v0=(k0>=cs)&&(k0<=cs+15),v1=(k1>=cs)&&(k1<=cs+15);
      const float b0=bias[v0?base+k0:0],b1=bias[v1?base+k1:0]; c0[r_]=v0?c0[r_]+b0:-INFINITY; c1[r_]=v1?c1[r_]+b1:-INFINITY; }
  }
  __device__ __forceinline__ float sink()const{return -INFINITY;}
  __device__ __forceinline__ const bf16* qrow(int)const{return Qw_;}
};
constexpr int ATTN_LDS_BYTES=LDS_BYTES;
#undef SBAR
#undef WAIT_BAR
}
namespace fa {
constexpr int C_SLOTB=16384, C_LDS_K=0, C_LDS_V=NSLOT*C_SLOTB, C_LDS_WS=2*NSLOT*C_SLOTB, C_LDS_X=C_LDS_WS+NW*64*4, C_LDS_BYTES=C_LDS_X;
#define SBAR() __builtin_amdgcn_sched_barrier(0)
#define WAIT_BAR(N) asm volatile("s_waitcnt vmcnt(" #N ") lgkmcnt(0)\n\ts_barrier":::"memory")
__device__ __forceinline__ void pv4(f32x16*o,int vb,bf16x8 pa0,bf16x8 pa1,bf16x8 pa2,bf16x8 pa3){
  #pragma unroll
  for(int d0=0;d0<4;++d0){s16x4 lo[4],hi[4];
    #pragma unroll
    for(int ks=0;ks<4;++ks){
      asm volatile("ds_read_b64_tr_b16 %0,%1 offset:%c2":"=&v"(lo[ks]):"v"(vb),"i"(d0*4096+ks*1024):"memory");
      asm volatile("ds_read_b64_tr_b16 %0,%1 offset:%c2":"=&v"(hi[ks]):"v"(vb),"i"(d0*4096+ks*1024+512):"memory");}
    asm volatile("s_waitcnt lgkmcnt(0)":::"memory");SBAR();
    #define PK(k) (bf16x8){lo[k][0],lo[k][1],lo[k][2],lo[k][3],hi[k][0],hi[k][1],hi[k][2],hi[k][3]}
    o[d0]=__builtin_amdgcn_mfma_f32_32x32x16_bf16(pa0,PK(0),o[d0],0,0,0);
    o[d0]=__builtin_amdgcn_mfma_f32_32x32x16_bf16(pa1,PK(1),o[d0],0,0,0);
    o[d0]=__builtin_amdgcn_mfma_f32_32x32x16_bf16(pa2,PK(2),o[d0],0,0,0);
    o[d0]=__builtin_amdgcn_mfma_f32_32x32x16_bf16(pa3,PK(3),o[d0],0,0,0);
    #undef PK
  }
}
template<int THRL,class Out> __device__ __forceinline__ void attn_unit_c(const bf16*Q0,const bf16*__restrict__ Kh,const bf16*__restrict__ Vh,const int NT,char*shm,const Out&out){
  int tid_=threadIdx.x; asm volatile("":"+v"(tid_)); const int tid=tid_,lane=tid&63,r32=lane&31,hi=lane>>5; const int wid=__builtin_amdgcn_readfirstlane(tid>>6); const int msub=wid>>2;
  const bf16*Qw=Q0+(long)((wid&3)*QBLK)*DM+msub*64;
  const unsigned lds0=(unsigned)(uintptr_t)shm;
  float*wsf=(float*)(shm+C_LDS_WS)+wid*64;
  const bf16*ksrc=Kh+(long)lane*DM+wid*8;
  const bf16*vsrc=Vh+(long)(16*(wid&3)+(lane>>2))*DM+(wid>>2)*32+(lane&3)*8;
  const unsigned kdst=lds0+C_LDS_K+wid*1024, vdst=lds0+C_LDS_V+wid*1024;
  #define DMA_K(t,slot) do{ glds16(ksrc+(long)(t)*KVBLK*DM,(unsigned)__builtin_amdgcn_readfirstlane(kdst+(slot))); glds16(ksrc+64+(long)(t)*KVBLK*DM,(unsigned)__builtin_amdgcn_readfirstlane(kdst+(slot)+8192)); }while(0)
  #define DMA_V(t,slot) do{ glds16(vsrc+(long)(t)*KVBLK*DM,(unsigned)__builtin_amdgcn_readfirstlane(vdst+(slot))); glds16(vsrc+64+(long)(t)*KVBLK*DM,(unsigned)__builtin_amdgcn_readfirstlane(vdst+(slot)+8192)); }while(0)
  const int vb0=(int)(lds0+C_LDS_V)+((lane>>4)&1)*32+(lane&3)*8+(4*hi+((lane&15)>>2))*64;
  const char*Kbase=shm+C_LDS_K+msub*8192; bf16x8 kf[8];
  const lds_cptr shm3=(lds_cptr)shm; const lds_cptr kp0=shm3+C_LDS_K+msub*8192+hi*1024+r32*16; const lds_cptr vp0=shm3+C_LDS_V+((lane>>4)&1)*32+(lane&3)*8+(4*hi+((lane&15)>>2))*64;
  DMA_K(0,0);DMA_V(0,0);DMA_K(1,C_SLOTB);
  bf16x8 qr[4];
  #pragma unroll
  for(int d0=0;d0<4;++d0)qr[d0]=*reinterpret_cast<const bf16x8*>(&Qw[(long)r32*DM+d0*16+hi*8]);
  float mhat=0.f,l_reg=0.f;f32x16 o[4];o[0]=f32x16{};o[1]=f32x16{};o[2]=f32x16{};o[3]=f32x16{};f32x16 negm=f32x16{};asm volatile("":"+v"(negm));
  bool resc=false;
  #define RESC() do{ if(resc){ asm volatile("s_waitcnt lgkmcnt(0)":::"memory"); \
      _Pragma("unroll") for(int d_=0;d_<4;++d_) _Pragma("unroll") for(int r=0;r<16;++r)o[d_][r]*=wsf[crow(r,hi)]; } }while(0)
  f32x16 C0,C1; u32x4 pwA[4],pwB[4];
  int sl_prev=0,sl_cur=0,sl_next=C_SLOTB;
  #define ROT() do{sl_prev=sl_cur;sl_cur=sl_next;sl_next=(sl_next==(NSLOT-1)*C_SLOTB)?0:sl_next+C_SLOTB;}while(0)
  DMA_K(2,2*C_SLOTB);
  WAIT_BAR(6);
  qkt(C0,C1,Kbase,qr,negm,r32,hi);asm volatile("s_nop 15\n\ts_nop 7":"+v"(C0),"+v"(C1));
  { const float rm=rowmax(C0,C1); mhat=fadd_s(mhat,rm);
    _Pragma("unroll") for(int r=0;r<16;++r){C0[r]=fsub_s(C0[r],rm);C1[r]=fsub_s(C1[r],rm);}
    _Pragma("unroll") for(int r=0;r<16;++r)negm[r]=-mhat; asm volatile("":"+v"(negm));
    float sacc=0.f;
    _Pragma("unroll") for(int r=0;r<16;++r){C0[r]=__builtin_amdgcn_exp2f(C0[r]);C1[r]=__builtin_amdgcn_exp2f(C1[r]);sacc+=C0[r]+C1[r];}
    l_reg+=sacc;
    _Pragma("unroll") for(int i=0;i<4;++i){pwA[0][i]=cvtpk_s(C0[2*i],C0[2*i+1]);pwA[1][i]=cvtpk_s(C0[8+2*i],C0[9+2*i]);pwA[2][i]=cvtpk_s(C1[2*i],C1[2*i+1]);pwA[3][i]=cvtpk_s(C1[8+2*i],C1[9+2*i]);} }
  WAIT_BAR(0);
  DMA_K(3,0);DMA_V(1,C_SLOTB);
  ROT();
  kload8(kf,kp0+sl_cur);
  WAIT_BAR(4);
  s16x4 vlo[8],vhi[8];
  #define PAF(PW,k) __builtin_bit_cast(bf16x8,PW[k])
  #define VFR(i) (bf16x8){vlo[i][0],vlo[i][1],vlo[i][2],vlo[i][3],vhi[i][0],vhi[i][1],vhi[i][2],vhi[i][3]}
  #define PIN(x) asm volatile("":"+v"(x))
  #define MX3(a,b,c) __builtin_fmaxf(__builtin_fmaxf((a),(b)),(c))
  #define EX(v) __builtin_amdgcn_exp2f(v)
  #define VRD(i) do{ vlo[i]=vtr(vp_+(((i)>>2)*4096+((i)&3)*1024)); vhi[i]=vtr(vp_+(((i)>>2)*4096+((i)&3)*1024+512)); }while(0)
  #define VRD2(i) do{ vlo[i]=vtr(vp_+((2+((i)>>2))*4096+((i)&3)*1024)); vhi[i]=vtr(vp_+((2+((i)>>2))*4096+((i)&3)*1024+512)); }while(0)
  #define KRD(G,j) do{ if(G){ kload2(kf,kp0+sl_next,j); SBAR(); } }while(0)
  #define QKM(C,KF,Q,INIT) do{ C=__builtin_amdgcn_mfma_f32_32x32x16_bf16(KF,Q,INIT,0,0,0); SBAR(); }while(0)
  #define GAPC(MF,X,B,W,EXTRA) do{ MF; X[B]=EX(X[B]); X[B+1]=EX(X[B+1]); sacc+=X[B]; sacc+=X[B+1]; W=cvtpk_s(X[B],X[B+1]); PIN(sacc); PIN(W); EXTRA; SBAR(); }while(0)
  #define STEPC(PWP,PWC,t,GK,GV,GL) do{ SBAR(); \
    const lds_cptr vp_=vp0+sl_prev; \
    VRD(0); SBAR(); QKM(C0,kf[0],qr[0],negm); \
    VRD(4); SBAR(); QKM(C1,kf[1],qr[0],negm); \
    VRD(1); SBAR(); QKM(C0,kf[2],qr[1],C0); \
    VRD(5); SBAR(); QKM(C1,kf[3],qr[1],C1); \
    VRD(2); SBAR(); QKM(C0,kf[4],qr[2],C0); \
    VRD(6); SBAR(); QKM(C1,kf[5],qr[2],C1); \
    VRD(3); SBAR(); QKM(C0,kf[6],qr[3],C0); \
    VRD(7); SBAR(); QKM(C1,kf[7],qr[3],C1); \
    if(GK){DMA_K((t)+3,sl_cur);} if(GV){DMA_V((t)+1,sl_next);} \
    { float a=MX3(C0[0],C0[1],C1[0]),b=MX3(C0[2],C0[3],C1[1]); a=MX3(a,C1[2],C1[3]); \
      _Pragma("unroll") for(int r=4;r<16;r+=4){a=MX3(a,C0[r],C0[r+1]);b=MX3(b,C0[r+2],C0[r+3]);a=MX3(a,C1[r],C1[r+1]);b=MX3(b,C1[r+2],C1[r+3]);} \
      float rm=__builtin_fmaxf(a,b); rm=__builtin_fmaxf(rm,xhalf(rm)); \
      resc=false; \
      if(__builtin_expect(__any(rm>(float)THRL),0)){ const float dl=__builtin_fmaxf(rm,0.f); mhat+=dl; \
        _Pragma("unroll") for(int r=0;r<16;++r){C0[r]-=dl;C1[r]-=dl;} \
        _Pragma("unroll") for(int r=0;r<16;++r)negm[r]=-mhat; asm volatile("":"+v"(negm)); \
        const float f=__builtin_amdgcn_exp2f(-dl); l_reg*=f; if(hi==0)wsf[r32]=f; resc=true; } } \
    SBAR(); float sacc=0.f; \
    GAPC(o[0]=__builtin_amdgcn_mfma_f32_32x32x16_bf16(PAF(PWP,0),VFR(0),o[0],0,0,0), C0,0, PWC[0][0], VRD2(0)); \
    GAPC(o[1]=__builtin_amdgcn_mfma_f32_32x32x16_bf16(PAF(PWP,0),VFR(4),o[1],0,0,0), C0,2, PWC[0][1], VRD2(4)); \
    GAPC(o[0]=__builtin_amdgcn_mfma_f32_32x32x16_bf16(PAF(PWP,1),VFR(1),o[0],0,0,0), C0,4, PWC[0][2], VRD2(1)); \
    GAPC(o[1]=__builtin_amdgcn_mfma_f32_32x32x16_bf16(PAF(PWP,1),VFR(5),o[1],0,0,0), C0,6, PWC[0][3], VRD2(5)); \
    GAPC(o[0]=__builtin_amdgcn_mfma_f32_32x32x16_bf16(PAF(PWP,2),VFR(2),o[0],0,0,0), C0,8, PWC[1][0], VRD2(2)); \
    GAPC(o[1]=__builtin_amdgcn_mfma_f32_32x32x16_bf16(PAF(PWP,2),VFR(6),o[1],0,0,0), C0,10,PWC[1][1], VRD2(6)); \
    GAPC(o[0]=__builtin_amdgcn_mfma_f32_32x32x16_bf16(PAF(PWP,3),VFR(3),o[0],0,0,0), C0,12,PWC[1][2], VRD2(3)); \
    GAPC(o[1]=__builtin_amdgcn_mfma_f32_32x32x16_bf16(PAF(PWP,3),VFR(7),o[1],0,0,0), C0,14,PWC[1][3], VRD2(7)); \
    GAPC(o[2]=__builtin_amdgcn_mfma_f32_32x32x16_bf16(PAF(PWP,0),VFR(0),o[2],0,0,0), C1,0, PWC[2][0], ); \
    GAPC(o[3]=__builtin_amdgcn_mfma_f32_32x32x16_bf16(PAF(PWP,0),VFR(4),o[3],0,0,0), C1,2, PWC[2][1], ); \
    KRD(GL,0); GAPC(o[2]=__builtin_amdgcn_mfma_f32_32x32x16_bf16(PAF(PWP,1),VFR(1),o[2],0,0,0), C1,4, PWC[2][2], ); \
    KRD(GL,1); GAPC(o[3]=__builtin_amdgcn_mfma_f32_32x32x16_bf16(PAF(PWP,1),VFR(5),o[3],0,0,0), C1,6, PWC[2][3], ); \
    KRD(GL,2); GAPC(o[2]=__builtin_amdgcn_mfma_f32_32x32x16_bf16(PAF(PWP,2),VFR(2),o[2],0,0,0), C1,8, PWC[3][0], ); \
    KRD(GL,3); GAPC(o[3]=__builtin_amdgcn_mfma_f32_32x32x16_bf16(PAF(PWP,2),VFR(6),o[3],0,0,0), C1,10,PWC[3][1], ); \
    GAPC(o[2]=__builtin_amdgcn_mfma_f32_32x32x16_bf16(PAF(PWP,3),VFR(3),o[2],0,0,0), C1,12,PWC[3][2], ); \
    GAPC(o[3]=__builtin_amdgcn_mfma_f32_32x32x16_bf16(PAF(PWP,3),VFR(7),o[3],0,0,0), C1,14,PWC[3][3], ); \
    l_reg+=sacc; \
    }while(0)
  int t=1;
  for(;t+5<NT;t+=2){
    STEPC(pwA,pwB,t,true,true,true);     WAIT_BAR(4); RESC(); ROT();
    STEPC(pwB,pwA,t+1,true,true,true);   WAIT_BAR(4); RESC(); ROT();
  }
  #define ENDW(tt) do{ if((tt)+3<NT){WAIT_BAR(4);} else if((tt)+2<NT){WAIT_BAR(2);} else {WAIT_BAR(0);} }while(0)
  for(;t+1<NT;t+=2){
    STEPC(pwA,pwB,t,(t+3<NT),(t+1<NT),(t+1<NT));       ENDW(t);   RESC(); ROT();
    STEPC(pwB,pwA,t+1,(t+4<NT),(t+2<NT),(t+2<NT));     ENDW(t+1); RESC(); ROT();
  }
  STEPC(pwA,pwB,NT-1,false,false,false); RESC();
  SBAR(); pv4(o,vb0+sl_cur,PAF(pwB,0),PAF(pwB,1),PAF(pwB,2),PAF(pwB,3));
  #undef PAF
  #undef VFR
  #undef PIN
  #undef MX3
  #undef EX
  #undef VRD
  #undef VRD2
  #undef KRD
  #undef QKM
  #undef GAPC
  #undef STEPC
  #undef ENDW
  l_reg+=xhalf(l_reg);
  if(hi==0)wsf[32+r32]=l_reg;asm volatile("s_waitcnt lgkmcnt(0)":::"memory");
  float rli[16];
  #pragma unroll
  for(int r=0;r<16;++r)rli[r]=__builtin_amdgcn_rcpf(wsf[32+crow(r,hi)]);
  asm volatile("s_waitcnt lgkmcnt(0)\n\ts_barrier":::"memory");
  out(o,rli,wid,lane,shm);
  asm volatile("s_waitcnt lgkmcnt(0)\n\ts_barrier":::"memory");
  #undef DMA_K
  #undef DMA_V
  #undef RESC
  #undef ROT
}
struct OutF32C {
  float* O0;
  __device__ __forceinline__ void operator()(const f32x16 (&o)[4],const float (&rli)[16],int wid,int lane,char*)const{
    const int r32=lane&31,hi=lane>>5; float*op=O0+(long)((wid&3)*QBLK)*1024+(wid>>2)*128+r32;
    #pragma unroll
    for(int r=0;r<16;++r){const int q=crow(r,hi);
      #pragma unroll
      for(int db=0;db<4;++db)op[(long)q*1024+db*32]=o[db][r]*rli[r];}
  }
};
#undef SBAR
#undef WAIT_BAR
}
typedef float f32x2 __attribute__((ext_vector_type(2)));
#ifndef KSEL_MIX
#define KSEL_MIX 0
#endif
#ifndef FA_THR
#define FA_THR 8
#endif
constexpr int NB = 4, SEQ = 8192, CTXL = 256, DM = 1024, SE = SEQ + CTXL, RT = NB * SE, NIN = 3328, NQKV = 2304;
constexpr float LOG2E = 1.4426950408889634f, LAM0 = 0.35550906759f;
constexpr size_t MiB = 1u << 20;
constexpr size_t WS_CTL = 0, CTL_ZERO_BYTES = 1 * MiB;
constexpr size_t WS_MOD = 1 * MiB;
constexpr size_t WS_ROPE = 1 * MiB + 256 * 1024;
constexpr size_t WS_WIN0 = 2 * MiB, WS_WIN1 = 10 * MiB;
constexpr size_t WS_WOUT0 = 18 * MiB, WS_WOUT1 = 20 * MiB;
constexpr size_t WS_XC1 = 24 * MiB;
constexpr size_t WS_H = 32 * MiB;
constexpr size_t WS_Y = 100 * MiB;
constexpr size_t WS_QKV = 168 * MiB;
constexpr size_t WS_OC = 320 * MiB;
constexpr size_t WS_END = 448 * MiB;
static_assert(WS_H + (size_t)RT * DM * 2 <= WS_Y && WS_Y + (size_t)RT * DM * 2 <= WS_QKV && WS_QKV + (size_t)RT * NQKV * 2 <= WS_OC && WS_OC + (size_t)32768 * 1024 * 4 <= WS_END, "ws map");
constexpr int CW_BAR = 4096;
constexpr int RING_BYTES = 131072, SCR_OFF = RING_BYTES, BIAS_OFF = SCR_OFF + 2048, TAB_OFF = BIAS_OFF, TAB_FLOATS = 4096 + 128, LDSCTL_OFF = 150016, MISC_OFF = LDSCTL_OFF + 320, LDS_BYTES = 148 * 1024;
static_assert(BIAS_OFF + 8 * 465 * 4 <= LDSCTL_OFF && TAB_OFF + TAB_FLOATS * 4 <= LDSCTL_OFF && MISC_OFF + 128 <= LDS_BYTES, "LDS map");

typedef unsigned short u16;
__device__ __forceinline__ float wave_sum(float v) {
#pragma unroll
    for (int o = 1; o < 64; o <<= 1) v += __shfl_xor(v, o);
    return v;
}
__device__ __forceinline__ void p0_transpose_item(const float* W, int K, int N, u16* WT, bool perm, LAS float* scr, int item, int lane) {
    const int nblk = N / 32, kb = item / nblk, nb = item % nblk, k0 = 64 * kb, n0 = 32 * nb;
    const int rowbase = perm ? (256 * (n0 >> 8) + 32 * ((n0 >> 6) & 3) + 8 * ((n0 >> 5) & 1)) : n0;
#pragma unroll 8
    for (int i = 0; i < 32; ++i) { const int kk = 2 * i + (lane >> 5); scr[kk * 33 + (lane & 31)] = W[(size_t)(k0 + kk) * N + n0 + (lane & 31)]; }
    LDS_WAIT(); asm volatile("" ::: "memory");
    const int c = lane & 7;
#pragma unroll
    for (int j = 0; j < 4; ++j) { const int n = (lane >> 3) + 8 * j; const LAS float* s = scr + (8 * c) * 33 + n;
        const int rr = perm ? (128 * ((n >> 2) & 1) + 16 * (n >> 4) + 4 * ((n >> 3) & 1) + (n & 3)) : n;
        v4u o; o.x = pk2(s[0 * 33], s[1 * 33]); o.y = pk2(s[2 * 33], s[3 * 33]); o.z = pk2(s[4 * 33], s[5 * 33]); o.w = pk2(s[6 * 33], s[7 * 33]);
        *(v4u*)(WT + (size_t)(rowbase + rr) * K + k0 + 8 * c) = o; }
    LDS_WAIT(); asm volatile("" ::: "memory");
}

struct Args { const float* in[17]; float* out; unsigned char* ws; };

__global__ void __launch_bounds__(512, 2) fwd_kernel(Args args) {
    extern __shared__ __attribute__((aligned(16))) unsigned char lds_raw[];
    LAS unsigned char* lds = (LAS unsigned char*)lds_raw;
    volatile LAS unsigned* MISC = (volatile LAS unsigned*)(lds + MISC_OFF);
    const int G = gridDim.x, bx = blockIdx.x, vcu = (G % 8 == 0) ? (bx % 8) * (G / 8) + bx / 8 : bx, NGW = G * 8;
#define PH_IDS KP_DECL int tid = threadIdx.x; asm volatile("" : "+v"(tid)); const int lane = tid & 63, wave = __builtin_amdgcn_readfirstlane(tid >> 6), gw = vcu * 8 + wave; (void)lane; (void)gw;
#define AS4 __attribute__((address_space(4)))
#define KP_DECL const AS4 unsigned char* kp_ = (const AS4 unsigned char*)__builtin_amdgcn_kernarg_segment_ptr(); asm volatile("" : "+s"(kp_)); unsigned char* const ws = *(unsigned char* const AS4*)(kp_ + 144); (void)ws;
#define KIN(i) (*(const float* const AS4*)(kp_ + 8 * (i)))
#define KOUT (*(float* const AS4*)(kp_ + 136))
#define W_MOD ((float*)(ws + WS_MOD))
#define W_ROPEC ((float*)(ws + WS_ROPE))
#define W_ROPES ((float*)(ws + WS_ROPE) + 128 * 16)
#define W_XC1 ((float*)(ws + WS_XC1))
#define W_H ((u16*)(ws + WS_H))
#define W_Y ((u16*)(ws + WS_Y))
#define W_QKV ((u16*)(ws + WS_QKV))
#define W_OC ((float*)(ws + WS_OC))
    (void)args;
    for (int u = threadIdx.x; u < (LDS_BYTES - LDSCTL_OFF) / 4; u += 512) ((LAS unsigned*)(lds + LDSCTL_OFF))[u] = 0u;
    __syncthreads();
    { KP_DECL (void)xcd_barrier_post((unsigned*)(ws + WS_CTL) + CW_BAR, MISC + 8); }
#ifdef USE_CG
#define GRID_BAR() do { asm volatile("s_waitcnt vmcnt(0)" ::: "memory"); __threadfence(); cooperative_groups::this_grid().sync(); __threadfence(); } while (0)
#else
#define GRID_BAR() do { KP_DECL XcdBarrier b_; b_.bar = (unsigned*)(ws + WS_CTL) + CW_BAR; b_.x = xb_xcc_id(); b_.st = MISC + 8; xcd_barrier(b_); } while (0)
#endif

    {
        PH_IDS
        const float* cvec = KIN(1); const float* cctx = KIN(3); const float* w_mod = KIN(4); const float* b_mod = KIN(5); float* MOD = W_MOD; float* ROPEC = W_ROPEC; float* ROPES = W_ROPES;
        LAS float* sil = (LAS float*)lds;
        LAS float* part = (LAS float*)(lds + 20480);
        if (bx < 192) {
            for (int i = tid; i < 5120; i += 512) { const int v = i >> 10, k = i & 1023; const float cv = (v < 4) ? cvec[v * 1024 + k] : cctx[k]; sil[i] = cv / (1.0f + __expf(-cv)); }
            __syncthreads();
            for (int it = bx; it < 192; it += G) {
                const int layer = it / 96, n0 = (it % 96) * 32, ks = tid >> 5, cl = tid & 31;
                const float* W = w_mod + (size_t)layer * 1024 * 3072 + n0 + cl;
                float a0 = 0.f, a1 = 0.f, a2 = 0.f, a3 = 0.f, a4 = 0.f;
#pragma unroll 16
                for (int kk = 0; kk < 64; ++kk) { const int k = ks * 64 + kk; const float w = W[(size_t)k * 3072];
                    a0 += sil[k] * w; a1 += sil[1024 + k] * w; a2 += sil[2048 + k] * w; a3 += sil[3072 + k] * w; a4 += sil[4096 + k] * w; }
                part[(ks * 5 + 0) * 32 + cl] = a0; part[(ks * 5 + 1) * 32 + cl] = a1; part[(ks * 5 + 2) * 32 + cl] = a2; part[(ks * 5 + 3) * 32 + cl] = a3; part[(ks * 5 + 4) * 32 + cl] = a4;
                __syncthreads();
                if (tid < 160) { const int v = tid >> 5; float s = b_mod[layer * 3072 + n0 + cl];
#pragma unroll
                    for (int q = 0; q < 16; ++q) s += part[(q * 5 + v) * 32 + cl];
                    MOD[(size_t)(layer * 5 + v) * 3072 + n0 + cl] = s; }
                __syncthreads();
            }
        } else if (bx >= G - 4) {
            const int e = (bx - (G - 4)) * 512 + tid, pos = e >> 4, j = e & 15;
            const float inv = exp2f(-(float)j * (13.287712379549449f / 16.0f));
            const float ang = (float)pos * inv;
            ROPEC[e] = cosf(ang); ROPES[e] = sinf(ang);
        }
        __syncthreads();
        LAS float* scr = (LAS float*)(lds + wave * 16384);
        constexpr int I_IN = 16 * 104, I_OUT = 16 * 32, NITEMS = 2 * I_IN + 2 * I_OUT;
        for (int it = gw; it < NITEMS; it += NGW) {
            const float* Wsrc; u16* Wdst; int N_, r; bool perm;
            if (it < I_IN) { Wsrc = KIN(6); Wdst = (u16*)(ws + WS_WIN0); N_ = NIN; r = it; perm = true; }
            else if (it < 2 * I_IN) { Wsrc = KIN(11); Wdst = (u16*)(ws + WS_WIN1); N_ = NIN; r = it - I_IN; perm = true; }
            else if (it < 2 * I_IN + I_OUT) { Wsrc = KIN(7); Wdst = (u16*)(ws + WS_WOUT0); N_ = 1024; r = it - 2 * I_IN; perm = false; }
            else { Wsrc = KIN(12); Wdst = (u16*)(ws + WS_WOUT1); N_ = 1024; r = it - 2 * I_IN - I_OUT; perm = false; }
            p0_transpose_item(Wsrc, 1024, N_, Wdst, perm, scr, r, lane);
        }
    }
    GRID_BAR();

    for (int layer = 0; layer < 2; ++layer) {
        {
            PH_IDS
            const float* modl = W_MOD + (size_t)layer * 5 * 3072; u16* H = W_H;
            const float* xs = layer == 0 ? KIN(0) : KOUT; const float* cs = layer == 0 ? KIN(2) : W_XC1;
            for (int R = gw; R < RT; R += NGW) {
                const int b = R / SE, t = R % SE;
                const float* src; const float* mv;
                if (t < SEQ) { src = xs + ((size_t)b * SEQ + t) * DM; mv = modl + b * 3072; } else { src = cs + ((size_t)b * CTXL + (t - SEQ)) * DM; mv = modl + 4 * 3072; }
                f32x4 v[4]; float ss = 0.f;
#pragma unroll
                for (int j = 0; j < 4; ++j) { v[j] = *(const f32x4*)(src + 4 * lane + 256 * j); ss += (v[j].x * v[j].x + v[j].y * v[j].y) + (v[j].z * v[j].z + v[j].w * v[j].w); }
                const float rstd = 1.0f / sqrtf(wave_sum(ss) * (1.0f / DM) + 1e-6f);
#pragma unroll
                for (int j = 0; j < 4; ++j) { const f32x4 sh = *(const f32x4*)(mv + 4 * lane + 256 * j), sc = *(const f32x4*)(mv + 1024 + 4 * lane + 256 * j);
                    const f32x4 h = v[j] * rstd * (sc + 1.0f) + sh;
                    *(unsigned long long*)(H + (size_t)R * DM + 4 * lane + 256 * j) = (unsigned long long)pk2(h.x, h.y) | ((unsigned long long)pk2(h.z, h.w) << 32); }
            }
        }
        GRID_BAR();
        {
            KP_DECL
            { LAS float* tabw = (LAS float*)(lds + TAB_OFF); const float* rc = W_ROPEC; const float* g8 = KIN(8); const float* g9 = KIN(9);
              int tid0 = threadIdx.x; asm volatile("" : "+v"(tid0));
              for (int i = tid0; i < TAB_FLOATS; i += 512) tabw[i] = i < 4096 ? rc[i] : (i < 4160 ? g8[i - 4096] : g9[i - 4160]);
              __syncthreads(); }
            pg8::Gemm g{W_H, (const u16*)(ws + (layer == 0 ? WS_WIN0 : WS_WIN1)), RT, NIN, DM}; pg8::StaticOrder S; S.init(RT, NIN, G, bx);
            pg8::EpiQKV E{W_QKV, W_Y, (const LAS float*)(lds + TAB_OFF), layer};
            pg8::gemm_phase<pg8::EpiQKV, pg8::StaticOrder, true, true>(lds, g, S, E);
        }
        GRID_BAR();
        {
            PH_IDS
            const u16* QKV = W_QKV; u16* Y = W_Y; float* OC = W_OC;
            const int r32 = lane & 31;
            if (layer == 0) {
                const float* rpb = KIN(10);
                LAS float* biasT = (LAS float*)(lds + BIAS_OFF);
                for (int i = tid; i < 8 * 465; i += 512) biasT[i] = rpb[i] * LOG2E;
                __syncthreads();
                for (int uid = vcu; uid < 1024; uid += G) {
                    const int i = uid >> 8, g = (uid & 255) >> 5, s = uid & 31, b = g >> 1, kv = g & 1, hq = kv * 4 + i; const u16* base = QKV + (size_t)b * SE * NQKV;
                    const fa::OutMulY o_{Y + ((size_t)b * SE + s * 256) * DM + hq * 64};
                    const fa::PlainMap tm_{(const fa::bf16*)(base + (size_t)(s * 256) * NQKV + hq * 64)};
                    fa::attn_unit<FA_THR>(tm_, (const fa::bf16*)(base + 512 + kv * 64), (const fa::bf16*)(base + 640 + kv * 64), 132, (char*)lds_raw, o_);
                }
                for (int uid = vcu; uid < 1024; uid += G) {
                    const int i = uid >> 8, g = (uid & 255) >> 5, s = uid & 31, bh = 4 * g + i, b = bh >> 3, h = bh & 7, R0 = 4 * s; const u16* base = QKV + (size_t)b * SE * NQKV;
                    const int rs0 = min(max(R0 - 4, 0), 120), nr = min(max(R0 - 1, 0), 120) + 8 - rs0, r = R0 + (wave >> 1), c = 32 * (wave & 1) + r32;
                    const fa::NAMap tm_{(const fa::bf16*)(base + (size_t)(r * 64 + 32 * (wave & 1)) * NQKV + 768 + h * 64), rs0, nr, r, min(max(r - 4, 0), 120), c, min(max(c - 8, 0), 48), (const float*)(lds_raw + BIAS_OFF) + h * 465};
                    const fa::OutMulYW o_{Y + ((size_t)b * SE + r * 64 + 32 * (wave & 1)) * DM + 512 + h * 64};
                    fa::attn_unit<FA_THR>(tm_, (const fa::bf16*)(base + 1280 + h * 64), (const fa::bf16*)(base + 1792 + h * 64), (4 + nr + 1) & ~1, (char*)lds_raw, o_);
                }
                const wa::lptr slot = lds + wave * 16384; LAS float* wsf = (LAS float*)(lds + SCR_OFF + wave * 256);
                for (int v = gw; v < 512; v += NGW) {
                    wa::State st; st.m = -INFINITY; st.l = 0.f; float rl[16];
                    const int isb = v >> 8, w = v & 255, b = w >> 6, h = (w >> 3) & 7, qb = w & 7; const u16* base = QKV + ((size_t)b * SE + SEQ) * NQKV;
                    const int kc = isb ? 1280 + h * 64 : 512 + (h >> 2) * 64, vc = isb ? 1792 + h * 64 : 640 + (h >> 2) * 64, qc = isb ? 768 + h * 64 : h * 64;
                    wa::SpecPlain sp{base + kc, base + vc, 4};
                    wa::run(sp, base + (size_t)(qb * 32 + r32) * NQKV + qc, st, slot, wsf, lane);
                    wa::row_recip(st, rl, wsf, lane);
                    wa::store_mul(st, rl, Y + ((size_t)b * SE + SEQ + qb * 32) * DM + isb * 512 + h * 64, slot, lane);
                }
            } else {
                const float* sinks = KIN(15);
                for (int uid = vcu; uid < 1024; uid += G) {
                    const int i = uid >> 8, g = (uid & 255) >> 5, s = (uid & 31) + 32 * (i & 1), bh = 2 * g + (i >> 1), b = bh >> 2, h = bh & 3; const u16* base = QKV + (size_t)b * SE * NQKV;
                    const fa::OutF32C o_{OC + ((size_t)b * SEQ + s * 128) * 1024 + h * 256};
                    fa::attn_unit_c<FA_THR>((const fa::bf16*)(base + (size_t)(s * 128) * NQKV + (2 * h) * 64), (const fa::bf16*)(base + 512 + (2 * h) * 64), (const fa::bf16*)(base + 1024 + h * 128), 132, (char*)lds_raw, o_);
                }
                for (int uid = vcu; uid < 1024; uid += G) {
                    const int i = uid >> 8, g = (uid & 255) >> 5, s = (uid & 31) + 32 * i, b = g >> 1, kv = g & 1, T0 = 64 * s, hq = 4 * kv + (wave >> 1); const u16* base = QKV + (size_t)b * SE * NQKV;
                    const int first = T0 - 128, ilo = first < 0 ? (-first) >> 6 : 0, ihi = min(4, (SEQ - 64 - first) >> 6), nw = ihi - ilo + 1, qrow0 = T0 + 32 * (wave & 1);
                    const fa::WinMap tm_{(const fa::bf16*)(base + (size_t)qrow0 * NQKV + 1536 + hq * 64), first + 64 * ilo, nw, qrow0 + r32, sinks[hq] * LOG2E};
                    const fa::OutMulYW o_{Y + ((size_t)b * SE + qrow0) * DM + 512 + hq * 64};
                    fa::attn_unit<FA_THR>(tm_, (const fa::bf16*)(base + 2048 + kv * 64), (const fa::bf16*)(base + 2176 + kv * 64), (4 + nw + 1) & ~1, (char*)lds_raw, o_);
                }
            }
        }
        GRID_BAR();
        if (layer == 1) {
            PH_IDS
            const float* clam = KIN(13); const float* subln = KIN(14); const float* OC = W_OC; u16* Y = W_Y;
            float lam;
            { const float a = clam[lane] * clam[64 + lane], b2 = clam[128 + lane] * clam[192 + lane]; lam = expf(wave_sum(a)) - expf(wave_sum(b2)) + LAM0; }
            const f32x2 g2 = *(const f32x2*)(subln + 2 * lane);
            for (int row = gw; row < NB * SEQ; row += NGW) {
                const int b = row >> 13, t = row & 8191; const size_t R = (size_t)b * SE + t;
#pragma unroll
                for (int h = 0; h < 4; ++h) {
                    const float* o0 = OC + (size_t)row * 1024 + h * 256 + 2 * lane; const f32x2 a = *(const f32x2*)o0, c2 = *(const f32x2*)(o0 + 128);
                    const f32x2 v = a - c2 * lam; const float rstd = 1.0f / sqrtf(wave_sum(v.x * v.x + v.y * v.y) * (1.0f / 128.0f) + 1e-6f);
                    const f32x2 o = v * rstd * g2 * (1.0f - LAM0);
                    unsigned* yp = (unsigned*)(Y + R * DM + h * 128 + 2 * lane); const unsigned yv = *yp;
                    *yp = wa::cvtpk(o.x * wa::bflo(yv), o.y * wa::bfhi(yv));
                }
            }
            GRID_BAR();
        }
        {
            KP_DECL
            pg8::Gemm g{W_Y, (const u16*)(ws + (layer == 0 ? WS_WOUT0 : WS_WOUT1)), RT, DM, DM}; pg8::FlexOrder S; S.init(DM, G, bx, layer);
            pg8::EpiOut E{layer == 0 ? KIN(0) : KOUT, KOUT, KIN(2), W_XC1, W_MOD + (size_t)layer * 5 * 3072};
            pg8::gemm_phase<pg8::EpiOut, pg8::FlexOrder, true, true>(lds, g, S, E);
        }
        GRID_BAR();
    }
    PH_IDS
    float* out = KOUT; const float* fnorm = KIN(16);
    const float bad = (__hip_atomic_load((unsigned*)(ws + WS_CTL) + CW_BAR + XB_TMO, __ATOMIC_RELAXED, __HIP_MEMORY_SCOPE_AGENT) != 0u) ? __builtin_nanf("") : 0.f;
    for (int row = gw; row < NB * SEQ; row += NGW) {
        float* p = out + (size_t)row * DM; f32x4 v[4]; float ss = 0.f;
#pragma unroll
        for (int j = 0; j < 4; ++j) { v[j] = *(const f32x4*)(p + 4 * lane + 256 * j); ss += (v[j].x * v[j].x + v[j].y * v[j].y) + (v[j].z * v[j].z + v[j].w * v[j].w); }
        const float rstd = 1.0f / sqrtf(wave_sum(ss) * (1.0f / DM) + 1e-6f);
#pragma unroll
        for (int j = 0; j < 4; ++j) { const f32x4 gn = *(const f32x4*)(fnorm + 4 * lane + 256 * j); *(f32x4*)(p + 4 * lane + 256 * j) = v[j] * rstd * gn + bad; }
    }
}

extern "C" void kernel_launch(void* const* d_in, const int* in_sizes, int n_in, void* d_out, int out_size, void* d_ws, size_t ws_size, hipStream_t stream) {
    static int grid = 0;
    if (grid == 0) {
        if (n_in != 17 || in_sizes[0] != NB * SEQ * DM || out_size != NB * SEQ * DM || ws_size < WS_END) { fprintf(stderr, "kernel_launch: unexpected shapes / workspace (n_in %d, ws %zu)\n", n_in, ws_size); grid = -1; return; }
        int dev = 0, cus = 0, per_cu = 0;
        if (hipGetDevice(&dev) != hipSuccess || hipDeviceGetAttribute(&cus, hipDeviceAttributeMultiprocessorCount, dev) != hipSuccess) { grid = -1; return; }
        if (hipFuncSetAttribute((const void*)fwd_kernel, hipFuncAttributeMaxDynamicSharedMemorySize, LDS_BYTES) != hipSuccess) { fprintf(stderr, "kernel_launch: hipFuncSetAttribute failed\n"); grid = -1; return; }
        if (hipOccupancyMaxActiveBlocksPerMultiprocessor(&per_cu, (const void*)fwd_kernel, 512, LDS_BYTES) != hipSuccess || per_cu < 1) { fprintf(stderr, "kernel_launch: occupancy query says %d blocks per CU\n", per_cu); per_cu = 1; }
        (void)hipGetLastError();
        grid = cus;
    }
    if (grid < 0) return;
    if (hipMemsetAsync((char*)d_ws + WS_CTL, 0, CTL_ZERO_BYTES, stream) != hipSuccess) { fprintf(stderr, "kernel_launch: memset failed\n"); return; }
    Args a{};
    for (int i = 0; i < 17; ++i) a.in[i] = (const float*)d_in[i];
    a.out = (float*)d_out; a.ws = (unsigned char*)d_ws;
#ifdef USE_CG
    void* kargs[] = {&a};
    hipError_t e = hipLaunchCooperativeKernel((const void*)fwd_kernel, dim3(grid), dim3(512), kargs, LDS_BYTES, stream);
    if (e != hipSuccess) fprintf(stderr, "cooperative launch failed: %s\n", hipGetErrorString(e));
#else
    hipLaunchKernelGGL(fwd_kernel, dim3(grid), dim3(512), LDS_BYTES, stream, a);
#endif
}
```

```cpp
#include <hip/hip_runtime.h>
#include <hip/hip_bf16.h>
#include <hip/hip_cooperative_groups.h>
#include <cstdio>
#include <cstdint>
#include <cmath>
namespace pg8 {
#define PG8_LAS __attribute__((address_space(3)))
typedef unsigned short bf16_t;
typedef short bf16x8 __attribute__((ext_vector_type(8)));
typedef float f32x4 __attribute__((ext_vector_type(4)));
typedef unsigned u32x4 __attribute__((ext_vector_type(4)));
constexpr int BM = 256, BK = 64, HALF = 128, HTB = HALF * BK * 2  , STAGE_BYTES = 8 * HTB, NXCD = 8, WGM = 8;

__host__ __device__ __forceinline__ int lds_byte(int r, int c) { const int st = (r >> 4) * 2 + (c >> 5), rr = r & 15, cc = c & 31, ob = rr * 64 + cc * 2; return st * 1024 + (ob ^ (((ob >> 9) & 1) << 5)); }
__host__ __device__ __forceinline__ void stage_rc(int b, int& R, int& C) { const int st = b / 1024, sb = b % 1024, swz = sb ^ (((sb >> 9) & 1) << 5); R = (st >> 1) * 16 + swz / 64; C = (st & 1) * 32 + (swz % 64) / 2; }
__host__ __device__ __forceinline__ int perm32(int rho) { const int n = rho >> 4, i = rho & 15; return 8 * (i >> 2) + 4 * n + (i & 3); }

struct Unit { int pm, pn; };
struct Gemm { const bf16_t* A; const bf16_t* Bt; int M, N, K; };

struct StaticOrder {
    int nM, nN, nwg, G, c;
    __host__ __device__ void init(int M, int N, int G_, int c_) { nM = M / BM; nN = N / BM; nwg = nM * nN; G = G_; c = c_; }
    __host__ __device__ bool next(int i, Unit& u) const {
        const long L = (long)i * G + c; if (L >= nwg) return false;
        int wgid = (int)L; { const int q = nwg / NXCD, r = nwg % NXCD, xcd = wgid % NXCD, off = wgid / NXCD; wgid = (xcd < r ? xcd * (q + 1) : r * (q + 1) + (xcd - r) * q) + off; }
        const int nig = WGM * nN, gid = wgid / nig, fm = gid * WGM, gsz = (nM - fm) < WGM ? (nM - fm) : WGM;
        u.pm = fm + ((wgid % nig) % gsz); u.pn = (wgid % nig) / gsz; return true;
    }
    __device__ __forceinline__ void a_ready(const Unit&) const {}
    __device__ __forceinline__ void done(const Unit&) const {}
};

__device__ __forceinline__ unsigned cvt_pk_bf16(float lo, float hi) { unsigned r; asm volatile("v_cvt_pk_bf16_f32 %0, %1, %2" : "=v"(r) : "v"(lo), "v"(hi)); return r; }
typedef float f32x2 __attribute__((ext_vector_type(2)));
typedef unsigned u32x2 __attribute__((ext_vector_type(2)));
constexpr float QSCALE = 0.125f * 1.4426950408889634f;
constexpr int SE = 8448, NQKV = 2304, DMODEL = 1024;

struct EpiQKV {
    static constexpr bool PERM = false, AFTER_DRAIN = false;
    bf16_t* QKV; bf16_t* Y; const PG8_LAS float* tab; int layer;
    __device__ __forceinline__ void operator()(const f32x4 (&acc)[2][2][4][2], const Unit& u, int wr, int wc, int fr, int fq) const {
        asm volatile("" : "+v"(fr), "+v"(fq));
        const int c64 = u.pn * 4 + wc;
        int norm = 0; bool rope = false, scale = false, silu = false;
        if (layer == 0) { if (c64 < 8) { norm = 1; rope = true; scale = true; } else if (c64 < 10) { norm = 2; rope = true; } else if (c64 >= 12 && c64 < 20) scale = true; else if (c64 >= 36) silu = true; }
        else { if (c64 < 8) { rope = true; scale = true; } else if (c64 < 16) rope = true; else if (c64 >= 24 && c64 < 32) { rope = true; scale = true; } else if (c64 >= 32 && c64 < 34) rope = true; else if (c64 >= 36) silu = true; }
        const int pmb = u.pm % 33; const bool isctx = (pmb == 32); if (isctx) rope = false;
        const int hh = fq >> 1, gg = fq & 1, d0 = 32 * hh + 8 * gg;
        const PG8_LAS float* gain = tab + 4096 + (norm == 2 ? 64 : 0) + d0;
#pragma unroll
        for (int ai = 0; ai < 2; ++ai) {
            const int pr = pmb * 4 + ai * 2 + wr;
#pragma unroll
            for (int m = 0; m < 4; ++m) {
                const size_t R = (size_t)u.pm * 256 + ai * 128 + wr * 64 + m * 16 + fr;
                f32x4 v[2][2];
#pragma unroll
                for (int bj = 0; bj < 2; ++bj)
#pragma unroll
                    for (int n = 0; n < 2; ++n) v[bj][n] = acc[ai][bj][m][n];
                if (norm) {
                    float ss = 0.f;
#pragma unroll
                    for (int bj = 0; bj < 2; ++bj)
#pragma unroll
                        for (int n = 0; n < 2; ++n) { const f32x4 x = v[bj][n]; ss += (x[0] * x[0] + x[1] * x[1]) + (x[2] * x[2] + x[3] * x[3]); }
                    ss += __shfl_xor(ss, 16); ss += __shfl_xor(ss, 32);
                    const float rs = 1.0f / sqrtf(ss * (1.0f / 64.0f) + 1e-6f);
#pragma unroll
                    for (int bj = 0; bj < 2; ++bj)
#pragma unroll
                        for (int n = 0; n < 2; ++n) v[bj][n] = v[bj][n] * rs * *(const PG8_LAS f32x4*)(gain + 16 * n + 4 * bj);
                }
                if (rope) {
                    const int pos = hh ? (m * 16 + fr) : pr;
                    const PG8_LAS float* tp = tab + pos * 16 + 8 * gg;
#pragma unroll
                    for (int bj = 0; bj < 2; ++bj) { const f32x4 c4 = *(const PG8_LAS f32x4*)(tp + 4 * bj), s4 = *(const PG8_LAS f32x4*)(tp + 2048 + 4 * bj);
                        const f32x4 x1 = v[bj][0], x2 = v[bj][1]; v[bj][0] = x1 * c4 - x2 * s4; v[bj][1] = x1 * s4 + x2 * c4; }
                }
                if (scale) {
#pragma unroll
                    for (int bj = 0; bj < 2; ++bj)
#pragma unroll
                        for (int n = 0; n < 2; ++n) v[bj][n] = v[bj][n] * QSCALE;
                }
                bf16_t* dst;
                if (silu) {
#pragma unroll
                    for (int bj = 0; bj < 2; ++bj)
#pragma unroll
                        for (int n = 0; n < 2; ++n)
#pragma unroll
                            for (int e = 0; e < 4; ++e) { const float x = v[bj][n][e]; v[bj][n][e] = x * __builtin_amdgcn_rcpf(1.0f + __builtin_amdgcn_exp2f(-1.4426950408889634f * x)); }
                    dst = Y + R * DMODEL + (size_t)(c64 - 36) * 64 + d0;
                } else dst = QKV + R * NQKV + (size_t)c64 * 64 + d0;
#pragma unroll
                for (int n = 0; n < 2; ++n) { u32x4 w; w.x = cvt_pk_bf16(v[0][n][0], v[0][n][1]); w.y = cvt_pk_bf16(v[0][n][2], v[0][n][3]); w.z = cvt_pk_bf16(v[1][n][0], v[1][n][1]); w.w = cvt_pk_bf16(v[1][n][2], v[1][n][3]);
                    *(u32x4*)(dst + 16 * n) = w; }
                asm volatile("" ::: "memory");
            }
        }
    }
};

struct EpiProbe {
    static constexpr bool PERM = false, AFTER_DRAIN = false;
    bf16_t* O;
    __device__ __forceinline__ void operator()(const f32x4 (&acc)[2][2][4][2], const Unit& u, int wr, int wc, int fr, int fq) const {
        asm volatile("" : "+v"(fr), "+v"(fq));
#pragma unroll
        for (int ai = 0; ai < 2; ++ai)
#pragma unroll
            for (int m = 0; m < 4; ++m) { bf16_t* rowp = O + ((size_t)(u.pm & 63) * 256 + ai * 128 + wr * 64 + m * 16 + fr) * 3328 + u.pn * 256 + wc * 64 + 16 * fq;
#pragma unroll
                for (int bj = 0; bj < 2; ++bj) { u32x4 w; w.x = cvt_pk_bf16(acc[ai][bj][m][0][0], acc[ai][bj][m][0][1]); w.y = cvt_pk_bf16(acc[ai][bj][m][0][2], acc[ai][bj][m][0][3]); w.z = cvt_pk_bf16(acc[ai][bj][m][1][0], acc[ai][bj][m][1][1]); w.w = cvt_pk_bf16(acc[ai][bj][m][1][2], acc[ai][bj][m][1][3]);
                    *(u32x4*)(rowp + bj * 8) = w; }
                asm volatile("" ::: "memory"); }
    }
};

struct EpiOut {
    static constexpr bool PERM = false, AFTER_DRAIN = false;
    const float* xin; float* xout; const float* cin; float* cout; const float* mod;
    __device__ __forceinline__ void operator()(const f32x4 (&acc)[2][2][4][2], const Unit& u, int wr, int wc, int fr, int fq) const {
        asm volatile("" : "+v"(fr), "+v"(fq));
        const int pmb = u.pm % 33, b = u.pm / 33; const bool isctx = (pmb == 32);
        const float* src; float* dst; const float* gate;
        if (isctx) { src = cin + (size_t)b * 256 * DMODEL; dst = cout + (size_t)b * 256 * DMODEL; gate = mod + 4 * 3072 + 2048; }
        else { const size_t o = ((size_t)b * 8192 + (size_t)pmb * 256) * DMODEL; src = xin + o; dst = xout + o; gate = mod + b * 3072 + 2048; }
        const int col0 = u.pn * BM + wc * 32 + 4 * fq;
        f32x4 g[2][2], cur[2][2], nxt[2][2];
#pragma unroll
        for (int bj = 0; bj < 2; ++bj)
#pragma unroll
            for (int n = 0; n < 2; ++n) { g[bj][n] = *(const f32x4*)(gate + col0 + bj * HALF + n * 16); cur[bj][n] = *(const f32x4*)(src + (size_t)(wr * 64 + fr) * DMODEL + col0 + bj * HALF + n * 16); }
#pragma unroll
        for (int idx = 0; idx < 8; ++idx) { const int ai = idx >> 2, m = idx & 3; const size_t off = (size_t)(ai * HALF + wr * 64 + m * 16 + fr) * DMODEL + col0;
            if (idx < 7) { const int ai2 = (idx + 1) >> 2, m2 = (idx + 1) & 3; const size_t off2 = (size_t)(ai2 * HALF + wr * 64 + m2 * 16 + fr) * DMODEL + col0;
#pragma unroll
                for (int bj = 0; bj < 2; ++bj)
#pragma unroll
                    for (int n = 0; n < 2; ++n) nxt[bj][n] = *(const f32x4*)(src + off2 + bj * HALF + n * 16); }
#pragma unroll
            for (int bj = 0; bj < 2; ++bj)
#pragma unroll
                for (int n = 0; n < 2; ++n) { *(f32x4*)(dst + off + bj * HALF + n * 16) = cur[bj][n] + g[bj][n] * acc[ai][bj][m][n]; cur[bj][n] = nxt[bj][n]; }
            asm volatile("" ::: "memory"); }
    }
};
struct FlexOrder {
    StaticOrder base; int latent_only;
    __device__ void init(int N, int G_, int c_, int latent_only_) { latent_only = latent_only_; base.init(latent_only_ ? 4 * 8192 : 4 * SE, N, G_, c_); }
    __device__ bool next(int i, Unit& u) const { if (!base.next(i, u)) return false; if (latent_only) u.pm += u.pm >> 5; return true; }
    __device__ __forceinline__ void a_ready(const Unit&) const {}
    __device__ __forceinline__ void done(const Unit&) const {}
};
template <class Epi, class Sched, bool ALIGN_EPI = false, bool SP2 = false>
__device__ __forceinline__ void gemm_phase(PG8_LAS unsigned char* lds, const Gemm g, const Sched& S, const Epi& E) {
    int tid_ = threadIdx.x; asm volatile("" : "+v"(tid_));
    const int tid = tid_, wid = __builtin_amdgcn_readfirstlane(tid >> 6), lane = tid & 63, wr = wid >> 2, wc = wid & 3, fr = lane & 15, fq = lane >> 4;
    const int K = g.K, nt = K / BK;
    unsigned voffA[2], voffB[2];
#pragma unroll
    for (int i = 0; i < 2; ++i) { int R, C; stage_rc(tid * 16 + i * 8192, R, C); const int Rb = Epi::PERM ? ((R & ~31) + perm32(R & 31)) : R;
        voffA[i] = (unsigned)(R * K + C) * 2u; voffB[i] = (unsigned)(Rb * K + C) * 2u; }
    const size_t kstep = (size_t)(BK * 2);
    const size_t hstep = (size_t)HALF * K * 2;
    const size_t tstep = 2 * hstep;
    const unsigned ldsw = (unsigned)wid * 1024u;
    const int aoff = lds_byte(wr * 64 + fr, fq * 8), boff = lds_byte(wc * 32 + fr, fq * 8);
#define PG8_SA(b, h) (((b) * 2 + (h)) * HTB)
#define PG8_SB(b, h) ((4 + (b) * 2 + (h)) * HTB)
#define PG8_STAGE(bufoff, gbase, voff) do { _Pragma("unroll") for (int _i = 0; _i < 2; ++_i) \
        __builtin_amdgcn_global_load_lds((const unsigned*)((const char*)(gbase) + (voff)[_i]), (PG8_LAS unsigned*)(lds + (bufoff) + ldsw + _i * 8192), 16, 0, 0); } while (0)
#define PG8_LDA(dst, b, h) do { _Pragma("unroll") for (int m = 0; m < 4; ++m) _Pragma("unroll") for (int k = 0; k < 2; ++k) dst[m][k] = *(const PG8_LAS bf16x8*)(lds + PG8_SA(b, h) + aoff + m * 2048 + k * 1024); } while (0)
#define PG8_LDB(dst, b, h) do { _Pragma("unroll") for (int n = 0; n < 2; ++n) _Pragma("unroll") for (int k = 0; k < 2; ++k) dst[n][k] = *(const PG8_LAS bf16x8*)(lds + PG8_SB(b, h) + boff + n * 2048 + k * 1024); } while (0)
#define PG8_MMA(ai, bj, At, Bt) do { __builtin_amdgcn_s_setprio(1); _Pragma("unroll") for (int m = 0; m < 4; ++m) _Pragma("unroll") for (int n = 0; n < 2; ++n) _Pragma("unroll") for (int k = 0; k < 2; ++k) \
        acc[ai][bj][m][n] = __builtin_amdgcn_mfma_f32_16x16x32_bf16(Bt[n][k], At[m][k], acc[ai][bj][m][n], 0, 0, 0); __builtin_amdgcn_s_setprio(0); } while (0)
#define PG8_WAIT_V(n) asm volatile("s_waitcnt vmcnt(" #n ")" ::: "memory")
#define PG8_WAIT_L(n) asm volatile("s_waitcnt lgkmcnt(" #n ")" ::: "memory")
#define PG8_BAR __builtin_amdgcn_s_barrier()
#define PG8_SCHED __builtin_amdgcn_sched_barrier(0)
    Unit cur, nxt; int ui = 0;
    if (!S.next(0, cur)) return;
    f32x4 acc[2][2][4][2];
#pragma unroll
    for (int a = 0; a < 2; ++a)
#pragma unroll
        for (int b = 0; b < 2; ++b)
#pragma unroll
            for (int m = 0; m < 4; ++m)
#pragma unroll
                for (int n = 0; n < 2; ++n) acc[a][b][m][n] = (f32x4){0.f, 0.f, 0.f, 0.f};
    bf16x8 At[4][2], B0[2][2], B1[2][2];
    const char* cA = (const char*)g.A + (size_t)cur.pm * tstep; const char* cB = (const char*)g.Bt + (size_t)cur.pn * tstep;
    S.a_ready(cur);
    if constexpr (SP2) {
        PG8_STAGE(PG8_SB(0, 0), cB, voffB); PG8_STAGE(PG8_SB(0, 1), cB + hstep, voffB); PG8_STAGE(PG8_SA(0, 0), cA, voffA); PG8_STAGE(PG8_SA(0, 1), cA + hstep, voffA);
        if (wr == 1) PG8_BAR;
        PG8_WAIT_V(2); PG8_BAR;
        PG8_STAGE(PG8_SB(1, 0), cB + kstep, voffB); PG8_STAGE(PG8_SA(1, 0), cA + kstep, voffA); PG8_STAGE(PG8_SB(1, 1), cB + hstep + kstep, voffB);
        PG8_WAIT_V(6); PG8_BAR;
    } else {
        PG8_STAGE(PG8_SB(0, 0), cB, voffB); PG8_STAGE(PG8_SA(0, 0), cA, voffA); PG8_STAGE(PG8_SB(0, 1), cB + hstep, voffB); PG8_STAGE(PG8_SA(0, 1), cA + hstep, voffA);
        if (wr == 1) PG8_BAR;
        PG8_WAIT_V(4); PG8_BAR;
        PG8_STAGE(PG8_SB(1, 0), cB + kstep, voffB); PG8_STAGE(PG8_SA(1, 0), cA + kstep, voffA); PG8_STAGE(PG8_SB(1, 1), cB + hstep + kstep, voffB);
        PG8_WAIT_V(6); PG8_BAR;
    }
    for (;;) {
        const bool has_next = S.next(ui + 1, nxt);
        const char* nA = has_next ? (const char*)g.A + (size_t)nxt.pm * tstep : cA; const char* nB = has_next ? (const char*)g.Bt + (size_t)nxt.pn * tstep : cB;
        for (int t = 0; t < nt; t += 2) {
            const bool last = (t == nt - 2);
            const char* a1 = cA + (size_t)(t + 1) * kstep;
            const char* a2 = last ? nA : cA + (size_t)(t + 2) * kstep; const char* b2 = last ? nB : cB + (size_t)(t + 2) * kstep;
            const char* a3 = a2 + kstep; const char* b3 = b2 + kstep;
            if (last && has_next) S.a_ready(nxt);
            if constexpr (SP2) {
            PG8_LDB(B0, 0, 0); PG8_LDB(B1, 0, 1); PG8_SCHED; PG8_LDA(At, 0, 0); PG8_STAGE(PG8_SA(1, 1), a1 + hstep, voffA);
            PG8_WAIT_V(8); PG8_WAIT_L(0); PG8_BAR; PG8_MMA(0, 0, At, B0); PG8_MMA(0, 1, At, B1); PG8_BAR; PG8_SCHED;
            PG8_LDA(At, 0, 1); PG8_STAGE(PG8_SB(0, 0), b2, voffB); PG8_STAGE(PG8_SB(0, 1), b2 + hstep, voffB); PG8_STAGE(PG8_SA(0, 0), a2, voffA);
            PG8_WAIT_V(8); PG8_WAIT_L(0); PG8_BAR; PG8_MMA(1, 0, At, B0); PG8_MMA(1, 1, At, B1); PG8_BAR; PG8_SCHED;
            PG8_LDB(B0, 1, 0); PG8_LDB(B1, 1, 1); PG8_SCHED; PG8_LDA(At, 1, 0); PG8_STAGE(PG8_SA(0, 1), a2 + hstep, voffA);
            PG8_WAIT_V(8); PG8_WAIT_L(0); PG8_BAR; PG8_MMA(0, 0, At, B0); PG8_MMA(0, 1, At, B1); PG8_BAR; PG8_SCHED;
            PG8_LDA(At, 1, 1); PG8_STAGE(PG8_SB(1, 0), b3, voffB); PG8_STAGE(PG8_SB(1, 1), b3 + hstep, voffB); PG8_STAGE(PG8_SA(1, 0), a3, voffA);
            PG8_WAIT_V(8); PG8_WAIT_L(0); PG8_BAR; PG8_MMA(1, 0, At, B0); PG8_MMA(1, 1, At, B1); PG8_BAR; PG8_SCHED;
            } else {
            PG8_LDB(B0, 0, 0); PG8_SCHED; PG8_LDA(At, 0, 0); PG8_STAGE(PG8_SA(1, 1), a1 + hstep, voffA);
            PG8_WAIT_L(8); PG8_BAR; PG8_WAIT_L(0); PG8_MMA(0, 0, At, B0); PG8_BAR; PG8_SCHED;
            PG8_LDB(B1, 0, 1); PG8_STAGE(PG8_SB(0, 0), b2, voffB);
            PG8_BAR; PG8_WAIT_L(0); PG8_MMA(0, 1, At, B1); PG8_BAR;
            PG8_LDA(At, 0, 1); PG8_STAGE(PG8_SA(0, 0), a2, voffA);
            PG8_BAR; PG8_WAIT_L(0); PG8_MMA(1, 0, At, B0); PG8_BAR; PG8_SCHED;
            PG8_STAGE(PG8_SB(0, 1), b2 + hstep, voffB);
            PG8_WAIT_V(6); PG8_BAR; PG8_MMA(1, 1, At, B1); PG8_BAR;
            PG8_LDB(B0, 1, 0); PG8_SCHED; PG8_LDA(At, 1, 0); PG8_STAGE(PG8_SA(0, 1), a2 + hstep, voffA);
            PG8_WAIT_L(8); PG8_BAR; PG8_WAIT_L(0); PG8_MMA(0, 0, At, B0); PG8_BAR; PG8_SCHED;
            PG8_LDB(B1, 1, 1); PG8_STAGE(PG8_SB(1, 0), b3, voffB);
            PG8_BAR; PG8_WAIT_L(0); PG8_MMA(0, 1, At, B1); PG8_BAR;
            PG8_LDA(At, 1, 1); PG8_STAGE(PG8_SA(1, 0), a3, voffA);
            PG8_BAR; PG8_WAIT_L(0); PG8_MMA(1, 0, At, B0); PG8_BAR; PG8_SCHED;
            PG8_STAGE(PG8_SB(1, 1), b3 + hstep, voffB);
            PG8_WAIT_V(6); PG8_BAR; PG8_MMA(1, 1, At, B1); PG8_BAR;
            }
        }
        if constexpr (ALIGN_EPI) { if (wr == 0) PG8_BAR; }
        if constexpr (!Epi::AFTER_DRAIN) { E(acc, cur, wr, wc, fr, fq); S.done(cur); }
        if (!has_next) break;
#pragma unroll
        for (int a = 0; a < 2; ++a)
#pragma unroll
            for (int b = 0; b < 2; ++b)
#pragma unroll
                for (int m = 0; m < 4; ++m)
#pragma unroll
                    for (int n = 0; n < 2; ++n) acc[a][b][m][n] = (f32x4){0.f, 0.f, 0.f, 0.f};
        cur = nxt; cA = nA; cB = nB; ++ui;
        if constexpr (ALIGN_EPI) { if (wr == 1) PG8_BAR; }
    }
    PG8_WAIT_V(0);
    if constexpr (!ALIGN_EPI) { if (wr == 0) PG8_BAR; }
    PG8_BAR;
    if constexpr (Epi::AFTER_DRAIN) { E.fused(acc, cur, wr, wc, fr, fq, lds, wid, lane); S.done(cur); }
#undef PG8_SA
#undef PG8_SB
#undef PG8_STAGE
#undef PG8_LDA
#undef PG8_LDB
#undef PG8_MMA
#undef PG8_WAIT_V
#undef PG8_WAIT_L
#undef PG8_BAR
#undef PG8_SCHED
}
}
#define GAS __attribute__((address_space(1)))
#define LAS __attribute__((address_space(3)))
typedef unsigned short bf16;
typedef unsigned v4u __attribute__((ext_vector_type(4)));
typedef float f32x4 __attribute__((ext_vector_type(4)));
typedef short bf16x8 __attribute__((ext_vector_type(8)));
typedef GAS unsigned gu32;
typedef GAS unsigned long long gu64;
#define RLX_AGENT __ATOMIC_RELAXED, __HIP_MEMORY_SCOPE_AGENT
#define LDS_WAIT() asm volatile("s_waitcnt lgkmcnt(0)" ::: "memory")
#define VM_WAIT() asm volatile("s_waitcnt vmcnt(0)" ::: "memory")
__device__ __forceinline__ unsigned long long rt() { return __builtin_amdgcn_s_memrealtime(); }
__device__ __forceinline__ unsigned f2bf(float f) { unsigned u = __builtin_bit_cast(unsigned, f); return (u + 0x7fffu + ((u >> 16) & 1u)) >> 16; }
__device__ __forceinline__ unsigned pk2(float lo, float hi) { return f2bf(lo) | (f2bf(hi) << 16); }
#define XB_TMO      128
#define XB_XCNT(j)  (256  + 64 * (j))
#define XB_XSUB(j)  (1280 + 64 * (j))
#define XB_XGEN(j)  (2304 + 64 * (j))
#define XB_TOP      3328
#define XB_TOPGEN   3392
#define XCD_BAR_WORDS 3456
#define XB_SPIN_CAP (1u << 18)

__device__ __forceinline__ unsigned xb_ld(unsigned* p)              { return __hip_atomic_load(p, __ATOMIC_RELAXED, __HIP_MEMORY_SCOPE_AGENT); }
__device__ __forceinline__ unsigned xb_add(unsigned* p, unsigned v) { return __hip_atomic_fetch_add(p, v, __ATOMIC_RELAXED, __HIP_MEMORY_SCOPE_AGENT); }
__device__ __forceinline__ unsigned xb_xcc_id() { return (unsigned)__builtin_amdgcn_s_getreg((3 << 11) | 20) & 0xFu; }
#define XB_SPIN(cond, bar) do { unsigned _sp = 0; while (cond) { __builtin_amdgcn_s_sleep(1); \
    if ((++_sp & 255u) == 0u) { if (xb_ld(&(bar)[XB_TMO])) break; if (_sp > XB_SPIN_CAP) { atomicAdd(&(bar)[XB_TMO], 1u); break; } } } } while (0)

struct XcdBarrier {
    unsigned* bar; unsigned x;
    volatile LAS unsigned* st;
};

__device__ __forceinline__ XcdBarrier xcd_barrier_post(unsigned* bar, volatile LAS unsigned* st) {
    XcdBarrier b; b.bar = bar; b.x = xb_xcc_id(); b.st = st;
    if (threadIdx.x == 0) (void)xb_add(&bar[XB_XCNT(b.x)], 1u);
    return b;
}
__device__ __forceinline__ void xcd_barrier_complete(unsigned* bar, unsigned x, unsigned& nloc, unsigned& nx) {
    const unsigned G = gridDim.x * gridDim.y * gridDim.z;
    unsigned sum, cnt, mine, sp = 0u;
    for (;;) {
        sum = 0u; cnt = 0u; mine = 0u;
#pragma unroll
        for (unsigned j = 0; j < 16; ++j) { const unsigned c = xb_ld(&bar[XB_XCNT(j)]); sum += c; cnt += (c > 0u) ? 1u : 0u; mine = (j == x) ? c : mine; }
        if (sum == G) break;
        __builtin_amdgcn_s_sleep(1);
        if ((++sp & 255u) == 0u) { if (xb_ld(&bar[XB_TMO])) break; if (sp > XB_SPIN_CAP) { atomicAdd(&bar[XB_TMO], 1u); break; } }
    }
    nloc = mine > 0u ? mine : 1u; nx = cnt > 0u ? cnt : 1u;
}

__device__ __forceinline__ void xcd_barrier(const XcdBarrier& b) {
    asm volatile("s_waitcnt vmcnt(0)" ::: "memory");
    __syncthreads();
    if (threadIdx.x == 0) {
        unsigned* bar = b.bar;
        __builtin_amdgcn_s_waitcnt(0);
        unsigned nloc = b.st[0], nx = b.st[1];
        if (nloc == 0u) { xcd_barrier_complete(bar, b.x, nloc, nx); b.st[0] = nloc; b.st[1] = nx; }
        const unsigned old = xb_add(&bar[XB_XSUB(b.x)], 1u);
        const unsigned gen = old / nloc;
        if (old + 1u == (gen + 1u) * nloc) {
            __builtin_amdgcn_fence(__ATOMIC_RELEASE, "agent");
            asm volatile("s_waitcnt vmcnt(0)" ::: "memory");
            const unsigned og = xb_add(&bar[XB_TOP], 1u);
            const unsigned tg = og / nx;
            if (og + 1u == (tg + 1u) * nx) xb_add(&bar[XB_TOPGEN], 1u);
            else XB_SPIN(xb_ld(&bar[XB_TOPGEN]) == tg, bar);
            __builtin_amdgcn_fence(__ATOMIC_ACQUIRE, "agent");
            xb_add(&bar[XB_XGEN(b.x)], 1u);
            asm volatile("s_waitcnt vmcnt(0)" ::: "memory");
        } else {
            XB_SPIN(xb_ld(&bar[XB_XGEN(b.x)]) == gen, bar);
            __builtin_amdgcn_fence(__ATOMIC_ACQUIRE, "agent");
            asm volatile("s_waitcnt vmcnt(0)" ::: "memory");
        }
    }
    __syncthreads();
}
namespace wa {
typedef unsigned short u16;
typedef short bf16x8 __attribute__((ext_vector_type(8)));
typedef short s16x4 __attribute__((ext_vector_type(4)));
typedef float f32x16 __attribute__((ext_vector_type(16)));
typedef unsigned u32x4 __attribute__((ext_vector_type(4)));
typedef __attribute__((address_space(3))) unsigned char* lptr;
#define WA_LAS __attribute__((address_space(3)))
__device__ __forceinline__ int crow(int r, int hi) { return (r & 3) + 8 * (r >> 2) + 4 * hi; }
typedef float f32x2_t __attribute__((ext_vector_type(2))); typedef __bf16 bf16x2_t __attribute__((ext_vector_type(2)));
__device__ __forceinline__ unsigned cvtpk(float lo, float hi) { f32x2_t v = {lo, hi}; bf16x2_t b = __builtin_convertvector(v, bf16x2_t); return __builtin_bit_cast(unsigned, b); }
__device__ __forceinline__ float bflo(unsigned w) { return __builtin_bit_cast(float, w << 16); }
__device__ __forceinline__ float bfhi(unsigned w) { return __builtin_bit_cast(float, w & 0xffff0000u); }

struct TileRegs { u32x4 k[8], v[8]; };
constexpr unsigned PITCH = 2304;
__device__ __forceinline__ void tile_load(TileRegs& t, const u16* Kp, const u16* Vp, unsigned koff, unsigned voff) {
#pragma unroll
    for (int i = 0; i < 8; ++i) t.k[i] = *(const u32x4*)(Kp + (size_t)(8 * i) * PITCH + koff);
#pragma unroll
    for (int pc = 0; pc < 8; ++pc) t.v[pc] = *(const u32x4*)(Vp + (size_t)(16 * (pc & 3)) * PITCH + (pc >> 2) * 32 + voff);
}
__device__ __forceinline__ void tile_store(const TileRegs& t, lptr slot, int lane) {
#pragma unroll
    for (int i = 0; i < 8; ++i) *(WA_LAS u32x4*)(slot + (lane & 7) * 1024 + (8 * i + (lane >> 3)) * 16) = t.k[i];
#pragma unroll
    for (int pc = 0; pc < 8; ++pc) *(WA_LAS u32x4*)(slot + 8192 + pc * 1024 + lane * 16) = t.v[pc];
}
__device__ __forceinline__ void qkt(f32x16& p0, f32x16& p1, lptr slot, const bf16x8 (&qr)[4], int r32, int hi) {
    const lptr kb = slot + hi * 1024 + r32 * 16;
    const f32x16 z = {0.f, 0.f, 0.f, 0.f, 0.f, 0.f, 0.f, 0.f, 0.f, 0.f, 0.f, 0.f, 0.f, 0.f, 0.f, 0.f};
    p0 = z; p1 = z;
#pragma unroll
    for (int d0 = 0; d0 < 4; ++d0) {
        const bf16x8 b0 = *(const WA_LAS bf16x8*)(kb + d0 * 2048);
        const bf16x8 b1 = *(const WA_LAS bf16x8*)(kb + d0 * 2048 + 512);
        p0 = __builtin_amdgcn_mfma_f32_32x32x16_bf16(b0, qr[d0], p0, 0, 0, 0);
        p1 = __builtin_amdgcn_mfma_f32_32x32x16_bf16(b1, qr[d0], p1, 0, 0, 0);
    }
}
typedef short v4i16_t __attribute__((ext_vector_type(4)));
__device__ __forceinline__ s16x4 vtr(lptr p) { return __builtin_bit_cast(s16x4, __builtin_amdgcn_ds_read_tr16_b64_v4i16((WA_LAS v4i16_t*)p)); }
__device__ __forceinline__ void pv(f32x16 (&o)[2], lptr slot, const u32x4 (&pw)[4], int lane) {
    const int hi = lane >> 5;
    const lptr vb = slot + 8192 + ((lane >> 4) & 1) * 32 + (lane & 3) * 8 + (4 * hi + ((lane & 15) >> 2)) * 64;
#pragma unroll
    for (int d0 = 0; d0 < 2; ++d0)
#pragma unroll
        for (int ks = 0; ks < 4; ++ks) {
            const s16x4 lo = vtr(vb + d0 * 4096 + ks * 1024), hh = vtr(vb + d0 * 4096 + ks * 1024 + 512);
            const bf16x8 vf = (bf16x8){lo[0], lo[1], lo[2], lo[3], hh[0], hh[1], hh[2], hh[3]};
            o[d0] = __builtin_amdgcn_mfma_f32_32x32x16_bf16(__builtin_bit_cast(bf16x8, pw[ks]), vf, o[d0], 0, 0, 0);
        }
}
__device__ __forceinline__ void xhalf(float mine, float& other) {
    unsigned x = __builtin_bit_cast(unsigned, mine), y = x; asm volatile("" : "+v"(y));
    auto rr = __builtin_amdgcn_permlane32_swap(x, y, false, false);
    const unsigned lo = rr[0], hi = rr[1];
    other = __builtin_bit_cast(float, (__builtin_amdgcn_mbcnt_hi(~0u, __builtin_amdgcn_mbcnt_lo(~0u, 0u)) < 32u) ? hi : lo);
}
__device__ __forceinline__ float rowmax(const f32x16& p0, const f32x16& p1) {
    float a = fmaxf(p0[0], p1[0]);
#pragma unroll
    for (int r = 1; r < 16; ++r) a = fmaxf(a, fmaxf(p0[r], p1[r]));
    float other; xhalf(a, other);
    return fmaxf(a, other);
}
struct State { f32x16 o[2]; float m, l; };
__device__ __forceinline__ void sm_pv(State& st, f32x16& p0, f32x16& p1, lptr slot, WA_LAS float* wsf, int lane) {
    const int r32 = lane & 31, hi = lane >> 5;
    const float rm = rowmax(p0, p1);
    const float mnew = fmaxf(st.m, rm);
    const float ms = (mnew == -INFINITY) ? 0.f : mnew;
    const float alpha = __builtin_amdgcn_exp2f(st.m - ms);
    st.m = mnew;
    float ps = 0.f;
#pragma unroll
    for (int r = 0; r < 16; ++r) { p0[r] = __builtin_amdgcn_exp2f(p0[r] - ms); p1[r] = __builtin_amdgcn_exp2f(p1[r] - ms); ps += p0[r] + p1[r]; }
    st.l = st.l * alpha + ps;
    if (!__all(alpha == 1.0f)) {
        if (hi == 0) wsf[r32] = alpha;
#pragma unroll
        for (int r = 0; r < 16; ++r) { const float f = wsf[crow(r, hi)]; st.o[0][r] *= f; st.o[1][r] *= f; }
    }
    u32x4 pw[4];
#pragma unroll
    for (int i = 0; i < 4; ++i) { pw[0][i] = cvtpk(p0[2 * i], p0[2 * i + 1]); pw[1][i] = cvtpk(p0[8 + 2 * i], p0[9 + 2 * i]); pw[2][i] = cvtpk(p1[2 * i], p1[2 * i + 1]); pw[3][i] = cvtpk(p1[8 + 2 * i], p1[9 + 2 * i]); }
    pv(st.o, slot, pw, lane);
}
__device__ __forceinline__ void row_recip(const State& st, float (&rl)[16], WA_LAS float* wsf, int lane) {
    const int r32 = lane & 31, hi = lane >> 5;
    float other; xhalf(st.l, other);
    const float lt = st.l + other;
    if (hi == 0) wsf[32 + r32] = lt;
#pragma unroll
    for (int r = 0; r < 16; ++r) rl[r] = 1.0f / wsf[32 + crow(r, hi)];
}
__device__ __forceinline__ void store_mul(const State& st, const float (&rl)[16], u16* Yp, lptr stg_, int lane) {
    const int r32 = lane & 31, hi = lane >> 5; WA_LAS u16* stg = (WA_LAS u16*)stg_;
#pragma unroll
    for (int r = 0; r < 16; ++r) { const int orow = crow(r, hi);
#pragma unroll
        for (int d0 = 0; d0 < 2; ++d0) stg[orow * 64 + d0 * 32 + r32] = (u16)(cvtpk(st.o[d0][r] * rl[r], 0.f) & 0xffffu); }
    asm volatile("s_waitcnt lgkmcnt(0)" ::: "memory");
#pragma unroll
    for (int i = 0; i < 4; ++i) { const int row = i * 8 + (lane >> 3), ch = lane & 7;
        const u32x4 a = *(const WA_LAS u32x4*)(stg + row * 64 + ch * 8); u32x4* gp = (u32x4*)(Yp + (size_t)row * 1024 + ch * 8); const u32x4 y = *gp; u32x4 w;
#pragma unroll
        for (int e = 0; e < 4; ++e) w[e] = cvtpk(bflo(a[e]) * bflo(y[e]), bfhi(a[e]) * bfhi(y[e]));
        *gp = w; }
}

struct SpecPlain {
    const u16 *K, *V; int n;
    __device__ __forceinline__ int nt() const { return n; }
    __device__ __forceinline__ void tile(int j, const u16*& Kp, const u16*& Vp) const { Kp = K + (size_t)(64 * j) * PITCH; Vp = V + (size_t)(64 * j) * PITCH; }
    __device__ __forceinline__ void mask(int, f32x16&, f32x16&, int) const {}
};
struct SpecNA {
    const u16 *K, *V;
    int r, rs, c, cs; const WA_LAS float* bias;
    __device__ __forceinline__ int nt() const { return 12; }
    __device__ __forceinline__ void tile(int j, const u16*& Kp, const u16*& Vp) const { const int row = (j < 8) ? 64 * (rs + j) : 8192 + 64 * (j - 8); Kp = K + (size_t)row * PITCH; Vp = V + (size_t)row * PITCH; }
    __device__ __forceinline__ void mask(int j, f32x16& p0, f32x16& p1, int hi) const {
        if (j >= 8) return;
        const int base = (rs + j - r + 7) * 31 + 15 - c;
#pragma unroll
        for (int rr = 0; rr < 16; ++rr) {
            const int k0 = crow(rr, hi), k1 = k0 + 32;
            const bool v0 = (k0 >= cs) && (k0 <= cs + 15), v1 = (k1 >= cs) && (k1 <= cs + 15);
            const float b0 = bias[v0 ? base + k0 : 0], b1 = bias[v1 ? base + k1 : 0];
            p0[rr] = v0 ? p0[rr] + b0 : -INFINITY; p1[rr] = v1 ? p1[rr] + b1 : -INFINITY;
        }
    }
};
struct SpecWin {
    const u16 *K, *V; int ks0, nw, q;
    __device__ __forceinline__ int nt() const { return nw + 4; }
    __device__ __forceinline__ void tile(int j, const u16*& Kp, const u16*& Vp) const { const int row = (j < nw) ? ks0 + 64 * j : 8192 + 64 * (j - nw); Kp = K + (size_t)row * PITCH; Vp = V + (size_t)row * PITCH; }
    __device__ __forceinline__ void mask(int j, f32x16& p0, f32x16& p1, int hi) const {
        if (j >= nw) return;
#ifdef NOMASK_D
        return;
#endif
        const int kb = ks0 + 64 * j - q;
#pragma unroll
        for (int rr = 0; rr < 16; ++rr) { const int d0 = kb + crow(rr, hi), d1 = d0 + 32;
            if (d0 < -128 || d0 > 128) p0[rr] = -INFINITY; if (d1 < -128 || d1 > 128) p1[rr] = -INFINITY; }
    }
};
template <class Spec>
__device__ __forceinline__ void run(const Spec& sp, const u16* Qp, State& st, lptr slot, WA_LAS float* wsf, int lane, float* dumpS = nullptr, bool ksel = true) {
    const int r32 = lane & 31, hi = lane >> 5;
    bf16x8 qr[4];
#pragma unroll
    for (int d0 = 0; d0 < 4; ++d0) qr[d0] = *(const bf16x8*)(Qp + d0 * 16 + hi * 8);
    const f32x16 z = {0.f, 0.f, 0.f, 0.f, 0.f, 0.f, 0.f, 0.f, 0.f, 0.f, 0.f, 0.f, 0.f, 0.f, 0.f, 0.f};
    st.o[0] = z; st.o[1] = z;
    const int nt = sp.nt();
    TileRegs tr; const u16 *Kp, *Vp;
    const unsigned koff = (unsigned)(lane >> 3) * PITCH + (lane & 7) * 8, voff = (unsigned)(lane >> 2) * PITCH + (lane & 3) * 8;
#ifndef NOPF
    sp.tile(0, Kp, Vp); tile_load(tr, Kp, Vp, koff, voff);
#endif
    for (int j = 0; j < nt; ++j) {
#ifdef NOPF
        sp.tile(j, Kp, Vp); tile_load(tr, Kp, Vp, koff, voff);
        asm volatile("s_waitcnt vmcnt(0) lgkmcnt(0)" ::: "memory");
#endif
        tile_store(tr, slot, lane);
        asm volatile("" ::: "memory");
#ifdef NOPF
        asm volatile("s_waitcnt vmcnt(0) lgkmcnt(0)" ::: "memory");
#else
        if (j + 1 < nt) { sp.tile(j + 1, Kp, Vp); tile_load(tr, Kp, Vp, koff, voff); }
#endif
        f32x16 p0, p1;
        qkt(p0, p1, slot, qr, r32, hi);
#ifdef DUMP_S
        if (dumpS && j == 0) {
#pragma unroll
            for (int r = 0; r < 16; ++r) { dumpS[(size_t)r32 * 64 + crow(r, hi)] = p0[r]; dumpS[(size_t)r32 * 64 + 32 + crow(r, hi)] = p1[r]; }
        }
#endif
#ifdef UNIFORM_P
        p0 = p0 * 0.f; p1 = p1 * 0.f;
#endif
#ifdef KSEL
        if (ksel)
#pragma unroll
        for (int r = 0; r < 16; ++r) { if (crow(r, hi) != (KSEL)) p0[r] = -INFINITY; if (crow(r, hi) + 32 != (KSEL)) p1[r] = -INFINITY; }
#endif
        sp.mask(j, p0, p1, hi);
        sm_pv(st, p0, p1, slot, wsf, lane);
        asm volatile("" ::: "memory");
    }
}
}
namespace fa {
using bf16=__hip_bfloat16;
using bf16x8=__attribute__((ext_vector_type(8)))short;
using s16x4=__attribute__((ext_vector_type(4)))short;
using f32x16=__attribute__((ext_vector_type(16)))float;
using u32x4=__attribute__((ext_vector_type(4)))unsigned;
constexpr int D=64,DM=2304;
constexpr int NW=8,QBLK=32,QB=QBLK*NW,KVBLK=64;
__device__ __forceinline__ int crow(int r,int hi){return (r&3)+8*(r>>2)+4*hi;}
#define SBAR() __builtin_amdgcn_sched_barrier(0)
__device__ __forceinline__ void cmask(f32x16&p0,f32x16&p1,int jb,int qrel,int hi){
  const float NEG=-INFINITY; int kb=64*jb+4*hi;
  #pragma unroll
  for(int r=0;r<16;++r){int kv=kb+(r&3)+8*(r>>2); if(kv>qrel)p0[r]=NEG; if(kv+32>qrel)p1[r]=NEG;}
}

constexpr int NSLOT=3, SLOTB=8192;
constexpr int LDS_K=0, LDS_V=NSLOT*SLOTB, LDS_WS=2*NSLOT*SLOTB, LDS_OST=LDS_WS+NW*64*4, LDS_BYTES=LDS_OST+NW*4096;
constexpr float C2=0.125f*1.4426950408889634f;
__device__ __forceinline__ void glds16(const void*gsrc,unsigned lds_dst){unsigned keep;
  asm volatile("s_mov_b32 %0, m0\n\ts_mov_b32 m0, %2\n\ts_nop 0\n\tglobal_load_lds_dwordx4 %1, off\n\ts_mov_b32 m0, %0":"=&s"(keep):"v"(gsrc),"s"(lds_dst):"memory");}
__device__ __forceinline__ float max3f(float a,float b,float c){float r;asm("v_max3_f32 %0, %1, %2, %3":"=v"(r):"v"(a),"v"(b),"v"(c));return r;}
__device__ __forceinline__ float max2f(float a,float b){float r;asm("v_max_f32_e32 %0, %1, %2":"=v"(r):"v"(a),"v"(b));return r;}
__device__ __forceinline__ float fadd_s(float a,float b){float r;asm("v_add_f32_e32 %0, %1, %2":"=v"(r):"v"(a),"v"(b));return r;}
__device__ __forceinline__ float fsub_s(float a,float b){float r;asm("v_sub_f32_e32 %0, %1, %2":"=v"(r):"v"(a),"v"(b));return r;}
typedef float f32x2_t __attribute__((ext_vector_type(2))); typedef __bf16 bf16x2_t __attribute__((ext_vector_type(2)));
__device__ __forceinline__ unsigned cvtpk_s(float lo,float hi){f32x2_t v={lo,hi};bf16x2_t b=__builtin_convertvector(v,bf16x2_t);return __builtin_bit_cast(unsigned,b);}
#define WAIT_BAR(N) asm volatile("s_waitcnt vmcnt(" #N ") lgkmcnt(0)\n\ts_barrier":::"memory")

__device__ __forceinline__ void qkt(f32x16&p0,f32x16&p1,const char*Kslot,const bf16x8*qr,const f32x16&negm,int r32,int hi){
  const char*kb=Kslot+hi*1024+r32*16;
  #pragma unroll
  for(int d0=0;d0<4;++d0){
    const bf16x8 b0=*reinterpret_cast<const bf16x8*>(kb+d0*2048);
    const bf16x8 b1=*reinterpret_cast<const bf16x8*>(kb+d0*2048+512);
    if(d0==0){p0=__builtin_amdgcn_mfma_f32_32x32x16_bf16(b0,qr[0],negm,0,0,0);p1=__builtin_amdgcn_mfma_f32_32x32x16_bf16(b1,qr[0],negm,0,0,0);}
    else{p0=__builtin_amdgcn_mfma_f32_32x32x16_bf16(b0,qr[d0],p0,0,0,0);p1=__builtin_amdgcn_mfma_f32_32x32x16_bf16(b1,qr[d0],p1,0,0,0);}}
}
typedef __attribute__((address_space(3))) const char* lds_cptr;
typedef short v4i16_t __attribute__((ext_vector_type(4)));
__device__ __forceinline__ void kload8(bf16x8*kf,lds_cptr kp){
  kf[0]=*(const __attribute__((address_space(3))) bf16x8*)(kp);      kf[1]=*(const __attribute__((address_space(3))) bf16x8*)(kp+512);
  kf[2]=*(const __attribute__((address_space(3))) bf16x8*)(kp+2048); kf[3]=*(const __attribute__((address_space(3))) bf16x8*)(kp+2560);
  kf[4]=*(const __attribute__((address_space(3))) bf16x8*)(kp+4096); kf[5]=*(const __attribute__((address_space(3))) bf16x8*)(kp+4608);
  kf[6]=*(const __attribute__((address_space(3))) bf16x8*)(kp+6144); kf[7]=*(const __attribute__((address_space(3))) bf16x8*)(kp+6656);
}
__device__ __forceinline__ void kload2(bf16x8*kf,lds_cptr kp,int j){ kf[2*j]=*(const __attribute__((address_space(3))) bf16x8*)(kp+j*2048); kf[2*j+1]=*(const __attribute__((address_space(3))) bf16x8*)(kp+j*2048+512); }
__device__ __forceinline__ s16x4 vtr(lds_cptr p){ return __builtin_bit_cast(s16x4,__builtin_amdgcn_ds_read_tr16_b64_v4i16((__attribute__((address_space(3))) v4i16_t*)p)); }
__device__ __forceinline__ float xhalf(float mine){ unsigned x=__float_as_uint(mine),y=x; asm volatile("":"+v"(y)); auto rr=__builtin_amdgcn_permlane32_swap(x,y,false,false);
  const unsigned lo=rr[0],hi_=rr[1]; return __uint_as_float((__builtin_amdgcn_mbcnt_hi(~0u,__builtin_amdgcn_mbcnt_lo(~0u,0u))<32u)?hi_:lo); }
__device__ __forceinline__ float rowmax(const f32x16&p0,const f32x16&p1){
  float a=max3f(p0[0],p0[1],p1[0]),b=max3f(p0[2],p0[3],p1[1]);a=max3f(a,p1[2],p1[3]);
  #pragma unroll
  for(int r=4;r<16;r+=4){a=max3f(a,p0[r],p0[r+1]);b=max3f(b,p0[r+2],p0[r+3]);a=max3f(a,p1[r],p1[r+1]);b=max3f(b,p1[r+2],p1[r+3]);}
  const float m=max2f(a,b);
  return max2f(m,xhalf(m));
}
__device__ __forceinline__ void pv(f32x16*o,int vb,bf16x8 pa0,bf16x8 pa1,bf16x8 pa2,bf16x8 pa3){
  #pragma unroll
  for(int d0=0;d0<2;++d0){s16x4 lo[4],hi[4];
    #pragma unroll
    for(int ks=0;ks<4;++ks){
      asm volatile("ds_read_b64_tr_b16 %0,%1 offset:%c2":"=&v"(lo[ks]):"v"(vb),"i"(d0*4096+ks*1024):"memory");
      asm volatile("ds_read_b64_tr_b16 %0,%1 offset:%c2":"=&v"(hi[ks]):"v"(vb),"i"(d0*4096+ks*1024+512):"memory");}
    asm volatile("s_waitcnt lgkmcnt(0)":::"memory");SBAR();
    #define PK(k) (bf16x8){lo[k][0],lo[k][1],lo[k][2],lo[k][3],hi[k][0],hi[k][1],hi[k][2],hi[k][3]}
    o[d0]=__builtin_amdgcn_mfma_f32_32x32x16_bf16(pa0,PK(0),o[d0],0,0,0);
    o[d0]=__builtin_amdgcn_mfma_f32_32x32x16_bf16(pa1,PK(1),o[d0],0,0,0);
    o[d0]=__builtin_amdgcn_mfma_f32_32x32x16_bf16(pa2,PK(2),o[d0],0,0,0);
    o[d0]=__builtin_amdgcn_mfma_f32_32x32x16_bf16(pa3,PK(3),o[d0],0,0,0);
    #undef PK
  }
}

#ifndef ATTN_STORE16
#define ATTN_STORE16(p,v) (*(u32x4*)(p)=(v))
#endif
template<int THRL,class TM,class Out> __device__ __forceinline__ void attn_unit(const TM&tm,const bf16*__restrict__ Kh,const bf16*__restrict__ Vh,const int NT,char*shm,const Out&out){
  int tid_=threadIdx.x; asm volatile("":"+v"(tid_)); const int tid=tid_,lane=tid&63,r32=lane&31,hi=lane>>5; const int wid=__builtin_amdgcn_readfirstlane(tid>>6);
  const bf16*Qw=tm.qrow(wid);
  const unsigned lds0=(unsigned)(uintptr_t)shm;
  float*wsf=(float*)(shm+LDS_WS)+wid*64;
  const bf16*ksrc=Kh+(long)lane*DM+wid*8;
  const bf16*vsrc=Vh+(long)(16*(wid&3)+(lane>>2))*DM+(wid>>2)*32+(lane&3)*8;
  const unsigned kdst=lds0+LDS_K+wid*1024, vdst=lds0+LDS_V+wid*1024;
  #define DMA_K(t,slot) glds16(ksrc+tm.off(t),(unsigned)__builtin_amdgcn_readfirstlane(kdst+(slot)))
  #define DMA_V(t,slot) glds16(vsrc+tm.off(t),(unsigned)__builtin_amdgcn_readfirstlane(vdst+(slot)))
  const int vb0=(int)(lds0+LDS_V)+((lane>>4)&1)*32+(lane&3)*8+(4*hi+((lane&15)>>2))*64;
  const char*Kbase=shm+LDS_K; bf16x8 kf[8];
  const lds_cptr shm3=(lds_cptr)shm; const lds_cptr kp0=shm3+LDS_K+hi*1024+r32*16; const lds_cptr vp0=shm3+LDS_V+((lane>>4)&1)*32+(lane&3)*8+(4*hi+((lane&15)>>2))*64;
  DMA_K(0,0);DMA_V(0,0);DMA_K(1,SLOTB);
  bf16x8 qr[4];
  #pragma unroll
  for(int d0=0;d0<4;++d0)qr[d0]=*reinterpret_cast<const bf16x8*>(&Qw[(long)r32*DM+d0*16+hi*8]);
  float mhat=0.f,l_reg=0.f;f32x16 o[2];o[0]=f32x16{};o[1]=f32x16{};f32x16 negm=f32x16{};asm volatile("":"+v"(negm));
  #define CMASK(P0,P1,t) tm.mask(P0,P1,t,hi)
  bool resc=false;
  #define START(P0,P1) do{ const float rm=rowmax(P0,P1); resc=false; \
    { const float dl=rm; mhat=fadd_s(mhat,dl); \
      _Pragma("unroll") for(int r=0;r<16;++r){P0[r]=fsub_s(P0[r],dl);P1[r]=fsub_s(P1[r],dl);} \
      _Pragma("unroll") for(int r=0;r<16;++r)negm[r]=-mhat; asm volatile("":"+v"(negm)); } \
    _Pragma("unroll") for(int r=0;r<16;++r)P0[r]=__builtin_amdgcn_exp2f(P0[r]); }while(0)
  #define RESC() do{ if(resc){ asm volatile("s_waitcnt lgkmcnt(0)":::"memory"); \
      _Pragma("unroll") for(int d_=0;d_<2;++d_) _Pragma("unroll") for(int r=0;r<16;++r)o[d_][r]*=wsf[crow(r,hi)]; } }while(0)
  f32x16 pA0,pA1,pB0,pB1;
  int sl_prev=0,sl_cur=0,sl_next=SLOTB;
  #define ROT() do{sl_prev=sl_cur;sl_cur=sl_next;sl_next=(sl_next==(NSLOT-1)*SLOTB)?0:sl_next+SLOTB;}while(0)
  DMA_K(2,2*SLOTB);
  WAIT_BAR(3);
  qkt(pA0,pA1,Kbase,qr,negm,r32,hi);asm volatile("s_nop 15\n\ts_nop 7":"+v"(pA0),"+v"(pA1));CMASK(pA0,pA1,0);
  START(pA0,pA1);
  { const float sk=tm.sink(); if(sk!=-INFINITY&&hi==0)l_reg+=__builtin_amdgcn_exp2f(sk-mhat); }
  _Pragma("unroll") for(int r=0;r<16;++r)pA1[r]=__builtin_amdgcn_exp2f(pA1[r]);
  WAIT_BAR(0);
  DMA_K(3,0);DMA_V(1,SLOTB);
  ROT();
  kload8(kf,kp0+sl_cur);
  WAIT_BAR(2);
  s16x4 vlo[8],vhi[8]; u32x4 pw0,pw1,pw2,pw3;
  #define PKW(P,B) cvtpk_s(P[B],P[B+1])
  #define PAF(k) __builtin_bit_cast(bf16x8,pw##k)
  #define VFR(i) (bf16x8){vlo[i][0],vlo[i][1],vlo[i][2],vlo[i][3],vhi[i][0],vhi[i][1],vhi[i][2],vhi[i][3]}
  #define PIN(x) asm volatile("":"+v"(x))
  #define MX3(a,b,c) __builtin_fmaxf(__builtin_fmaxf((a),(b)),(c))
  #define GAPA(MF,A0,A1,A2,A3,W0,W1,PW) do{ MF; sacc+=A0; sacc+=A1; sacc+=A2; sacc+=A3; PIN(sacc); W0; W1; PIN(PW); SBAR(); }while(0)
  #define EX(v) __builtin_amdgcn_exp2f(v)
  #define GAPB(MF,X,B) do{ MF; X[B]=EX(X[B]); X[B+1]=EX(X[B+1]); X[B+2]=EX(X[B+2]); X[B+3]=EX(X[B+3]); PIN(X); SBAR(); }while(0)
  #define VRD(i) do{ vlo[i]=vtr(vp_+(((i)>>2)*4096+((i)&3)*1024)); vhi[i]=vtr(vp_+(((i)>>2)*4096+((i)&3)*1024+512)); }while(0)
  #define KRD(G,j) do{ if(G){ kload2(kf,kp0+sl_next,j); SBAR(); } }while(0)
  #define STEP(C0,C1,P0,P1,t,GK,GV,GL) do{ SBAR(); \
    const lds_cptr vp_=vp0+sl_prev; \
    VRD(0); SBAR(); float sacc=(P0[0]+P0[1]); \
    GAPA(C0=__builtin_amdgcn_mfma_f32_32x32x16_bf16(kf[0],qr[0],negm,0,0,0), P0[2],P0[3],P0[4],P0[5],     pw0[0]=PKW(P0,0), pw0[1]=PKW(P0,2), pw0); \
    VRD(4); SBAR(); GAPA(C1=__builtin_amdgcn_mfma_f32_32x32x16_bf16(kf[1],qr[0],negm,0,0,0), P0[6],P0[7],P0[8],P0[9],     pw0[2]=PKW(P0,4), pw0[3]=PKW(P0,6), pw0); \
    VRD(1); SBAR(); GAPA(C0=__builtin_amdgcn_mfma_f32_32x32x16_bf16(kf[2],qr[1],C0,0,0,0),   P0[10],P0[11],P0[12],P0[13], pw1[0]=PKW(P0,8), pw1[1]=PKW(P0,10), pw1); \
    VRD(5); SBAR(); GAPA(C1=__builtin_amdgcn_mfma_f32_32x32x16_bf16(kf[3],qr[1],C1,0,0,0),   P0[14],P0[15],P1[0],P1[1],   pw1[2]=PKW(P0,12),pw1[3]=PKW(P0,14), pw1); \
    VRD(2); SBAR(); GAPA(C0=__builtin_amdgcn_mfma_f32_32x32x16_bf16(kf[4],qr[2],C0,0,0,0),   P1[2],P1[3],P1[4],P1[5],     pw2[0]=PKW(P1,0), pw2[1]=PKW(P1,2), pw2); \
    VRD(6); SBAR(); GAPA(C1=__builtin_amdgcn_mfma_f32_32x32x16_bf16(kf[5],qr[2],C1,0,0,0),   P1[6],P1[7],P1[8],P1[9],     pw2[2]=PKW(P1,4), pw2[3]=PKW(P1,6), pw2); \
    VRD(3); SBAR(); GAPA(C0=__builtin_amdgcn_mfma_f32_32x32x16_bf16(kf[6],qr[3],C0,0,0,0),   P1[10],P1[11],P1[12],P1[13], pw3[0]=PKW(P1,8), pw3[1]=PKW(P1,10), pw3); \
    VRD(7); SBAR(); GAPA(C1=__builtin_amdgcn_mfma_f32_32x32x16_bf16(kf[7],qr[3],C1,0,0,0),   P1[14],P1[15],0.f,0.f,       pw3[2]=PKW(P1,12),pw3[3]=PKW(P1,14), pw3); \
    l_reg+=sacc; \
    if(GK){DMA_K((t)+3,sl_cur);} if(GV){DMA_V((t)+1,sl_next);} \
    CMASK(C0,C1,t); \
    { float a=MX3(C0[0],C0[1],C1[0]),b=MX3(C0[2],C0[3],C1[1]); a=MX3(a,C1[2],C1[3]); \
      _Pragma("unroll") for(int r=4;r<16;r+=4){a=MX3(a,C0[r],C0[r+1]);b=MX3(b,C0[r+2],C0[r+3]);a=MX3(a,C1[r],C1[r+1]);b=MX3(b,C1[r+2],C1[r+3]);} \
      float rm=__builtin_fmaxf(a,b); rm=__builtin_fmaxf(rm,xhalf(rm)); \
      resc=false; \
      if(__builtin_expect(__any(rm>(float)THRL),0)){ const float dl=__builtin_fmaxf(rm,0.f); mhat+=dl; \
        _Pragma("unroll") for(int r=0;r<16;++r){C0[r]-=dl;C1[r]-=dl;} \
        _Pragma("unroll") for(int r=0;r<16;++r)negm[r]=-mhat; asm volatile("":"+v"(negm)); \
        const float f=__builtin_amdgcn_exp2f(-dl); l_reg*=f; if(hi==0)wsf[r32]=f; resc=true; } } \
    SBAR(); \
    GAPB(o[0]=__builtin_amdgcn_mfma_f32_32x32x16_bf16(PAF(0),VFR(0),o[0],0,0,0), C0,0); \
    GAPB(o[1]=__builtin_amdgcn_mfma_f32_32x32x16_bf16(PAF(0),VFR(4),o[1],0,0,0), C0,4); \
    KRD(GL,0); GAPB(o[0]=__builtin_amdgcn_mfma_f32_32x32x16_bf16(PAF(1),VFR(1),o[0],0,0,0), C0,8); \
    KRD(GL,1); GAPB(o[1]=__builtin_amdgcn_mfma_f32_32x32x16_bf16(PAF(1),VFR(5),o[1],0,0,0), C0,12); \
    KRD(GL,2); GAPB(o[0]=__builtin_amdgcn_mfma_f32_32x32x16_bf16(PAF(2),VFR(2),o[0],0,0,0), C1,0); \
    KRD(GL,3); GAPB(o[1]=__builtin_amdgcn_mfma_f32_32x32x16_bf16(PAF(2),VFR(6),o[1],0,0,0), C1,4); \
    GAPB(o[0]=__builtin_amdgcn_mfma_f32_32x32x16_bf16(PAF(3),VFR(3),o[0],0,0,0), C1,8); \
    GAPB(o[1]=__builtin_amdgcn_mfma_f32_32x32x16_bf16(PAF(3),VFR(7),o[1],0,0,0), C1,12); \
    }while(0)
  int t=1;
  for(;t+5<NT;t+=2){
    STEP(pB0,pB1,pA0,pA1,t,true,true,true);     WAIT_BAR(2); RESC(); ROT();
    STEP(pA0,pA1,pB0,pB1,t+1,true,true,true);   WAIT_BAR(2); RESC(); ROT();
  }
  #define ENDW(tt) do{ if((tt)+3<NT){WAIT_BAR(2);} else if((tt)+2<NT){WAIT_BAR(1);} else {WAIT_BAR(0);} }while(0)
  for(;t+1<NT;t+=2){
    STEP(pB0,pB1,pA0,pA1,t,(t+3<NT),(t+1<NT),(t+1<NT));       ENDW(t);   RESC(); ROT();
    STEP(pA0,pA1,pB0,pB1,t+1,(t+4<NT),(t+2<NT),(t+2<NT));     ENDW(t+1); RESC(); ROT();
  }
  STEP(pB0,pB1,pA0,pA1,NT-1,false,false,false); RESC();
  { float sacc=pB0[0]+pB0[1]; _Pragma("unroll") for(int r=2;r<16;++r)sacc+=pB0[r]; _Pragma("unroll") for(int r=0;r<16;++r)sacc+=pB1[r]; l_reg+=sacc;
    pw0=(u32x4){PKW(pB0,0),PKW(pB0,2),PKW(pB0,4),PKW(pB0,6)};pw1=(u32x4){PKW(pB0,8),PKW(pB0,10),PKW(pB0,12),PKW(pB0,14)};pw2=(u32x4){PKW(pB1,0),PKW(pB1,2),PKW(pB1,4),PKW(pB1,6)};pw3=(u32x4){PKW(pB1,8),PKW(pB1,10),PKW(pB1,12),PKW(pB1,14)};
    SBAR(); pv(o,vb0+sl_cur,PAF(0),PAF(1),PAF(2),PAF(3)); }
  #undef PKW
  #undef PAF
  #undef VFR
  #undef PIN
  #undef MX3
  #undef GAPA
  #undef GAPB
  #undef EX
  #undef VRD
  #undef KRD
  #undef STEP
  #undef ENDW
  l_reg+=xhalf(l_reg);
  if(hi==0)wsf[32+r32]=l_reg;asm volatile("s_waitcnt lgkmcnt(0)":::"memory");
  float rli[16];
  #pragma unroll
  for(int r=0;r<16;++r)rli[r]=__builtin_amdgcn_rcpf(wsf[32+crow(r,hi)]);
  out(o,rli,wid,lane,shm);
  asm volatile("s_waitcnt lgkmcnt(0)\n\ts_barrier":::"memory");
  #undef DMA_K
  #undef DMA_V
  #undef CMASK
  #undef START
  #undef RESC
  #undef ROT
}
struct PlainMap {
  const bf16* Q0;
  __device__ __forceinline__ long off(int t)const{return (long)t*KVBLK*DM;}
  __device__ __forceinline__ void mask(f32x16&,f32x16&,int,int)const{}
  __device__ __forceinline__ float sink()const{return -INFINITY;}
  __device__ __forceinline__ const bf16* qrow(int wid)const{return Q0+(long)(wid*QBLK)*DM;}
};
struct OutMulY {
  unsigned short* Y0;
  __device__ __forceinline__ void operator()(const f32x16 (&o)[2],const float (&rli)[16],int wid,int lane,char*shm)const{
    const int r32=lane&31,hi=lane>>5; unsigned short*stg=(unsigned short*)(shm+LDS_OST)+wid*2048;
    #pragma unroll
    for(int r=0;r<16;++r){const int orow=crow(r,hi);
      #pragma unroll
      for(int d0=0;d0<2;++d0)stg[orow*64+d0*32+r32]=(unsigned short)(cvtpk_s(o[d0][r]*rli[r],0.f)&0xffffu);}
    asm volatile("s_waitcnt lgkmcnt(0)":::"memory");
    unsigned short*Yw=Y0+(long)(wid*QBLK)*1024;
    #pragma unroll
    for(int i=0;i<4;++i){const int row=i*8+(lane>>3),ch=lane&7; const u32x4 a=*(const u32x4*)(stg+row*64+ch*8); u32x4*gp=(u32x4*)(Yw+(long)row*1024+ch*8); const u32x4 y=*gp; u32x4 w;
      #pragma unroll
      for(int e=0;e<4;++e)w[e]=cvtpk_s(__uint_as_float(a[e]<<16)*__uint_as_float(y[e]<<16),__uint_as_float(a[e]&0xffff0000u)*__uint_as_float(y[e]&0xffff0000u));
      *gp=w;}
  }
};
struct OutF32 {
  float* O0;
  __device__ __forceinline__ void operator()(const f32x16 (&o)[2],const float (&rli)[16],int wid,int lane,char*)const{
    const int r32=lane&31,hi=lane>>5; float*op=O0+(long)(wid*QBLK)*1024+r32;
    #pragma unroll
    for(int r=0;r<16;++r){const int q=crow(r,hi); op[(long)q*1024]=o[0][r]*rli[r]; op[(long)q*1024+32]=o[1][r]*rli[r];}
  }
};
struct OutMulYW {
  unsigned short* Yw;
  __device__ __forceinline__ void operator()(const f32x16 (&o)[2],const float (&rli)[16],int wid,int lane,char*shm)const{ const OutMulY t{Yw-(long)(wid*QBLK)*1024}; t(o,rli,wid,lane,shm); }
};
struct WinMap {
  const bf16* Qw_; int ks0, nw, q; float sk;
  __device__ __forceinline__ long off(int t)const{ const int row=(t<4)?8192+64*t:((t<4+nw)?ks0+64*(t-4):8192); return (long)row*DM; }
  __device__ __forceinline__ void mask(f32x16&c0,f32x16&c1,int t,int hi)const{
    if(t<4)return;
    if(t>=4+nw){ _Pragma("unroll") for(int r=0;r<16;++r){c0[r]=-INFINITY;c1[r]=-INFINITY;} return; }
    const int kb=ks0+64*(t-4)-q;
    _Pragma("unroll") for(int r=0;r<16;++r){ const int d0=kb+crow(r,hi),d1=d0+32; if(d0<-128||d0>128)c0[r]=-INFINITY; if(d1<-128||d1>128)c1[r]=-INFINITY; }
  }
  __device__ __forceinline__ float sink()const{return sk;}
  __device__ __forceinline__ const bf16* qrow(int)const{return Qw_;}
};
struct NAMap {
  const bf16* Qw_; int rs0, nr, r, rs, c, cs; const float* bias;
  __device__ __forceinline__ long off(int t)const{ const int row=(t<4)?8192+64*t:((t<4+nr)?64*(rs0+t-4):8192); return (long)row*DM; }
  __device__ __forceinline__ void mask(f32x16&c0,f32x16&c1,int t,int hi)const{
    if(t<4)return;
    const int kr=rs0+t-4;
    if(t>=4+nr||kr<rs||kr>rs+7){ _Pragma("unroll") for(int r_=0;r_<16;++r_){c0[r_]=-INFINITY;c1[r_]=-INFINITY;} return; }
    const int base=(kr-r+7)*31+15-c;
    _Pragma("unroll") for(int r_=0;r_<16;++r_){ const int k0=crow(r_,hi),k1=k0+32; const bool v0=(k0>=cs)&&(k0<=cs+15),v1=(k1>=cs)&&(k1<=cs+15);
      const float b0=bias[v0?base+k0:0],b1=bias[v1?base+k1:0]; c0[r_]=v0?c0[r_]+b0:-INFINITY; c1[r_]=v1?c1[r_]+b1:-INFINITY; }
  }
  __device__ __forceinline__ float sink()const{return -INFINITY;}
  __device__ __forceinline__ const bf16* qrow(int)const{return Qw_;}
};
constexpr int ATTN_LDS_BYTES=LDS_BYTES;
#undef SBAR
#undef WAIT_BAR
}
namespace fa {
constexpr int C_SLOTB=16384, C_LDS_K=0, C_LDS_V=NSLOT*C_SLOTB, C_LDS_WS=2*NSLOT*C_SLOTB, C_LDS_X=C_LDS_WS+NW*64*4, C_LDS_BYTES=C_LDS_X;
#define SBAR() __builtin_amdgcn_sched_barrier(0)
#define WAIT_BAR(N) asm volatile("s_waitcnt vmcnt(" #N ") lgkmcnt(0)\n\ts_barrier":::"memory")
__device__ __forceinline__ void pv4(f32x16*o,int vb,bf16x8 pa0,bf16x8 pa1,bf16x8 pa2,bf16x8 pa3){
  #pragma unroll
  for(int d0=0;d0<4;++d0){s16x4 lo[4],hi[4];
    #pragma unroll
    for(int ks=0;ks<4;++ks){
      asm volatile("ds_read_b64_tr_b16 %0,%1 offset:%c2":"=&v"(lo[ks]):"v"(vb),"i"(d0*4096+ks*1024):"memory");
      asm volatile("ds_read_b64_tr_b16 %0,%1 offset:%c2":"=&v"(hi[ks]):"v"(vb),"i"(d0*4096+ks*1024+512):"memory");}
    asm volatile("s_waitcnt lgkmcnt(0)":::"memory");SBAR();
    #define PK(k) (bf16x8){lo[k][0],lo[k][1],lo[k][2],lo[k][3],hi[k][0],hi[k][1],hi[k][2],hi[k][3]}
    o[d0]=__builtin_amdgcn_mfma_f32_32x32x16_bf16(pa0,PK(0),o[d0],0,0,0);
    o[d0]=__builtin_amdgcn_mfma_f32_32x32x16_bf16(pa1,PK(1),o[d0],0,0,0);
    o[d0]=__builtin_amdgcn_mfma_f32_32x32x16_bf16(pa2,PK(2),o[d0],0,0,0);
    o[d0]=__builtin_amdgcn_mfma_f32_32x32x16_bf16(pa3,PK(3),o[d0],0,0,0);
    #undef PK
  }
}
template<int THRL,class Out> __device__ __forceinline__ void attn_unit_c(const bf16*Q0,const bf16*__restrict__ Kh,const bf16*__restrict__ Vh,const int NT,char*shm,const Out&out){
  int tid_=threadIdx.x; asm volatile("":"+v"(tid_)); const int tid=tid_,lane=tid&63,r32=lane&31,hi=lane>>5; const int wid=__builtin_amdgcn_readfirstlane(tid>>6); const int msub=wid>>2;
  const bf16*Qw=Q0+(long)((wid&3)*QBLK)*DM+msub*64;
  const unsigned lds0=(unsigned)(uintptr_t)shm;
  float*wsf=(float*)(shm+C_LDS_WS)+wid*64;
  const bf16*ksrc=Kh+(long)lane*DM+wid*8;
  const bf16*vsrc=Vh+(long)(16*(wid&3)+(lane>>2))*DM+(wid>>2)*32+(lane&3)*8;
  const unsigned kdst=lds0+C_LDS_K+wid*1024, vdst=lds0+C_LDS_V+wid*1024;
  #define DMA_K(t,slot) do{ glds16(ksrc+(long)(t)*KVBLK*DM,(unsigned)__builtin_amdgcn_readfirstlane(kdst+(slot))); glds16(ksrc+64+(long)(t)*KVBLK*DM,(unsigned)__builtin_amdgcn_readfirstlane(kdst+(slot)+8192)); }while(0)
  #define DMA_V(t,slot) do{ glds16(vsrc+(long)(t)*KVBLK*DM,(unsigned)__builtin_amdgcn_readfirstlane(vdst+(slot))); glds16(vsrc+64+(long)(t)*KVBLK*DM,(unsigned)__builtin_amdgcn_readfirstlane(vdst+(slot)+8192)); }while(0)
  const int vb0=(int)(lds0+C_LDS_V)+((lane>>4)&1)*32+(lane&3)*8+(4*hi+((lane&15)>>2))*64;
  const char*Kbase=shm+C_LDS_K+msub*8192; bf16x8 kf[8];
  const lds_cptr shm3=(lds_cptr)shm; const lds_cptr kp0=shm3+C_LDS_K+msub*8192+hi*1024+r32*16; const lds_cptr vp0=shm3+C_LDS_V+((lane>>4)&1)*32+(lane&3)*8+(4*hi+((lane&15)>>2))*64;
  DMA_K(0,0);DMA_V(0,0);DMA_K(1,C_SLOTB);
  bf16x8 qr[4];
  #pragma unroll
  for(int d0=0;d0<4;++d0)qr[d0]=*reinterpret_cast<const bf16x8*>(&Qw[(long)r32*DM+d0*16+hi*8]);
  float mhat=0.f,l_reg=0.f;f32x16 o[4];o[0]=f32x16{};o[1]=f32x16{};o[2]=f32x16{};o[3]=f32x16{};f32x16 negm=f32x16{};asm volatile("":"+v"(negm));
  bool resc=false;
  #define RESC() do{ if(resc){ asm volatile("s_waitcnt lgkmcnt(0)":::"memory"); \
      _Pragma("unroll") for(int d_=0;d_<4;++d_) _Pragma("unroll") for(int r=0;r<16;++r)o[d_][r]*=wsf[crow(r,hi)]; } }while(0)
  f32x16 C0,C1; u32x4 pwA[4],pwB[4];
  int sl_prev=0,sl_cur=0,sl_next=C_SLOTB;
  #define ROT() do{sl_prev=sl_cur;sl_cur=sl_next;sl_next=(sl_next==(NSLOT-1)*C_SLOTB)?0:sl_next+C_SLOTB;}while(0)
  DMA_K(2,2*C_SLOTB);
  WAIT_BAR(6);
  qkt(C0,C1,Kbase,qr,negm,r32,hi);asm volatile("s_nop 15\n\ts_nop 7":"+v"(C0),"+v"(C1));
  { const float rm=rowmax(C0,C1); mhat=fadd_s(mhat,rm);
    _Pragma("unroll") for(int r=0;r<16;++r){C0[r]=fsub_s(C0[r],rm);C1[r]=fsub_s(C1[r],rm);}
    _Pragma("unroll") for(int r=0;r<16;++r)negm[r]=-mhat; asm volatile("":"+v"(negm));
    float sacc=0.f;
    _Pragma("unroll") for(int r=0;r<16;++r){C0[r]=__builtin_amdgcn_exp2f(C0[r]);C1[r]=__builtin_amdgcn_exp2f(C1[r]);sacc+=C0[r]+C1[r];}
    l_reg+=sacc;
    _Pragma("unroll") for(int i=0;i<4;++i){pwA[0][i]=cvtpk_s(C0[2*i],C0[2*i+1]);pwA[1][i]=cvtpk_s(C0[8+2*i],C0[9+2*i]);pwA[2][i]=cvtpk_s(C1[2*i],C1[2*i+1]);pwA[3][i]=cvtpk_s(C1[8+2*i],C1[9+2*i]);} }
  WAIT_BAR(0);
  DMA_K(3,0);DMA_V(1,C_SLOTB);
  ROT();
  kload8(kf,kp0+sl_cur);
  WAIT_BAR(4);
  s16x4 vlo[8],vhi[8];
  #define PAF(PW,k) __builtin_bit_cast(bf16x8,PW[k])
  #define VFR(i) (bf16x8){vlo[i][0],vlo[i][1],vlo[i][2],vlo[i][3],vhi[i][0],vhi[i][1],vhi[i][2],vhi[i][3]}
  #define PIN(x) asm volatile("":"+v"(x))
  #define MX3(a,b,c) __builtin_fmaxf(__builtin_fmaxf((a),(b)),(c))
  #define EX(v) __builtin_amdgcn_exp2f(v)
  #define VRD(i) do{ vlo[i]=vtr(vp_+(((i)>>2)*4096+((i)&3)*1024)); vhi[i]=vtr(vp_+(((i)>>2)*4096+((i)&3)*1024+512)); }while(0)
  #define VRD2(i) do{ vlo[i]=vtr(vp_+((2+((i)>>2))*4096+((i)&3)*1024)); vhi[i]=vtr(vp_+((2+((i)>>2))*4096+((i)&3)*1024+512)); }while(0)
  #define KRD(G,j) do{ if(G){ kload2(kf,kp0+sl_next,j); SBAR(); } }while(0)
  #define QKM(C,KF,Q,INIT) do{ C=__builtin_amdgcn_mfma_f32_32x32x16_bf16(KF,Q,INIT,0,0,0); SBAR(); }while(0)
  #define GAPC(MF,X,B,W,EXTRA) do{ MF; X[B]=EX(X[B]); X[B+1]=EX(X[B+1]); sacc+=X[B]; sacc+=X[B+1]; W=cvtpk_s(X[B],X[B+1]); PIN(sacc); PIN(W); EXTRA; SBAR(); }while(0)
  #define STEPC(PWP,PWC,t,GK,GV,GL) do{ SBAR(); \
    const lds_cptr vp_=vp0+sl_prev; \
    VRD(0); SBAR(); QKM(C0,kf[0],qr[0],negm); \
    VRD(4); SBAR(); QKM(C1,kf[1],qr[0],negm); \
    VRD(1); SBAR(); QKM(C0,kf[2],qr[1],C0); \
    VRD(5); SBAR(); QKM(C1,kf[3],qr[1],C1); \
    VRD(2); SBAR(); QKM(C0,kf[4],qr[2],C0); \
    VRD(6); SBAR(); QKM(C1,kf[5],qr[2],C1); \
    VRD(3); SBAR(); QKM(C0,kf[6],qr[3],C0); \
    VRD(7); SBAR(); QKM(C1,kf[7],qr[3],C1); \
    if(GK){DMA_K((t)+3,sl_cur);} if(GV){DMA_V((t)+1,sl_next);} \
    { float a=MX3(C0[0],C0[1],C1[0]),b=MX3(C0[2],C0[3],C1[1]); a=MX3(a,C1[2],C1[3]); \
      _Pragma("unroll") for(int r=4;r<16;r+=4){a=MX3(a,C0[r],C0[r+1]);b=MX3(b,C0[r+2],C0[r+3]);a=MX3(a,C1[r],C1[r+1]);b=MX3(b,C1[r+2],C1[r+3]);} \
      float rm=__builtin_fmaxf(a,b); rm=__builtin_fmaxf(rm,xhalf(rm)); \
      resc=false; \
      if(__builtin_expect(__any(rm>(float)THRL),0)){ const float dl=__builtin_fmaxf(rm,0.f); mhat+=dl; \
        _Pragma("unroll") for(int r=0;r<16;++r){C0[r]-=dl;C1[r]-=dl;} \
        _Pragma("unroll") for(int r=0;r<16;++r)negm[r]=-mhat; asm volatile("":"+v"(negm)); \
        const float f=__builtin_amdgcn_exp2f(-dl); l_reg*=f; if(hi==0)wsf[r32]=f; resc=true; } } \
    SBAR(); float sacc=0.f; \
    GAPC(o[0]=__builtin_amdgcn_mfma_f32_32x32x16_bf16(PAF(PWP,0),VFR(0),o[0],0,0,0), C0,0, PWC[0][0], VRD2(0)); \
    GAPC(o[1]=__builtin_amdgcn_mfma_f32_32x32x16_bf16(PAF(PWP,0),VFR(4),o[1],0,0,0), C0,2, PWC[0][1], VRD2(4)); \
    GAPC(o[0]=__builtin_amdgcn_mfma_f32_32x32x16_bf16(PAF(PWP,1),VFR(1),o[0],0,0,0), C0,4, PWC[0][2], VRD2(1)); \
    GAPC(o[1]=__builtin_amdgcn_mfma_f32_32x32x16_bf16(PAF(PWP,1),VFR(5),o[1],0,0,0), C0,6, PWC[0][3], VRD2(5)); \
    GAPC(o[0]=__builtin_amdgcn_mfma_f32_32x32x16_bf16(PAF(PWP,2),VFR(2),o[0],0,0,0), C0,8, PWC[1][0], VRD2(2)); \
    GAPC(o[1]=__builtin_amdgcn_mfma_f32_32x32x16_bf16(PAF(PWP,2),VFR(6),o[1],0,0,0), C0,10,PWC[1][1], VRD2(6)); \
    GAPC(o[0]=__builtin_amdgcn_mfma_f32_32x32x16_bf16(PAF(PWP,3),VFR(3),o[0],0,0,0), C0,12,PWC[1][2], VRD2(3)); \
    GAPC(o[1]=__builtin_amdgcn_mfma_f32_32x32x16_bf16(PAF(PWP,3),VFR(7),o[1],0,0,0), C0,14,PWC[1][3], VRD2(7)); \
    GAPC(o[2]=__builtin_amdgcn_mfma_f32_32x32x16_bf16(PAF(PWP,0),VFR(0),o[2],0,0,0), C1,0, PWC[2][0], ); \
    GAPC(o[3]=__builtin_amdgcn_mfma_f32_32x32x16_bf16(PAF(PWP,0),VFR(4),o[3],0,0,0), C1,2, PWC[2][1], ); \
    KRD(GL,0); GAPC(o[2]=__builtin_amdgcn_mfma_f32_32x32x16_bf16(PAF(PWP,1),VFR(1),o[2],0,0,0), C1,4, PWC[2][2], ); \
    KRD(GL,1); GAPC(o[3]=__builtin_amdgcn_mfma_f32_32x32x16_bf16(PAF(PWP,1),VFR(5),o[3],0,0,0), C1,6, PWC[2][3], ); \
    KRD(GL,2); GAPC(o[2]=__builtin_amdgcn_mfma_f32_32x32x16_bf16(PAF(PWP,2),VFR(2),o[2],0,0,0), C1,8, PWC[3][0], ); \
    KRD(GL,3); GAPC(o[3]=__builtin_amdgcn_mfma_f32_32x32x16_bf16(PAF(PWP,2),VFR(6),o[3],0,0,0), C1,10,PWC[3][1], ); \
    GAPC(o[2]=__builtin_amdgcn_mfma_f32_32x32x16_bf16(PAF(PWP,3),VFR(3),o[2],0,0,0), C1,12,PWC[3][2], ); \
    GAPC(o[3]=__builtin_amdgcn_mfma_f32_32x32x16_bf16(PAF(PWP,3),VFR(7),o[3],0,0,0), C1,14,PWC[3][3], ); \
    l_reg+=sacc; \
    }while(0)
  int t=1;
  for(;t+5<NT;t+=2){
    STEPC(pwA,pwB,t,true,true,true);     WAIT_BAR(4); RESC(); ROT();
    STEPC(pwB,pwA,t+1,true,true,true);   WAIT_BAR(4); RESC(); ROT();
  }
  #define ENDW(tt) do{ if((tt)+3<NT){WAIT_BAR(4);} else if((tt)+2<NT){WAIT_BAR(2);} else {WAIT_BAR(0);} }while(0)
  for(;t+1<NT;t+=2){
    STEPC(pwA,pwB,t,(t+3<NT),(t+1<NT),(t+1<NT));       ENDW(t);   RESC(); ROT();
    STEPC(pwB,pwA,t+1,(t+4<NT),(t+2<NT),(t+2<NT));     ENDW(t+1); RESC(); ROT();
  }
  STEPC(pwA,pwB,NT-1,false,false,false); RESC();
  SBAR(); pv4(o,vb0+sl_cur,PAF(pwB,0),PAF(pwB,1),PAF(pwB,2),PAF(pwB,3));
  #undef PAF
  #undef VFR
  #undef PIN
  #undef MX3
  #undef EX
  #undef VRD
  #undef VRD2
  #undef KRD
  #undef QKM
  #undef GAPC
  #undef STEPC
  #undef ENDW
  l_reg+=xhalf(l_reg);
  if(hi==0)wsf[32+r32]=l_reg;asm volatile("s_waitcnt lgkmcnt(0)":::"memory");
  float rli[16];
  #pragma unroll
  for(int r=0;r<16;++r)rli[r]=__builtin_amdgcn_rcpf(wsf[32+crow(r,hi)]);
  asm volatile("s_waitcnt lgkmcnt(0)\n\ts_barrier":::"memory");
  out(o,rli,wid,lane,shm);
  asm volatile("s_waitcnt lgkmcnt(0)\n\ts_barrier":::"memory");
  #undef DMA_K
  #undef DMA_V
  #undef RESC
  #undef ROT
}
struct OutF32C {
  float* O0;
  __device__ __forceinline__ void operator()(const f32x16 (&o)[4],const float (&rli)[16],int wid,int lane,char*)const{
    const int r32=lane&31,hi=lane>>5; float*op=O0+(long)((wid&3)*QBLK)*1024+(wid>>2)*128+r32;
    #pragma unroll
    for(int r=0;r<16;++r){const int q=crow(r,hi);
      #pragma unroll
      for(int db=0;db<4;++db)op[(long)q*1024+db*32]=o[db][r]*rli[r];}
  }
};
struct OutDiffC {
  unsigned short* Y0;
  const float* subln; float lam, post;
  __device__ __forceinline__ void operator()(const f32x16 (&o)[4],const float (&rli)[16],int wid,int lane,char*shm)const{
    const int r32=lane&31,hi=lane>>5,wq=wid&3; float*X=(float*)shm+wq*4096;
    if(wid>=4){
      #pragma unroll
      for(int r=0;r<16;++r){const int q=crow(r,hi);
        #pragma unroll
        for(int db=0;db<4;++db)X[q*128+db*32+r32]=o[db][r]*rli[r];}
    }
    asm volatile("s_waitcnt lgkmcnt(0)\n\ts_barrier":::"memory");
    if(wid<4){
      float v[4][16],ss[16];
      #pragma unroll
      for(int r=0;r<16;++r){const int q=crow(r,hi); float a=0.f;
        #pragma unroll
        for(int db=0;db<4;++db){v[db][r]=o[db][r]*rli[r]-lam*X[q*128+db*32+r32]; a+=v[db][r]*v[db][r];}
        ss[r]=a;}
      #pragma unroll
      for(int r=0;r<16;++r){ float a=ss[r]; a+=__shfl_xor(a,1); a+=__shfl_xor(a,2); a+=__shfl_xor(a,4); a+=__shfl_xor(a,8); a+=__shfl_xor(a,16); ss[r]=post*__builtin_amdgcn_rsqf(a*(1.0f/128.0f)+1e-6f); }
      float g[4];
      #pragma unroll
      for(int db=0;db<4;++db)g[db]=subln[db*32+r32];
      asm volatile("s_waitcnt lgkmcnt(0)":::"memory");
      unsigned short*stg=(unsigned short*)(shm+65536)+wq*4096;
      #pragma unroll
      for(int r=0;r<16;++r){const int q=crow(r,hi);
        #pragma unroll
        for(int db=0;db<4;++db)stg[q*128+db*32+r32]=(unsigned short)(cvtpk_s(v[db][r]*ss[r]*g[db],0.f)&0xffffu);}
      asm volatile("s_waitcnt lgkmcnt(0)":::"memory");
      unsigned short*Yw=Y0+(long)(wq*QBLK)*1024;
      #pragma unroll
      for(int i=0;i<8;++i){const int row=i*4+(lane>>4),ch=lane&15; const u32x4 a=*(const u32x4*)(stg+row*128+ch*8); u32x4*gp=(u32x4*)(Yw+(long)row*1024+ch*8); const u32x4 y=*gp; u32x4 w;
        #pragma unroll
        for(int e=0;e<4;++e)w[e]=cvtpk_s(__uint_as_float(a[e]<<16)*__uint_as_float(y[e]<<16),__uint_as_float(a[e]&0xffff0000u)*__uint_as_float(y[e]&0xffff0000u));
        *gp=w;}
    }
  }
};
#undef SBAR
#undef WAIT_BAR
}
typedef float f32x2 __attribute__((ext_vector_type(2)));
#ifndef KSEL_MIX
#define KSEL_MIX 0
#endif
#ifndef FA_THR
#define FA_THR 8
#endif
constexpr int NB = 4, SEQ = 8192, CTXL = 256, DM = 1024, SE = SEQ + CTXL, RT = NB * SE, NIN = 3328, NQKV = 2304;
constexpr float LOG2E = 1.4426950408889634f, LAM0 = 0.35550906759f;
constexpr size_t MiB = 1u << 20;
constexpr size_t WS_CTL = 0, CTL_ZERO_BYTES = 1 * MiB;
constexpr size_t WS_MOD = 1 * MiB;
constexpr size_t WS_ROPE = 1 * MiB + 256 * 1024;
constexpr size_t WS_WIN0 = 2 * MiB, WS_WIN1 = 10 * MiB;
constexpr size_t WS_WOUT0 = 18 * MiB, WS_WOUT1 = 20 * MiB;
constexpr size_t WS_XC1 = 24 * MiB;
constexpr size_t WS_H = 32 * MiB;
constexpr size_t WS_Y = 100 * MiB;
constexpr size_t WS_QKV = 168 * MiB;
constexpr size_t WS_OC = 320 * MiB;
constexpr size_t WS_END = 448 * MiB;
static_assert(WS_H + (size_t)RT * DM * 2 <= WS_Y && WS_Y + (size_t)RT * DM * 2 <= WS_QKV && WS_QKV + (size_t)RT * NQKV * 2 <= WS_OC && WS_OC + (size_t)32768 * 1024 * 4 <= WS_END, "ws map");
constexpr int CW_BAR = 4096;
constexpr int RING_BYTES = 131072, SCR_OFF = RING_BYTES, BIAS_OFF = SCR_OFF + 2048, TAB_OFF = BIAS_OFF, TAB_FLOATS = 4096 + 128, LDSCTL_OFF = 150016, MISC_OFF = LDSCTL_OFF + 320, LDS_BYTES = 148 * 1024;
static_assert(BIAS_OFF + 8 * 465 * 4 <= LDSCTL_OFF && TAB_OFF + TAB_FLOATS * 4 <= LDSCTL_OFF && MISC_OFF + 128 <= LDS_BYTES, "LDS map");

typedef unsigned short u16;
__device__ __forceinline__ float wave_sum(float v) {
#pragma unroll
    for (int o = 1; o < 64; o <<= 1) v += __shfl_xor(v, o);
    return v;
}
__device__ __forceinline__ void p0_transpose_item(const float* W, int K, int N, u16* WT, bool perm, LAS float* scr, int item, int lane) {
    const int nblk = N / 32, kb = item / nblk, nb = item % nblk, k0 = 64 * kb, n0 = 32 * nb;
    const int rowbase = perm ? (256 * (n0 >> 8) + 32 * ((n0 >> 6) & 3) + 8 * ((n0 >> 5) & 1)) : n0;
#pragma unroll 8
    for (int i = 0; i < 32; ++i) { const int kk = 2 * i + (lane >> 5); scr[kk * 33 + (lane & 31)] = W[(size_t)(k0 + kk) * N + n0 + (lane & 31)]; }
    LDS_WAIT(); asm volatile("" ::: "memory");
    const int c = lane & 7;
#pragma unroll
    for (int j = 0; j < 4; ++j) { const int n = (lane >> 3) + 8 * j; const LAS float* s = scr + (8 * c) * 33 + n;
        const int rr = perm ? (128 * ((n >> 2) & 1) + 16 * (n >> 4) + 4 * ((n >> 3) & 1) + (n & 3)) : n;
        v4u o; o.x = pk2(s[0 * 33], s[1 * 33]); o.y = pk2(s[2 * 33], s[3 * 33]); o.z = pk2(s[4 * 33], s[5 * 33]); o.w = pk2(s[6 * 33], s[7 * 33]);
        *(v4u*)(WT + (size_t)(rowbase + rr) * K + k0 + 8 * c) = o; }
    LDS_WAIT(); asm volatile("" ::: "memory");
}

struct Args { const float* in[17]; float* out; unsigned char* ws; };

__global__ void __launch_bounds__(512, 2) fwd_kernel(Args args) {
    extern __shared__ __attribute__((aligned(16))) unsigned char lds_raw[];
    LAS unsigned char* lds = (LAS unsigned char*)lds_raw;
    volatile LAS unsigned* MISC = (volatile LAS unsigned*)(lds + MISC_OFF);
    const int G = gridDim.x, bx = blockIdx.x, vcu = (G % 8 == 0) ? (bx % 8) * (G / 8) + bx / 8 : bx, NGW = G * 8;
#define PH_IDS KP_DECL int tid = threadIdx.x; asm volatile("" : "+v"(tid)); const int lane = tid & 63, wave = __builtin_amdgcn_readfirstlane(tid >> 6), gw = vcu * 8 + wave; (void)lane; (void)gw;
#define AS4 __attribute__((address_space(4)))
#define KP_DECL const AS4 unsigned char* kp_ = (const AS4 unsigned char*)__builtin_amdgcn_kernarg_segment_ptr(); asm volatile("" : "+s"(kp_)); unsigned char* const ws = *(unsigned char* const AS4*)(kp_ + 144); (void)ws;
#define KIN(i) (*(const float* const AS4*)(kp_ + 8 * (i)))
#define KOUT (*(float* const AS4*)(kp_ + 136))
#define W_MOD ((float*)(ws + WS_MOD))
#define W_ROPEC ((float*)(ws + WS_ROPE))
#define W_ROPES ((float*)(ws + WS_ROPE) + 128 * 16)
#define W_XC1 ((float*)(ws + WS_XC1))
#define W_H ((u16*)(ws + WS_H))
#define W_Y ((u16*)(ws + WS_Y))
#define W_QKV ((u16*)(ws + WS_QKV))
#define W_OC ((float*)(ws + WS_OC))
    (void)args;
    for (int u = threadIdx.x; u < (LDS_BYTES - LDSCTL_OFF) / 4; u += 512) ((LAS unsigned*)(lds + LDSCTL_OFF))[u] = 0u;
    __syncthreads();
    { KP_DECL (void)xcd_barrier_post((unsigned*)(ws + WS_CTL) + CW_BAR, MISC + 8); }
#ifdef USE_CG
#define GRID_BAR() do { asm volatile("s_waitcnt vmcnt(0)" ::: "memory"); __threadfence(); cooperative_groups::this_grid().sync(); __threadfence(); } while (0)
#else
#define GRID_BAR() do { KP_DECL XcdBarrier b_; b_.bar = (unsigned*)(ws + WS_CTL) + CW_BAR; b_.x = xb_xcc_id(); b_.st = MISC + 8; xcd_barrier(b_); } while (0)
#endif

    {
        PH_IDS
        const float* cvec = KIN(1); const float* cctx = KIN(3); const float* w_mod = KIN(4); const float* b_mod = KIN(5); float* MOD = W_MOD; float* ROPEC = W_ROPEC; float* ROPES = W_ROPES;
        LAS float* sil = (LAS float*)lds;
        LAS float* part = (LAS float*)(lds + 20480);
        if (bx < 192) {
            for (int i = tid; i < 5120; i += 512) { const int v = i >> 10, k = i & 1023; const float cv = (v < 4) ? cvec[v * 1024 + k] : cctx[k]; sil[i] = cv / (1.0f + __expf(-cv)); }
            __syncthreads();
            for (int it = bx; it < 192; it += G) {
                const int layer = it / 96, n0 = (it % 96) * 32, ks = tid >> 5, cl = tid & 31;
                const float* W = w_mod + (size_t)layer * 1024 * 3072 + n0 + cl;
                float a0 = 0.f, a1 = 0.f, a2 = 0.f, a3 = 0.f, a4 = 0.f;
#pragma unroll 16
                for (int kk = 0; kk < 64; ++kk) { const int k = ks * 64 + kk; const float w = W[(size_t)k * 3072];
                    a0 += sil[k] * w; a1 += sil[1024 + k] * w; a2 += sil[2048 + k] * w; a3 += sil[3072 + k] * w; a4 += sil[4096 + k] * w; }
                part[(ks * 5 + 0) * 32 + cl] = a0; part[(ks * 5 + 1) * 32 + cl] = a1; part[(ks * 5 + 2) * 32 + cl] = a2; part[(ks * 5 + 3) * 32 + cl] = a3; part[(ks * 5 + 4) * 32 + cl] = a4;
                __syncthreads();
                if (tid < 160) { const int v = tid >> 5; float s = b_mod[layer * 3072 + n0 + cl];
#pragma unroll
                    for (int q = 0; q < 16; ++q) s += part[(q * 5 + v) * 32 + cl];
                    MOD[(size_t)(layer * 5 + v) * 3072 + n0 + cl] = s; }
                __syncthreads();
            }
        } else if (bx >= G - 4) {
            const int e = (bx - (G - 4)) * 512 + tid, pos = e >> 4, j = e & 15;
            const float inv = exp2f(-(float)j * (13.287712379549449f / 16.0f));
            const float ang = (float)pos * inv;
            ROPEC[e] = cosf(ang); ROPES[e] = sinf(ang);
        }
        __syncthreads();
        LAS float* scr = (LAS float*)(lds + wave * 16384);
        constexpr int I_IN = 16 * 104, I_OUT = 16 * 32, NITEMS = 2 * I_IN + 2 * I_OUT;
        for (int it = gw; it < NITEMS; it += NGW) {
            const float* Wsrc; u16* Wdst; int N_, r; bool perm;
            if (it < I_IN) { Wsrc = KIN(6); Wdst = (u16*)(ws + WS_WIN0); N_ = NIN; r = it; perm = true; }
            else if (it < 2 * I_IN) { Wsrc = KIN(11); Wdst = (u16*)(ws + WS_WIN1); N_ = NIN; r = it - I_IN; perm = true; }
            else if (it < 2 * I_IN + I_OUT) { Wsrc = KIN(7); Wdst = (u16*)(ws + WS_WOUT0); N_ = 1024; r = it - 2 * I_IN; perm = false; }
            else { Wsrc = KIN(12); Wdst = (u16*)(ws + WS_WOUT1); N_ = 1024; r = it - 2 * I_IN - I_OUT; perm = false; }
            p0_transpose_item(Wsrc, 1024, N_, Wdst, perm, scr, r, lane);
        }
    }
    GRID_BAR();

    for (int layer = 0; layer < 2; ++layer) {
        {
            PH_IDS
            const float* modl = W_MOD + (size_t)layer * 5 * 3072; u16* H = W_H;
            const float* xs = layer == 0 ? KIN(0) : KOUT; const float* cs = layer == 0 ? KIN(2) : W_XC1;
#ifdef PROBE_H
            for (int rep_ = 0; rep_ < 2; ++rep_)
#endif
            for (int R = gw; R < RT; R += NGW) {
                const int b = R / SE, t = R % SE;
                const float* src; const float* mv;
                if (t < SEQ) { src = xs + ((size_t)b * SEQ + t) * DM; mv = modl + b * 3072; } else { src = cs + ((size_t)b * CTXL + (t - SEQ)) * DM; mv = modl + 4 * 3072; }
                f32x4 v[4]; float ss = 0.f;
#pragma unroll
                for (int j = 0; j < 4; ++j) { v[j] = *(const f32x4*)(src + 4 * lane + 256 * j); ss += (v[j].x * v[j].x + v[j].y * v[j].y) + (v[j].z * v[j].z + v[j].w * v[j].w); }
                const float rstd = 1.0f / sqrtf(wave_sum(ss) * (1.0f / DM) + 1e-6f);
#pragma unroll
                for (int j = 0; j < 4; ++j) { const f32x4 sh = *(const f32x4*)(mv + 4 * lane + 256 * j), sc = *(const f32x4*)(mv + 1024 + 4 * lane + 256 * j);
                    const f32x4 h = v[j] * rstd * (sc + 1.0f) + sh;
                    *(unsigned long long*)(H + (size_t)R * DM + 4 * lane + 256 * j) = (unsigned long long)pk2(h.x, h.y) | ((unsigned long long)pk2(h.z, h.w) << 32); }
            }
        }
        GRID_BAR();
        {
            KP_DECL
            { LAS float* tabw = (LAS float*)(lds + TAB_OFF); const float* rc = W_ROPEC; const float* g8 = KIN(8); const float* g9 = KIN(9);
              int tid0 = threadIdx.x; asm volatile("" : "+v"(tid0));
              for (int i = tid0; i < TAB_FLOATS; i += 512) tabw[i] = i < 4096 ? rc[i] : (i < 4160 ? g8[i - 4096] : g9[i - 4160]);
              __syncthreads(); }
            pg8::Gemm g{W_H, (const u16*)(ws + (layer == 0 ? WS_WIN0 : WS_WIN1)), RT, NIN, DM}; pg8::StaticOrder S; S.init(RT, NIN, G, bx);
            pg8::EpiQKV E{W_QKV, W_Y, (const LAS float*)(lds + TAB_OFF), layer};
            pg8::gemm_phase<pg8::EpiQKV, pg8::StaticOrder, true, true>(lds, g, S, E);
        }
        GRID_BAR();
        {
            PH_IDS
            const u16* QKV = W_QKV; u16* Y = W_Y;
            const int r32 = lane & 31;
            if (layer == 0) {
                const float* rpb = KIN(10);
                LAS float* biasT = (LAS float*)(lds + BIAS_OFF);
                for (int i = tid; i < 8 * 465; i += 512) biasT[i] = rpb[i] * LOG2E;
                __syncthreads();
                for (int uid = vcu; uid < 1024; uid += G) {
                    const int i = uid >> 8, g = (uid & 255) >> 5, s = uid & 31, b = g >> 1, kv = g & 1, hq = kv * 4 + i; const u16* base = QKV + (size_t)b * SE * NQKV;
                    const fa::OutMulY o_{Y + ((size_t)b * SE + s * 256) * DM + hq * 64};
                    const fa::PlainMap tm_{(const fa::bf16*)(base + (size_t)(s * 256) * NQKV + hq * 64)};
                    fa::attn_unit<FA_THR>(tm_, (const fa::bf16*)(base + 512 + kv * 64), (const fa::bf16*)(base + 640 + kv * 64), 132, (char*)lds_raw, o_);
                }
                for (int uid = vcu; uid < 1024; uid += G) {
                    const int i = uid >> 8, g = (uid & 255) >> 5, s = uid & 31, bh = 4 * g + i, b = bh >> 3, h = bh & 7, R0 = 4 * s; const u16* base = QKV + (size_t)b * SE * NQKV;
                    const int rs0 = min(max(R0 - 4, 0), 120), nr = min(max(R0 - 1, 0), 120) + 8 - rs0, r = R0 + (wave >> 1), c = 32 * (wave & 1) + r32;
                    const fa::NAMap tm_{(const fa::bf16*)(base + (size_t)(r * 64 + 32 * (wave & 1)) * NQKV + 768 + h * 64), rs0, nr, r, min(max(r - 4, 0), 120), c, min(max(c - 8, 0), 48), (const float*)(lds_raw + BIAS_OFF) + h * 465};
                    const fa::OutMulYW o_{Y + ((size_t)b * SE + r * 64 + 32 * (wave & 1)) * DM + 512 + h * 64};
                    fa::attn_unit<FA_THR>(tm_, (const fa::bf16*)(base + 1280 + h * 64), (const fa::bf16*)(base + 1792 + h * 64), (4 + nr + 1) & ~1, (char*)lds_raw, o_);
                }
                const wa::lptr slot = lds + wave * 16384; LAS float* wsf = (LAS float*)(lds + SCR_OFF + wave * 256);
                for (int v = gw; v < 512; v += NGW) {
                    wa::State st; st.m = -INFINITY; st.l = 0.f; float rl[16];
                    const int isb = v >> 8, w = v & 255, b = w >> 6, h = (w >> 3) & 7, qb = w & 7; const u16* base = QKV + ((size_t)b * SE + SEQ) * NQKV;
                    const int kc = isb ? 1280 + h * 64 : 512 + (h >> 2) * 64, vc = isb ? 1792 + h * 64 : 640 + (h >> 2) * 64, qc = isb ? 768 + h * 64 : h * 64;
                    wa::SpecPlain sp{base + kc, base + vc, 4};
                    wa::run(sp, base + (size_t)(qb * 32 + r32) * NQKV + qc, st, slot, wsf, lane);
                    wa::row_recip(st, rl, wsf, lane);
                    wa::store_mul(st, rl, Y + ((size_t)b * SE + SEQ + qb * 32) * DM + isb * 512 + h * 64, slot, lane);
                }
            } else {
                const float* sinks = KIN(15); const float* clam = KIN(13); const float* subln = KIN(14);
                float lam; { const float a = clam[lane] * clam[64 + lane], b2 = clam[128 + lane] * clam[192 + lane]; lam = expf(wave_sum(a)) - expf(wave_sum(b2)) + LAM0; }
                for (int uid = vcu; uid < 1024; uid += G) {
                    const int i = uid >> 8, g = (uid & 255) >> 5, s = (uid & 31) + 32 * (i & 1), bh = 2 * g + (i >> 1), b = bh >> 2, h = bh & 3; const u16* base = QKV + (size_t)b * SE * NQKV;
                    const fa::OutDiffC o_{Y + ((size_t)b * SE + s * 128) * DM + h * 128, subln, lam, 1.0f - LAM0};
                    fa::attn_unit_c<FA_THR>((const fa::bf16*)(base + (size_t)(s * 128) * NQKV + (2 * h) * 64), (const fa::bf16*)(base + 512 + (2 * h) * 64), (const fa::bf16*)(base + 1024 + h * 128), 132, (char*)lds_raw, o_);
                }
                for (int uid = vcu; uid < 1024; uid += G) {
                    const int i = uid >> 8, g = (uid & 255) >> 5, s = (uid & 31) + 32 * i, b = g >> 1, kv = g & 1, T0 = 64 * s, hq = 4 * kv + (wave >> 1); const u16* base = QKV + (size_t)b * SE * NQKV;
                    const int first = T0 - 128, ilo = first < 0 ? (-first) >> 6 : 0, ihi = min(4, (SEQ - 64 - first) >> 6), nw = ihi - ilo + 1, qrow0 = T0 + 32 * (wave & 1);
                    const fa::WinMap tm_{(const fa::bf16*)(base + (size_t)qrow0 * NQKV + 1536 + hq * 64), first + 64 * ilo, nw, qrow0 + r32, sinks[hq] * LOG2E};
                    const fa::OutMulYW o_{Y + ((size_t)b * SE + qrow0) * DM + 512 + hq * 64};
                    fa::attn_unit<FA_THR>(tm_, (const fa::bf16*)(base + 2048 + kv * 64), (const fa::bf16*)(base + 2176 + kv * 64), (4 + nw + 1) & ~1, (char*)lds_raw, o_);
                }
            }
        }
        GRID_BAR();
        {
            KP_DECL
            pg8::Gemm g{W_Y, (const u16*)(ws + (layer == 0 ? WS_WOUT0 : WS_WOUT1)), RT, DM, DM}; pg8::FlexOrder S; S.init(DM, G, bx, layer);
            pg8::EpiOut E{layer == 0 ? KIN(0) : KOUT, KOUT, KIN(2), W_XC1, W_MOD + (size_t)layer * 5 * 3072};
            pg8::gemm_phase<pg8::EpiOut, pg8::FlexOrder, true, true>(lds, g, S, E);
#ifdef PROBE_G2
            if (layer == 0) { __syncthreads(); pg8::gemm_phase<pg8::EpiOut, pg8::FlexOrder, true, true>(lds, g, S, E); }
#endif
        }
        GRID_BAR();
    }
    PH_IDS
    float* out = KOUT; const float* fnorm = KIN(16);
    const float bad = (__hip_atomic_load((unsigned*)(ws + WS_CTL) + CW_BAR + XB_TMO, __ATOMIC_RELAXED, __HIP_MEMORY_SCOPE_AGENT) != 0u) ? __builtin_nanf("") : 0.f;
    for (int row = gw; row < NB * SEQ; row += NGW) {
        float* p = out + (size_t)row * DM; f32x4 v[4]; float ss = 0.f;
#pragma unroll
        for (int j = 0; j < 4; ++j) { v[j] = *(const f32x4*)(p + 4 * lane + 256 * j); ss += (v[j].x * v[j].x + v[j].y * v[j].y) + (v[j].z * v[j].z + v[j].w * v[j].w); }
        const float rstd = 1.0f / sqrtf(wave_sum(ss) * (1.0f / DM) + 1e-6f);
#pragma unroll
        for (int j = 0; j < 4; ++j) { const f32x4 gn = *(const f32x4*)(fnorm + 4 * lane + 256 * j); *(f32x4*)(p + 4 * lane + 256 * j) = v[j] * rstd * gn + bad; }
    }
}

extern "C" void kernel_launch(void* const* d_in, const int* in_sizes, int n_in, void* d_out, int out_size, void* d_ws, size_t ws_size, hipStream_t stream) {
    static int grid = 0;
    if (grid == 0) {
        if (n_in != 17 || in_sizes[0] != NB * SEQ * DM || out_size != NB * SEQ * DM || ws_size < WS_END) { fprintf(stderr, "kernel_launch: unexpected shapes / workspace (n_in %d, ws %zu)\n", n_in, ws_size); grid = -1; return; }
        int dev = 0, cus = 0, per_cu = 0;
        if (hipGetDevice(&dev) != hipSuccess || hipDeviceGetAttribute(&cus, hipDeviceAttributeMultiprocessorCount, dev) != hipSuccess) { grid = -1; return; }
        if (hipFuncSetAttribute((const void*)fwd_kernel, hipFuncAttributeMaxDynamicSharedMemorySize, LDS_BYTES) != hipSuccess) { fprintf(stderr, "kernel_launch: hipFuncSetAttribute failed\n"); grid = -1; return; }
        if (hipOccupancyMaxActiveBlocksPerMultiprocessor(&per_cu, (const void*)fwd_kernel, 512, LDS_BYTES) != hipSuccess || per_cu < 1) { fprintf(stderr, "kernel_launch: occupancy query says %d blocks per CU\n", per_cu); per_cu = 1; }
        (void)hipGetLastError();
        grid = cus;
    }
    if (grid < 0) return;
    if (hipMemsetAsync((char*)d_ws + WS_CTL, 0, CTL_ZERO_BYTES, stream) != hipSuccess) { fprintf(stderr, "kernel_launch: memset failed\n"); return; }
    Args a{};
    for (int i = 0; i < 17; ++i) a.in[i] = (const float*)d_in[i];
    a.out = (float*)d_out; a.ws = (unsigned char*)d_ws;
#ifdef USE_CG
    void* kargs[] = {&a};
    hipError_t e = hipLaunchCooperativeKernel((const void*)fwd_kernel, dim3(grid), dim3(512), kargs, LDS_BYTES, stream);
    if (e != hipSuccess) fprintf(stderr, "cooperative launch failed: %s\n", hipGetErrorString(e));
#else
    hipLaunchKernelGGL(fwd_kernel, dim3(grid), dim3(512), LDS_BYTES, stream, a);
#endif
}
```
